# Optimizing an MI355X kernel written in HIP

```python
import math
import jax, jax.numpy as jnp
from jax import lax
import numpy as np

D_MODEL = 4096
BATCH = 1
SEQ = 8192
DEPTH = 4

HEAD_DIM = 128
GRID_W = 64
Q_BLOCK = 128
NORM_EPS = 1e-6
NEG_INF = -1e30
A_HEADS = 16
A_KV_HEADS = 4
ROPE_THETA = 10000.0
B_HEADS = 16
NA_ROWS_MAX = 8
NA_COLS = 16
C_HEADS = 32
C_KV_HEADS = 8
C_WINDOW = 128

A_Q = A_HEADS * HEAD_DIM
A_KV = A_KV_HEADS * HEAD_DIM
B_W = B_HEADS * HEAD_DIM
AB_WIDTH = A_Q + B_W
AB_IN = A_Q + 2 * A_KV + 3 * B_W + AB_WIDTH
C_Q = C_HEADS * HEAD_DIM
C_KV = C_KV_HEADS * HEAD_DIM
C_IN = C_Q + 2 * C_KV + C_Q
N_EVEN = (DEPTH + 1) // 2
N_ODD = DEPTH // 2

kernel_name = "hybrid_gqa_natten_swa_gated_encoder"


def rms_norm(x, w):
    xf = x.astype(jnp.float32)
    y = xf * lax.rsqrt(jnp.mean(xf * xf, axis=-1, keepdims=True) + NORM_EPS)
    return (y * w.astype(jnp.float32)).astype(x.dtype)


def split_cols(z, sizes):
    idx = list(np.cumsum(sizes)[:-1])
    return jnp.split(z, idx, axis=-1)


def axial_rope(x, pos):
    half = HEAD_DIM // 2
    quarter = half // 2
    inv = jnp.exp(-math.log(ROPE_THETA) * jnp.arange(0, half, 2, dtype=jnp.float32) / half)
    rows = (pos // GRID_W).astype(jnp.float32)
    cols = (pos % GRID_W).astype(jnp.float32)

    def rot(xh, p):
        ang = p[:, None] * inv[None, :]
        cos = jnp.cos(ang)[None, :, None, :]
        sin = jnp.sin(ang)[None, :, None, :]
        xf = xh.astype(jnp.float32)
        x1, x2 = xf[..., :quarter], xf[..., quarter:]
        return jnp.concatenate([x1 * cos - x2 * sin, x2 * cos + x1 * sin], axis=-1)

    out = jnp.concatenate([rot(x[..., :half], rows), rot(x[..., half:], cols)], axis=-1)
    return out.astype(x.dtype)


def global_gqa(q, k, v):
    B, S, Hq, D = q.shape
    Hkv = k.shape[2]
    G = Hq // Hkv
    nb = S // Q_BLOCK
    scale = D ** -0.5
    qb = q.reshape(B, nb, Q_BLOCK, Hkv, G, D).transpose(1, 0, 2, 3, 4, 5)

    def one(qblk):
        s = jnp.einsum('bqkgd,bskd->bkgqs', qblk, k, preferred_element_type=jnp.float32) * scale
        p = jax.nn.softmax(s, axis=-1).astype(v.dtype)
        return jnp.einsum('bkgqs,bskd->bqkgd', p, v)

    o = lax.map(one, qb)
    return o.transpose(1, 0, 2, 3, 4, 5).reshape(B, S, Hq * D)


def neighbourhood_attention(q, k, v, rpb):
    B, S, H, D = q.shape
    rows = S // GRID_W
    wr = min(NA_ROWS_MAX, rows)
    wc = NA_COLS
    nb = S // Q_BLOCK
    scale = D ** -0.5
    qb = q.reshape(B, nb, Q_BLOCK, H, D).transpose(1, 0, 2, 3, 4)
    r_off = jnp.arange(wr, dtype=jnp.int32)
    c_off = jnp.arange(wc, dtype=jnp.int32)

    def one(args):
        blk, qblk = args
        t = blk * Q_BLOCK + jnp.arange(Q_BLOCK, dtype=jnp.int32)
        r = t // GRID_W
        c = t % GRID_W
        rs = jnp.clip(r - wr // 2, 0, rows - wr)
        cs = jnp.clip(c - wc // 2, 0, GRID_W - wc)
        kr = rs[:, None] + r_off[None, :]
        kc = cs[:, None] + c_off[None, :]
        idx = (kr[:, :, None] * GRID_W + kc[:, None, :]).reshape(Q_BLOCK, wr * wc)
        kg = k[:, idx]
        vg = v[:, idx]
        dr = kr - r[:, None] + (NA_ROWS_MAX - 1)
        dc = kc - c[:, None] + (NA_COLS - 1)
        bias = rpb[:, dr[:, :, None], dc[:, None, :]].reshape(H, Q_BLOCK, wr * wc)
        s = jnp.einsum('bqhd,bqnhd->bhqn', qblk, kg, preferred_element_type=jnp.float32) * scale
        s = s + bias.astype(jnp.float32)[None]
        p = jax.nn.softmax(s, axis=-1).astype(v.dtype)
        return jnp.einsum('bhqn,bqnhd->bqhd', p, vg)

    o = lax.map(one, (jnp.arange(nb, dtype=jnp.int32), qb))
    return o.transpose(1, 0, 2, 3, 4).reshape(B, S, H * D)


def alibi_slopes(n):
    return jnp.exp2(-8.0 * jnp.arange(1, n + 1, dtype=jnp.float32) / n)


def window_gqa_sink(q, k, v, sink):
    B, S, Hq, D = q.shape
    Hkv = k.shape[2]
    G = Hq // Hkv
    nb = S // Q_BLOCK
    W = C_WINDOW
    span = Q_BLOCK + 2 * W
    scale = D ** -0.5
    kp = jnp.pad(k, ((0, 0), (W, W), (0, 0), (0, 0)))
    vp = jnp.pad(v, ((0, 0), (W, W), (0, 0), (0, 0)))
    qb = q.reshape(B, nb, Q_BLOCK, Hkv, G, D).transpose(1, 0, 2, 3, 4, 5)
    slopes = alibi_slopes(Hq).reshape(Hkv, G)
    sink_g = sink.astype(jnp.float32).reshape(Hkv, G)

    def one(args):
        blk, qblk = args
        start = blk * Q_BLOCK
        kb = lax.dynamic_slice_in_dim(kp, start, span, axis=1)
        vb = lax.dynamic_slice_in_dim(vp, start, span, axis=1)
        t = start + jnp.arange(Q_BLOCK, dtype=jnp.int32)
        s_pos = start - W + jnp.arange(span, dtype=jnp.int32)
        dist = jnp.abs(t[:, None] - s_pos[None, :])
        valid = (dist <= W) & (s_pos >= 0)[None, :] & (s_pos < S)[None, :]
        sc = jnp.einsum('bqkgd,bskd->bkgqs', qblk, kb, preferred_element_type=jnp.float32) * scale
        sc = sc - slopes[None, :, :, None, None] * dist.astype(jnp.float32)[None, None, None]
        sc = jnp.where(valid[None, None, None], sc, NEG_INF)
        sink_col = jnp.broadcast_to(sink_g[None, :, :, None, None], (B, Hkv, G, Q_BLOCK, 1))
        p = jax.nn.softmax(jnp.concatenate([sc, sink_col], axis=-1), axis=-1)[..., :span]
        return jnp.einsum('bkgqs,bskd->bqkgd', p.astype(v.dtype), vb)

    o = lax.map(one, (jnp.arange(nb, dtype=jnp.int32), qb))
    return o.transpose(1, 0, 2, 3, 4, 5).reshape(B, S, Hq * D)


def setup_inputs(seed: int = 0) -> dict:
    key = jax.random.key(seed)
    ks = jax.random.split(key, 12)
    f32 = jnp.float32
    x = jax.random.normal(ks[0], (BATCH, SEQ, D_MODEL), f32)
    norm_w = 1.0 + 0.02 * jax.random.normal(ks[1], (DEPTH, D_MODEL), f32)
    w_in_ab = jax.random.normal(ks[2], (N_EVEN, D_MODEL, AB_IN), f32) * D_MODEL ** -0.5
    w_out_ab = jax.random.normal(ks[3], (N_EVEN, AB_WIDTH, D_MODEL), f32) * AB_WIDTH ** -0.5
    q_norm_a = 1.0 + 0.02 * jax.random.normal(ks[4], (N_EVEN, HEAD_DIM), f32)
    k_norm_a = 1.0 + 0.02 * jax.random.normal(ks[5], (N_EVEN, HEAD_DIM), f32)
    rpb_b = 0.1 * jax.random.normal(ks[6], (N_EVEN, B_HEADS, 2 * NA_ROWS_MAX - 1, 2 * NA_COLS - 1), f32)
    w_in_c = jax.random.normal(ks[7], (N_ODD, D_MODEL, C_IN), f32) * D_MODEL ** -0.5
    w_out_c = jax.random.normal(ks[8], (N_ODD, C_Q, D_MODEL), f32) * C_Q ** -0.5
    sink_c = 0.5 * jax.random.normal(ks[9], (N_ODD, C_HEADS), f32)
    final_norm_w = 1.0 + 0.02 * jax.random.normal(ks[10], (D_MODEL,), f32)
    return {"x": x, "norm_w": norm_w, "w_in_ab": w_in_ab, "w_out_ab": w_out_ab,
            "q_norm_a": q_norm_a, "k_norm_a": k_norm_a, "rpb_b": rpb_b,
            "w_in_c": w_in_c, "w_out_c": w_out_c, "sink_c": sink_c,
            "final_norm_w": final_norm_w}


def reference(x, norm_w, w_in_ab, w_out_ab, q_norm_a, k_norm_a, rpb_b, w_in_c, w_out_c, sink_c, final_norm_w):
    B, S, _ = x.shape
    pos = jnp.arange(S, dtype=jnp.int32)
    for layer in range(DEPTH):
        h = rms_norm(x, norm_w[layer])
        if layer % 2 == 0:
            e = layer // 2
            z = h @ w_in_ab[e]
            qa, ka, va, qb, kb, vb, gate = split_cols(z, [A_Q, A_KV, A_KV, B_W, B_W, B_W, AB_WIDTH])
            qa = qa.reshape(B, S, A_HEADS, HEAD_DIM)
            ka = ka.reshape(B, S, A_KV_HEADS, HEAD_DIM)
            va = va.reshape(B, S, A_KV_HEADS, HEAD_DIM)
            qa = axial_rope(rms_norm(qa, q_norm_a[e]), pos)
            ka = axial_rope(rms_norm(ka, k_norm_a[e]), pos)
            oa = global_gqa(qa, ka, va)
            ob = neighbourhood_attention(qb.reshape(B, S, B_HEADS, HEAD_DIM),
                                         kb.reshape(B, S, B_HEADS, HEAD_DIM),
                                         vb.reshape(B, S, B_HEADS, HEAD_DIM), rpb_b[e])
            y = jnp.concatenate([oa, ob], axis=-1) * jax.nn.silu(gate)
            x = x + y @ w_out_ab[e]
        else:
            o = layer // 2
            z = h @ w_in_c[o]
            qc, kc, vc, gate = split_cols(z, [C_Q, C_KV, C_KV, C_Q])
            oc = window_gqa_sink(qc.reshape(B, S, C_HEADS, HEAD_DIM),
                                 kc.reshape(B, S, C_KV_HEADS, HEAD_DIM),
                                 vc.reshape(B, S, C_KV_HEADS, HEAD_DIM), sink_c[o])
            x = x + (oc * jax.nn.silu(gate)) @ w_out_c[o]
    return rms_norm(x, final_norm_w)
```

```cpp
#include <hip/hip_runtime.h>
#include <cstdio>
#include <cstdint>
namespace pg8 {
#define PG8_LAS __attribute__((address_space(3)))
typedef unsigned short bf16_t;
typedef short bf16x8 __attribute__((ext_vector_type(8)));
typedef float f32x4 __attribute__((ext_vector_type(4)));
typedef unsigned u32x4 __attribute__((ext_vector_type(4)));
constexpr int BM = 256, BK = 64, HALF = 128, HTB = HALF * BK * 2  , STAGE_BYTES = 8 * HTB, NXCD = 8, WGM = 8;

__host__ __device__ __forceinline__ int lds_byte(int r, int c) { const int st = (r >> 4) * 2 + (c >> 5), rr = r & 15, cc = c & 31, ob = rr * 64 + cc * 2; return st * 1024 + (ob ^ (((ob >> 9) & 1) << 5)); }
__host__ __device__ __forceinline__ void stage_rc(int b, int& R, int& C) { const int st = b / 1024, sb = b % 1024, swz = sb ^ (((sb >> 9) & 1) << 5); R = (st >> 1) * 16 + swz / 64; C = (st & 1) * 32 + (swz % 64) / 2; }
__host__ __device__ __forceinline__ int perm32(int rho) { const int n = rho >> 4, i = rho & 15; return 8 * (i >> 2) + 4 * n + (i & 3); }

struct Unit { int pm, pn; };
struct Gemm { const bf16_t* A; const bf16_t* Bt; int M, N, K; };

struct StaticOrder {
    int nM, nN, nwg, G, c;
    __host__ __device__ void init(int M, int N, int G_, int c_) { nM = M / BM; nN = N / BM; nwg = nM * nN; G = G_; c = c_; }
    __host__ __device__ bool next(int i, Unit& u) const {
        const long L = (long)i * G + c; if (L >= nwg) return false;
        int wgid = (int)L; { const int q = nwg / NXCD, r = nwg % NXCD, xcd = wgid % NXCD, off = wgid / NXCD; wgid = (xcd < r ? xcd * (q + 1) : r * (q + 1) + (xcd - r) * q) + off; }
        const int nig = WGM * nN, gid = wgid / nig, fm = gid * WGM, gsz = (nM - fm) < WGM ? (nM - fm) : WGM;
        u.pm = fm + ((wgid % nig) % gsz); u.pn = (wgid % nig) / gsz; return true;
    }
    __device__ __forceinline__ void a_ready(const Unit&) const {}
    __device__ __forceinline__ void done(const Unit&) const {}
};

__device__ __forceinline__ unsigned cvt_pk_bf16(float lo, float hi) { unsigned r; asm volatile("v_cvt_pk_bf16_f32 %0, %1, %2" : "=v"(r) : "v"(lo), "v"(hi)); return r; }
typedef float f32x2 __attribute__((ext_vector_type(2)));
struct EpiIn {
    static constexpr bool PERM = true, AFTER_DRAIN = false;
    bf16_t* Z; int ldz; const float* part;
    __device__ __forceinline__ void operator()(const f32x4 (&acc)[2][2][4][2], const Unit& u, int wr, int wc, int fr, int fq) const {
        const int row0 = u.pm * BM + wr * 64 + fr, col0 = u.pn * BM + wc * 32 + 8 * fq;
#pragma unroll
        for (int ai = 0; ai < 2; ++ai)
#pragma unroll
            for (int m = 0; m < 4; ++m) {
                const int row = row0 + ai * HALF + m * 16;
                const f32x4* pp = (const f32x4*)(part + (size_t)row * 64 + fq * 16);
                const f32x4 a = pp[0], b = pp[1], c = pp[2], d = pp[3];
                float s = (((a[0] + a[1]) + (a[2] + a[3])) + ((b[0] + b[1]) + (b[2] + b[3]))) + (((c[0] + c[1]) + (c[2] + c[3])) + ((d[0] + d[1]) + (d[2] + d[3])));
                s += __shfl_xor(s, 16); s += __shfl_xor(s, 32);
                const float rs = 1.0f / sqrtf(s * (1.0f / 4096.0f) + 1e-6f);
                bf16_t* rowp = Z + (size_t)row * ldz + col0;
#pragma unroll
                for (int bj = 0; bj < 2; ++bj) { const f32x4 v0 = acc[ai][bj][m][0] * rs, v1 = acc[ai][bj][m][1] * rs;
                    u32x4 w; w.x = cvt_pk_bf16(v0[0], v0[1]); w.y = cvt_pk_bf16(v0[2], v0[3]); w.z = cvt_pk_bf16(v1[0], v1[1]); w.w = cvt_pk_bf16(v1[2], v1[3]);
                    *(u32x4*)(rowp + bj * HALF) = w; }
            }
    }
};
struct EpiOut {
    static constexpr bool PERM = true, AFTER_DRAIN = false;
    const float* Xold; float* Xnew; bf16_t* XB; float* part;
    __device__ __forceinline__ void operator()(const f32x4 (&acc)[2][2][4][2], const Unit& u, int wr, int wc, int fr, int fq) const {
        const int row0 = u.pm * BM + wr * 64 + fr, col0 = u.pn * BM + wc * 32 + 8 * fq;
#pragma unroll
        for (int ai = 0; ai < 2; ++ai)
#pragma unroll
            for (int m = 0; m < 4; ++m) {
                const int row = row0 + ai * HALF + m * 16; float ss = 0.f;
#pragma unroll
                for (int bj = 0; bj < 2; ++bj) { const size_t off = (size_t)row * 4096 + col0 + bj * HALF;
                    f32x4 x0 = *(const f32x4*)(Xold + off), x1 = *(const f32x4*)(Xold + off + 4);
                    x0 += acc[ai][bj][m][0]; x1 += acc[ai][bj][m][1];
                    *(f32x4*)(Xnew + off) = x0; *(f32x4*)(Xnew + off + 4) = x1;
                    u32x4 w; w.x = cvt_pk_bf16(x0[0], x0[1]); w.y = cvt_pk_bf16(x0[2], x0[3]); w.z = cvt_pk_bf16(x1[0], x1[1]); w.w = cvt_pk_bf16(x1[2], x1[3]);
                    *(u32x4*)(XB + off) = w;
                    ss += ((x0[0] * x0[0] + x0[1] * x0[1]) + (x0[2] * x0[2] + x0[3] * x0[3])) + ((x1[0] * x1[0] + x1[1] * x1[1]) + (x1[2] * x1[2] + x1[3] * x1[3])); }
                ss += __shfl_xor(ss, 16); ss += __shfl_xor(ss, 32);
                if (fq == 0) part[(size_t)row * 64 + u.pn * 4 + wc] = ss;
            }
    }
};
template <class Epi, class Sched, bool ALIGN_EPI = false, bool SP2 = false>
__device__ __forceinline__ void gemm_phase(PG8_LAS unsigned char* lds, const Gemm g, const Sched& S, const Epi& E) {
    int tid_ = threadIdx.x; asm volatile("" : "+v"(tid_));
    const int tid = tid_, wid = __builtin_amdgcn_readfirstlane(tid >> 6), lane = tid & 63, wr = wid >> 2, wc = wid & 3, fr = lane & 15, fq = lane >> 4;
    const int K = g.K, nt = K / BK;
    unsigned voffA[2], voffB[2];
#pragma unroll
    for (int i = 0; i < 2; ++i) { int R, C; stage_rc(tid * 16 + i * 8192, R, C); const int Rb = Epi::PERM ? ((R & ~31) + perm32(R & 31)) : R;
        voffA[i] = (unsigned)(R * K + C) * 2u; voffB[i] = (unsigned)(Rb * K + C) * 2u; }
    const size_t kstep = (size_t)(BK * 2);
    const size_t hstep = (size_t)HALF * K * 2;
    const size_t tstep = 2 * hstep;
    const unsigned ldsw = (unsigned)wid * 1024u;
    const int aoff = lds_byte(wr * 64 + fr, fq * 8), boff = lds_byte(wc * 32 + fr, fq * 8);
#define PG8_SA(b, h) (((b) * 2 + (h)) * HTB)
#define PG8_SB(b, h) ((4 + (b) * 2 + (h)) * HTB)
#define PG8_STAGE(bufoff, gbase, voff) do { _Pragma("unroll") for (int _i = 0; _i < 2; ++_i) \
        __builtin_amdgcn_global_load_lds((const unsigned*)((const char*)(gbase) + (voff)[_i]), (PG8_LAS unsigned*)(lds + (bufoff) + ldsw + _i * 8192), 16, 0, 0); } while (0)
#define PG8_LDA(dst, b, h) do { _Pragma("unroll") for (int m = 0; m < 4; ++m) _Pragma("unroll") for (int k = 0; k < 2; ++k) dst[m][k] = *(const PG8_LAS bf16x8*)(lds + PG8_SA(b, h) + aoff + m * 2048 + k * 1024); } while (0)
#define PG8_LDB(dst, b, h) do { _Pragma("unroll") for (int n = 0; n < 2; ++n) _Pragma("unroll") for (int k = 0; k < 2; ++k) dst[n][k] = *(const PG8_LAS bf16x8*)(lds + PG8_SB(b, h) + boff + n * 2048 + k * 1024); } while (0)
#define PG8_MMA(ai, bj, At, Bt) do { __builtin_amdgcn_s_setprio(1); _Pragma("unroll") for (int m = 0; m < 4; ++m) _Pragma("unroll") for (int n = 0; n < 2; ++n) _Pragma("unroll") for (int k = 0; k < 2; ++k) \
        acc[ai][bj][m][n] = __builtin_amdgcn_mfma_f32_16x16x32_bf16(Bt[n][k], At[m][k], acc[ai][bj][m][n], 0, 0, 0); __builtin_amdgcn_s_setprio(0); } while (0)
#define PG8_WAIT_V(n) asm volatile("s_waitcnt vmcnt(" #n ")" ::: "memory")
#define PG8_WAIT_L(n) asm volatile("s_waitcnt lgkmcnt(" #n ")" ::: "memory")
#define PG8_BAR __builtin_amdgcn_s_barrier()
#define PG8_SCHED __builtin_amdgcn_sched_barrier(0)
    Unit cur, nxt; int ui = 0;
    if (!S.next(0, cur)) return;
    f32x4 acc[2][2][4][2];
#pragma unroll
    for (int a = 0; a < 2; ++a)
#pragma unroll
        for (int b = 0; b < 2; ++b)
#pragma unroll
            for (int m = 0; m < 4; ++m)
#pragma unroll
                for (int n = 0; n < 2; ++n) acc[a][b][m][n] = (f32x4){0.f, 0.f, 0.f, 0.f};
    bf16x8 At[4][2], B0[2][2], B1[2][2];
    const char* cA = (const char*)g.A + (size_t)cur.pm * tstep; const char* cB = (const char*)g.Bt + (size_t)cur.pn * tstep;
    S.a_ready(cur);
    if constexpr (SP2) {
        PG8_STAGE(PG8_SB(0, 0), cB, voffB); PG8_STAGE(PG8_SB(0, 1), cB + hstep, voffB); PG8_STAGE(PG8_SA(0, 0), cA, voffA); PG8_STAGE(PG8_SA(0, 1), cA + hstep, voffA);
        if (wr == 1) PG8_BAR;
        PG8_WAIT_V(2); PG8_BAR;
        PG8_STAGE(PG8_SB(1, 0), cB + kstep, voffB); PG8_STAGE(PG8_SA(1, 0), cA + kstep, voffA); PG8_STAGE(PG8_SB(1, 1), cB + hstep + kstep, voffB);
        PG8_WAIT_V(6); PG8_BAR;
    } else {
        PG8_STAGE(PG8_SB(0, 0), cB, voffB); PG8_STAGE(PG8_SA(0, 0), cA, voffA); PG8_STAGE(PG8_SB(0, 1), cB + hstep, voffB); PG8_STAGE(PG8_SA(0, 1), cA + hstep, voffA);
        if (wr == 1) PG8_BAR;
        PG8_WAIT_V(4); PG8_BAR;
        PG8_STAGE(PG8_SB(1, 0), cB + kstep, voffB); PG8_STAGE(PG8_SA(1, 0), cA + kstep, voffA); PG8_STAGE(PG8_SB(1, 1), cB + hstep + kstep, voffB);
        PG8_WAIT_V(6); PG8_BAR;
    }
    for (;;) {
        const bool has_next = S.next(ui + 1, nxt);
        const char* nA = has_next ? (const char*)g.A + (size_t)nxt.pm * tstep : cA; const char* nB = has_next ? (const char*)g.Bt + (size_t)nxt.pn * tstep : cB;
        for (int t = 0; t < nt; t += 2) {
            const bool last = (t == nt - 2);
            const char* a1 = cA + (size_t)(t + 1) * kstep;
            const char* a2 = last ? nA : cA + (size_t)(t + 2) * kstep; const char* b2 = last ? nB : cB + (size_t)(t + 2) * kstep;
            const char* a3 = a2 + kstep; const char* b3 = b2 + kstep;
            if (last && has_next) S.a_ready(nxt);
            if constexpr (SP2) {
            PG8_LDB(B0, 0, 0); PG8_LDB(B1, 0, 1); PG8_SCHED; PG8_LDA(At, 0, 0); PG8_STAGE(PG8_SA(1, 1), a1 + hstep, voffA);
            PG8_WAIT_V(8); PG8_WAIT_L(0); PG8_BAR; PG8_MMA(0, 0, At, B0); PG8_MMA(0, 1, At, B1); PG8_BAR; PG8_SCHED;
            PG8_LDA(At, 0, 1); PG8_STAGE(PG8_SB(0, 0), b2, voffB); PG8_STAGE(PG8_SB(0, 1), b2 + hstep, voffB); PG8_STAGE(PG8_SA(0, 0), a2, voffA);
            PG8_WAIT_V(8); PG8_WAIT_L(0); PG8_BAR; PG8_MMA(1, 0, At, B0); PG8_MMA(1, 1, At, B1); PG8_BAR; PG8_SCHED;
            PG8_LDB(B0, 1, 0); PG8_LDB(B1, 1, 1); PG8_SCHED; PG8_LDA(At, 1, 0); PG8_STAGE(PG8_SA(0, 1), a2 + hstep, voffA);
            PG8_WAIT_V(8); PG8_WAIT_L(0); PG8_BAR; PG8_MMA(0, 0, At, B0); PG8_MMA(0, 1, At, B1); PG8_BAR; PG8_SCHED;
            PG8_LDA(At, 1, 1); PG8_STAGE(PG8_SB(1, 0), b3, voffB); PG8_STAGE(PG8_SB(1, 1), b3 + hstep, voffB); PG8_STAGE(PG8_SA(1, 0), a3, voffA);
            PG8_WAIT_V(8); PG8_WAIT_L(0); PG8_BAR; PG8_MMA(1, 0, At, B0); PG8_MMA(1, 1, At, B1); PG8_BAR; PG8_SCHED;
            } else {
            PG8_LDB(B0, 0, 0); PG8_SCHED; PG8_LDA(At, 0, 0); PG8_STAGE(PG8_SA(1, 1), a1 + hstep, voffA);
            PG8_WAIT_L(8); PG8_BAR; PG8_WAIT_L(0); PG8_MMA(0, 0, At, B0); PG8_BAR; PG8_SCHED;
            PG8_LDB(B1, 0, 1); PG8_STAGE(PG8_SB(0, 0), b2, voffB);
            PG8_BAR; PG8_WAIT_L(0); PG8_MMA(0, 1, At, B1); PG8_BAR;
            PG8_LDA(At, 0, 1); PG8_STAGE(PG8_SA(0, 0), a2, voffA);
            PG8_BAR; PG8_WAIT_L(0); PG8_MMA(1, 0, At, B0); PG8_BAR; PG8_SCHED;
            PG8_STAGE(PG8_SB(0, 1), b2 + hstep, voffB);
            PG8_WAIT_V(6); PG8_BAR; PG8_MMA(1, 1, At, B1); PG8_BAR;
            PG8_LDB(B0, 1, 0); PG8_SCHED; PG8_LDA(At, 1, 0); PG8_STAGE(PG8_SA(0, 1), a2 + hstep, voffA);
            PG8_WAIT_L(8); PG8_BAR; PG8_WAIT_L(0); PG8_MMA(0, 0, At, B0); PG8_BAR; PG8_SCHED;
            PG8_LDB(B1, 1, 1); PG8_STAGE(PG8_SB(1, 0), b3, voffB);
            PG8_BAR; PG8_WAIT_L(0); PG8_MMA(0, 1, At, B1); PG8_BAR;
            PG8_LDA(At, 1, 1); PG8_STAGE(PG8_SA(1, 0), a3, voffA);
            PG8_BAR; PG8_WAIT_L(0); PG8_MMA(1, 0, At, B0); PG8_BAR; PG8_SCHED;
            PG8_STAGE(PG8_SB(1, 1), b3 + hstep, voffB);
            PG8_WAIT_V(6); PG8_BAR; PG8_MMA(1, 1, At, B1); PG8_BAR;
            }
        }
        if constexpr (ALIGN_EPI) { if (wr == 0) PG8_BAR; }
        if constexpr (!Epi::AFTER_DRAIN) { E(acc, cur, wr, wc, fr, fq); S.done(cur); }
        if (!has_next) break;
#pragma unroll
        for (int a = 0; a < 2; ++a)
#pragma unroll
            for (int b = 0; b < 2; ++b)
#pragma unroll
                for (int m = 0; m < 4; ++m)
#pragma unroll
                    for (int n = 0; n < 2; ++n) acc[a][b][m][n] = (f32x4){0.f, 0.f, 0.f, 0.f};
        cur = nxt; cA = nA; cB = nB; ++ui;
        if constexpr (ALIGN_EPI) { if (wr == 1) PG8_BAR; }
    }
    PG8_WAIT_V(0);
    if constexpr (!ALIGN_EPI) { if (wr == 0) PG8_BAR; }
    PG8_BAR;
    if constexpr (Epi::AFTER_DRAIN) { E.fused(acc, cur, wr, wc, fr, fq, lds, wid, lane); S.done(cur); }
#undef PG8_SA
#undef PG8_SB
#undef PG8_STAGE
#undef PG8_LDA
#undef PG8_LDB
#undef PG8_MMA
#undef PG8_WAIT_V
#undef PG8_WAIT_L
#undef PG8_BAR
#undef PG8_SCHED
}
}
namespace att {
using bf16 = unsigned short;
constexpr int D = 128, NW = 8, QBLK = 32, KVBLK = 64;
constexpr float SCALE = 0.088388347648318440f;
constexpr float THR = 8.f;
using f32x4 = __attribute__((ext_vector_type(4))) float;
using bf16x8 = __attribute__((ext_vector_type(8))) short;
using s16x4  = __attribute__((ext_vector_type(4))) short;
using f32x16 = __attribute__((ext_vector_type(16))) float;
using f32x8  = __attribute__((ext_vector_type(8))) float;
using u32x4  = __attribute__((ext_vector_type(4))) unsigned;
#define KSWZ(row, colB) ((row) * 256 + ((colB) ^ (((row) & 7) << 4)))
#define SBAR() __builtin_amdgcn_sched_barrier(0)
__device__ __forceinline__ int crow(int r, int hi) { return (r & 3) + 8 * (r >> 2) + 4 * hi; }
__device__ __forceinline__ unsigned cvtpk(float lo, float hi) {
  unsigned r; asm volatile("v_cvt_pk_bf16_f32 %0, %1, %2" : "=v"(r) : "v"(lo), "v"(hi)); return r;
}
__device__ __forceinline__ void partialSM(f32x16& p0, f32x16& p1, float& m_reg, float& mn, float& alpha) {
  constexpr float C = SCALE * 1.4426950408889634f;
  float pmax = p0[0]; for (int r = 1; r < 16; ++r) pmax = fmaxf(pmax, p0[r]); for (int r = 0; r < 16; ++r) pmax = fmaxf(pmax, p1[r]);
  { auto rr = __builtin_amdgcn_permlane32_swap(__float_as_uint(pmax), __float_as_uint(pmax), false, false);
    pmax = fmaxf(__uint_as_float(rr[0]), __uint_as_float(rr[1])); }
  if (__builtin_expect(__all(pmax - m_reg <= THR / SCALE), 1)) { mn = m_reg; alpha = 1.f; }
  else { mn = fmaxf(m_reg, pmax); alpha = __builtin_amdgcn_exp2f((m_reg - mn) * C); m_reg = mn; }
  float mnC = -mn * C;
  for (int r = 0; r < 16; ++r) p0[r] = fmaf(p0[r], C, mnC); for (int r = 0; r < 16; ++r) p1[r] = fmaf(p1[r], C, mnC);
  for (int r = 0; r < 16; ++r) p0[r] = __builtin_amdgcn_exp2f(p0[r]);
}
__device__ __forceinline__ void finishSM(f32x16& p0, f32x16& p1, float alpha, float& l_reg, bf16x8& pa0, bf16x8& pa1, bf16x8& pa2, bf16x8& pa3) {
  for (int r = 0; r < 16; ++r) p1[r] = __builtin_amdgcn_exp2f(p1[r]);
  float ps = 0; for (int r = 0; r < 16; ++r) ps += p0[r]; for (int r = 0; r < 16; ++r) ps += p1[r];
  { auto rr = __builtin_amdgcn_permlane32_swap(__float_as_uint(ps), __float_as_uint(ps), false, false);
    ps = __uint_as_float(rr[0]) + __uint_as_float(rr[1]); }
  l_reg = l_reg * alpha + ps;
#define PK4(P, BASE, OUT) do { unsigned a0 = cvtpk(P[BASE + 0], P[BASE + 1]), a1 = cvtpk(P[BASE + 2], P[BASE + 3]);   \
    unsigned b0 = cvtpk(P[BASE + 4], P[BASE + 5]), b1 = cvtpk(P[BASE + 6], P[BASE + 7]);                              \
    auto r0 = __builtin_amdgcn_permlane32_swap(a0, b0, false, false); auto r1 = __builtin_amdgcn_permlane32_swap(a1, b1, false, false); \
    u32x4 w = {r0[0], r1[0], r0[1], r1[1]}; OUT = *reinterpret_cast<bf16x8*>(&w); } while (0)
  PK4(p0, 0, pa0); PK4(p0, 8, pa1); PK4(p1, 0, pa2); PK4(p1, 8, pa3);
#undef PK4
}
__device__ __forceinline__ void qkt(f32x16& p0, f32x16& p1, const bf16* Ks, const bf16x8* qr, int r32, int hi) {
  p0 = f32x16{}; p1 = f32x16{};
  for (int d0 = 0; d0 < 8; ++d0) { int cb = (d0 * 16 + hi * 8) * 2;
    bf16x8 b0 = *reinterpret_cast<const bf16x8*>((const char*)Ks + KSWZ(r32, cb));
    bf16x8 b1 = *reinterpret_cast<const bf16x8*>((const char*)Ks + KSWZ(32 + r32, cb));
    p0 = __builtin_amdgcn_mfma_f32_32x32x16_bf16(b0, qr[d0], p0, 0, 0, 0);
    p1 = __builtin_amdgcn_mfma_f32_32x32x16_bf16(b1, qr[d0], p1, 0, 0, 0); }
}
__device__ __forceinline__ int v_st(int k, int c) { const int kk = (k & ~0xC) | ((k & 4) << 1) | ((k & 8) >> 1); return ((kk >> 3) * 4 + (c >> 5)) * 512 + ((kk & 7) * 32 + (c & 31)) * 2; }
__device__ __forceinline__ int v_rd_base(int lane) { return ((lane & 3) << 3) | (((lane >> 2) & 3) << 6) | (((lane >> 4) & 1) << 5) | (((lane >> 5) & 1) << 8); }
constexpr int v_rd_off(int d0, int ks, int half) { return d0 * 512 + ks * 4096 + half * 2048; }
template <int OFF> __device__ __forceinline__ s16x4 tr_read(int vb) {
  s16x4 r; asm volatile("ds_read_b64_tr_b16 %0, %1 offset:%2" : "=&v"(r) : "v"(vb), "i"(OFF) : "memory"); return r;
}
template <int D0> __device__ __forceinline__ void pv_one(f32x16& od, int vb, bf16x8 pa0, bf16x8 pa1, bf16x8 pa2, bf16x8 pa3) {
  const s16x4 l0 = tr_read<v_rd_off(D0, 0, 0)>(vb), h0 = tr_read<v_rd_off(D0, 0, 1)>(vb), l1 = tr_read<v_rd_off(D0, 1, 0)>(vb), h1 = tr_read<v_rd_off(D0, 1, 1)>(vb);
  const s16x4 l2 = tr_read<v_rd_off(D0, 2, 0)>(vb), h2 = tr_read<v_rd_off(D0, 2, 1)>(vb), l3 = tr_read<v_rd_off(D0, 3, 0)>(vb), h3 = tr_read<v_rd_off(D0, 3, 1)>(vb);
  asm volatile("s_waitcnt lgkmcnt(0)" ::: "memory"); SBAR();
#define PK(L, H) (bf16x8){L[0], L[1], L[2], L[3], H[0], H[1], H[2], H[3]}
  od = __builtin_amdgcn_mfma_f32_32x32x16_bf16(pa0, PK(l0, h0), od, 0, 0, 0);
  od = __builtin_amdgcn_mfma_f32_32x32x16_bf16(pa1, PK(l1, h1), od, 0, 0, 0);
  od = __builtin_amdgcn_mfma_f32_32x32x16_bf16(pa2, PK(l2, h2), od, 0, 0, 0);
  od = __builtin_amdgcn_mfma_f32_32x32x16_bf16(pa3, PK(l3, h3), od, 0, 0, 0);
#undef PK
}
__device__ __forceinline__ void pv_d0(f32x16* o, int vb, bf16x8 pa0, bf16x8 pa1, bf16x8 pa2, bf16x8 pa3) {
  pv_one<0>(o[0], vb, pa0, pa1, pa2, pa3); pv_one<1>(o[1], vb, pa0, pa1, pa2, pa3); pv_one<2>(o[2], vb, pa0, pa1, pa2, pa3); pv_one<3>(o[3], vb, pa0, pa1, pa2, pa3);
}
constexpr int DMODEL = 4096;
constexpr size_t SHM_V = 64 * 128 * 2, SHM_K = 64 * 128 * 2;
constexpr int ATT_WS_OFF = 2 * SHM_V + 2 * SHM_K, ATT_TAB_OFF = ATT_WS_OFF + 8 * 256, ATT_OST_OFF = ATT_TAB_OFF + 704 * 4 + 256  , ATT_LDS_BYTES = ATT_OST_OFF + 8 * 8192;
constexpr float LOG2E = 1.4426950408889634f;
__device__ __forceinline__ float bf2f(bf16 v) { return __uint_as_float((unsigned)v << 16); }
__device__ __forceinline__ bf16 f2bf(float f) { return (bf16)(cvtpk(f, 0.f) & 0xffffu); }
__device__ __forceinline__ float silu_f(float g) { return g * __builtin_amdgcn_rcpf(1.0f + __builtin_amdgcn_exp2f(-g * LOG2E)); }
__device__ __forceinline__ void pack_p(const f32x16& p0, const f32x16& p1, bf16x8& pa0, bf16x8& pa1, bf16x8& pa2, bf16x8& pa3) {
#define PK4(P, BASE, OUT) do { unsigned a0 = cvtpk(P[BASE + 0], P[BASE + 1]), a1 = cvtpk(P[BASE + 2], P[BASE + 3]);   \
    unsigned b0 = cvtpk(P[BASE + 4], P[BASE + 5]), b1 = cvtpk(P[BASE + 6], P[BASE + 7]);                              \
    auto r0 = __builtin_amdgcn_permlane32_swap(a0, b0, false, false); auto r1 = __builtin_amdgcn_permlane32_swap(a1, b1, false, false); \
    u32x4 w = {r0[0], r1[0], r0[1], r1[1]}; OUT = *reinterpret_cast<bf16x8*>(&w); } while (0)
  PK4(p0, 0, pa0); PK4(p0, 8, pa1); PK4(p1, 0, pa2); PK4(p1, 8, pa3);
#undef PK4
}
template <int ZP>
__device__ __forceinline__ void store_gated(const f32x16* o, float l_reg, float* li_l, float* ost, const bf16* Gb, bf16* Yb, int wid, int lane, int r32, int hi) {
  if (hi == 0) li_l[r32] = l_reg;
  const int rr = lane >> 3, c8 = (lane & 7) * 8;
  u32x4 g[2][4];
#pragma unroll
  for (int h = 0; h < 2; ++h)
#pragma unroll
    for (int i = 0; i < 4; ++i) g[h][i] = *reinterpret_cast<const u32x4*>((const char*)Gb + (unsigned)(((wid * 32 + 8 * i + rr) * ZP + h * 64 + c8) * 2));
#pragma unroll
  for (int h = 0; h < 2; ++h) {
#pragma unroll
    for (int d = 0; d < 2; ++d)
#pragma unroll
      for (int r = 0; r < 16; ++r) ost[crow(r, hi) * 64 + d * 32 + r32] = o[2 * h + d][r];
    asm volatile("s_waitcnt lgkmcnt(0)" ::: "memory");
#pragma unroll
    for (int i = 0; i < 4; ++i) { const int row = 8 * i + rr;
      const f32x4 a = *reinterpret_cast<const f32x4*>(ost + row * 64 + c8), b = *reinterpret_cast<const f32x4*>(ost + row * 64 + c8 + 4);
      const float rl = __builtin_amdgcn_rcpf(li_l[row]); const u32x4 gg = g[h][i];
      u32x4 w;
      w.x = cvtpk(a[0] * rl * silu_f(__uint_as_float(gg.x << 16)), a[1] * rl * silu_f(__uint_as_float(gg.x & 0xffff0000u)));
      w.y = cvtpk(a[2] * rl * silu_f(__uint_as_float(gg.y << 16)), a[3] * rl * silu_f(__uint_as_float(gg.y & 0xffff0000u)));
      w.z = cvtpk(b[0] * rl * silu_f(__uint_as_float(gg.z << 16)), b[1] * rl * silu_f(__uint_as_float(gg.z & 0xffff0000u)));
      w.w = cvtpk(b[2] * rl * silu_f(__uint_as_float(gg.w << 16)), b[3] * rl * silu_f(__uint_as_float(gg.w & 0xffff0000u)));
      *reinterpret_cast<u32x4*>((char*)Yb + (unsigned)(((wid * 32 + row) * DMODEL + h * 64 + c8) * 2)) = w; }
    asm volatile("s_waitcnt lgkmcnt(0)" ::: "memory");
  }
}

template <int ZP>
__device__ __forceinline__ void dense_unit(const bf16* Qb, const bf16* Kh, const bf16* Vh, const bf16* Gb, bf16* Yb, int seq, char* lds) {
  int tid_ = threadIdx.x; asm volatile("" : "+v"(tid_));
  const int tid = tid_, wid = __builtin_amdgcn_readfirstlane(tid >> 6), lane = tid & 63, r32 = lane & 31, hi = lane >> 5;
  bf16* V_lds = (bf16*)lds; bf16* K_lds = (bf16*)(lds + 2 * SHM_V);
  float* ws = (float*)(lds + ATT_WS_OFF) + wid * 64; float* li_l = ws; float* al_l = ws + 32;
  float m_reg = -1e30f, l_reg = 0; f32x16 o[4] = {}; bf16x8 qr[8];
  { const unsigned qoff = (unsigned)((wid * QBLK + r32) * ZP + hi * 8) * 2u;
#pragma unroll
    for (int d0 = 0; d0 < 8; ++d0) qr[d0] = *reinterpret_cast<const bf16x8*>((const char*)Qb + qoff + d0 * 32); }
  const int sr = tid >> 4, sc = (tid & 15) * 8, vst0 = v_st(sr, sc), vst1 = v_st(32 + sr, sc);
  const int vb0 = (int)(uintptr_t)V_lds + v_rd_base(lane);
  struct { bf16x8 vs0, vs1, ks0, ks1; } sr_[2];
  const unsigned soff = (unsigned)(sr * ZP + sc) * 2u;
#define SLOAD(i, k0) do { const char* vp_ = (const char*)Vh + (size_t)(k0) * (ZP * 2); const char* kp_ = (const char*)Kh + (size_t)(k0) * (ZP * 2); \
    sr_[i].vs0 = *reinterpret_cast<const bf16x8*>(vp_ + soff); sr_[i].vs1 = *reinterpret_cast<const bf16x8*>(vp_ + 32 * ZP * 2 + soff); \
    sr_[i].ks0 = *reinterpret_cast<const bf16x8*>(kp_ + soff); sr_[i].ks1 = *reinterpret_cast<const bf16x8*>(kp_ + 32 * ZP * 2 + soff); } while (0)
#define SWRITE(b, i) do { *(bf16x8*)((char*)V_lds + (b) * SHM_V + vst0) = sr_[i].vs0;          \
    *(bf16x8*)((char*)V_lds + (b) * SHM_V + vst1) = sr_[i].vs1; int kc = sc * 2;               \
    *(bf16x8*)((char*)K_lds + (b) * SHM_K + KSWZ(sr, kc)) = sr_[i].ks0;                       \
    *(bf16x8*)((char*)K_lds + (b) * SHM_K + KSWZ(32 + sr, kc)) = sr_[i].ks1; } while (0)
#define SWAIT() asm volatile("s_waitcnt vmcnt(4)" ::: "memory")
#define RESC(a) do { if (__any((a) < 1.f)) { if (hi == 0) al_l[r32] = (a); asm volatile("s_waitcnt lgkmcnt(0)" ::: "memory"); \
    for (int d = 0; d < 4; ++d) for (int r = 0; r < 16; ++r) o[d][r] *= al_l[crow(r, hi)]; } } while (0)
  f32x16 pA0, pA1, pB0, pB1; float mnA, mnB, alA, alB; bf16x8 pa0, pa1, pa2, pa3; const int NT = seq / KVBLK;
  constexpr int SE = 0, SO = 1;
  SLOAD(SE, 0); asm volatile("s_waitcnt vmcnt(0)" ::: "memory"); SWRITE(0, SE); __syncthreads();
  qkt(pA0, pA1, K_lds, qr, r32, hi); partialSM(pA0, pA1, m_reg, mnA, alA);
  SLOAD(SO, KVBLK); if (2 < NT) SLOAD(SE, 2 * KVBLK);
  SWAIT(); SWRITE(1, SO); __syncthreads();
  for (int j = 1; j + 1 < NT; j += 2) {
    SBAR(); qkt(pB0, pB1, (bf16*)((char*)K_lds + SHM_K), qr, r32, hi);
    finishSM(pA0, pA1, alA, l_reg, pa0, pa1, pa2, pa3); SBAR();
    SLOAD(SO, (j + 2) * KVBLK); SBAR();
    pv_d0(o, vb0, pa0, pa1, pa2, pa3); partialSM(pB0, pB1, m_reg, mnB, alB);
    __syncthreads(); SWAIT(); SWRITE(0, SE);
    RESC(alB); __syncthreads();
    SBAR(); qkt(pA0, pA1, K_lds, qr, r32, hi);
    finishSM(pB0, pB1, alB, l_reg, pa0, pa1, pa2, pa3); SBAR();
    if (j + 3 < NT) SLOAD(SE, (j + 3) * KVBLK); SBAR();
    pv_d0(o, vb0 + (int)SHM_V, pa0, pa1, pa2, pa3); partialSM(pA0, pA1, m_reg, mnA, alA);
    __syncthreads(); SWAIT(); SWRITE(1, SO);
    RESC(alA); __syncthreads();
  }
  SBAR(); qkt(pB0, pB1, (bf16*)((char*)K_lds + SHM_K), qr, r32, hi);
  finishSM(pA0, pA1, alA, l_reg, pa0, pa1, pa2, pa3); SBAR();
  pv_d0(o, vb0, pa0, pa1, pa2, pa3); partialSM(pB0, pB1, m_reg, mnB, alB);
  __syncthreads(); RESC(alB);
  finishSM(pB0, pB1, alB, l_reg, pa0, pa1, pa2, pa3); SBAR();
  pv_d0(o, vb0 + (int)SHM_V, pa0, pa1, pa2, pa3);
  store_gated<ZP>(o, l_reg, li_l, (float*)(lds + ATT_OST_OFF) + wid * 2048, Gb, Yb, wid, lane, r32, hi);
#undef SLOAD
#undef SWRITE
#undef SWAIT
}

template <int MODE, int ZP>
__device__ __forceinline__ void local_unit(const bf16* Qb, const bf16* Kh, const bf16* Vh, const bf16* Gb, bf16* Yb, char* lds,
                                           int jlo, int jhi, int wlo, int whi, int pa, float fa, float fb, const float* rpbh) {
  int tid_ = threadIdx.x; asm volatile("" : "+v"(tid_));
  const int tid = tid_, wid = __builtin_amdgcn_readfirstlane(tid >> 6), lane = tid & 63, r32 = lane & 31, hi = lane >> 5;
  bf16* V_lds = (bf16*)lds; bf16* K_lds = (bf16*)(lds + 2 * SHM_V);
  float* ws = (float*)(lds + ATT_WS_OFF) + wid * 64; float* li_l = ws; float* al_l = ws + 32;
  float* tab = (float*)(lds + ATT_TAB_OFF);
  __syncthreads();
  if (MODE == 1) { for (int i = tid; i < 465; i += 512) tab[64 + i] = rpbh[i] * LOG2E; }
  float m_reg = -1e30f, l_reg = 0; f32x16 o[4] = {}; bf16x8 qr[8];
  { const unsigned qoff = (unsigned)((wid * QBLK + r32) * ZP + hi * 8) * 2u;
#pragma unroll
    for (int d0 = 0; d0 < 8; ++d0) qr[d0] = *reinterpret_cast<const bf16x8*>((const char*)Qb + qoff + d0 * 32); }
  const int sr = tid >> 4, sc = (tid & 15) * 8, vst0 = v_st(sr, sc), vst1 = v_st(32 + sr, sc);
  const int vb0 = (int)(uintptr_t)V_lds + v_rd_base(lane);
  bf16x8 vs0, vs1, ks0, ks1;
  const unsigned soff = (unsigned)(sr * ZP + sc) * 2u;
#define LLOAD(k0) do { const char* vp_ = (const char*)Vh + (size_t)(k0) * (ZP * 2); const char* kp_ = (const char*)Kh + (size_t)(k0) * (ZP * 2); \
    vs0 = *reinterpret_cast<const bf16x8*>(vp_ + soff); vs1 = *reinterpret_cast<const bf16x8*>(vp_ + 32 * ZP * 2 + soff); \
    ks0 = *reinterpret_cast<const bf16x8*>(kp_ + soff); ks1 = *reinterpret_cast<const bf16x8*>(kp_ + 32 * ZP * 2 + soff); } while (0)
#define LWRITE(b) do { *(bf16x8*)((char*)V_lds + (b) * SHM_V + vst0) = vs0; *(bf16x8*)((char*)V_lds + (b) * SHM_V + vst1) = vs1; int kc = sc * 2;               \
    *(bf16x8*)((char*)K_lds + (b) * SHM_K + KSWZ(sr, kc)) = ks0; *(bf16x8*)((char*)K_lds + (b) * SHM_K + KSWZ(32 + sr, kc)) = ks1; } while (0)
  constexpr float C = SCALE * LOG2E;
  const float NEG_INF = -__builtin_inff();
  int cq = 0, cs = 0, tq = 0;
  if (MODE == 1) { cq = 32 * (wid & 1) + r32; cs = cq - 8; cs = cs < 0 ? 0 : (cs > 48 ? 48 : cs); }
  else { tq = pa + wid * QBLK + r32; }
  LLOAD(jlo * KVBLK);
  for (int j = jlo; j < jhi; ++j) {
    const int b = (j - jlo) & 1;
    asm volatile("s_waitcnt vmcnt(0)" ::: "memory"); LWRITE(b);
    if (j + 1 < jhi) LLOAD((j + 1) * KVBLK);
    __syncthreads();
    if (j >= wlo && j < whi) {
      f32x16 p0, p1;
      qkt(p0, p1, (bf16*)((char*)K_lds + b * SHM_K), qr, r32, hi);
      if (MODE == 1) {
        const float* trow = tab + 64 + (j - pa + 7) * 31 + 15 + 4 * hi - cq;
        const int cb = 4 * hi - cs;
#pragma unroll
        for (int r = 0; r < 16; ++r) { const int kc0 = (r & 3) + 8 * (r >> 2);
          p0[r] = ((unsigned)(kc0 + cb) < 16u) ? fmaf(p0[r], C, trow[kc0]) : NEG_INF;
          p1[r] = ((unsigned)(kc0 + 32 + cb) < 16u) ? fmaf(p1[r], C, trow[kc0 + 32]) : NEG_INF; }
      } else {
        const int base = j * KVBLK + 4 * hi - tq;
#pragma unroll
        for (int r = 0; r < 16; ++r) { const int kc0 = (r & 3) + 8 * (r >> 2);
          const int d0 = kc0 + base, d1 = d0 + 32; const int a0 = d0 < 0 ? -d0 : d0, a1 = d1 < 0 ? -d1 : d1;
          p0[r] = (a0 <= 128) ? fmaf(p0[r], C, -fa * (float)a0) : NEG_INF;
          p1[r] = (a1 <= 128) ? fmaf(p1[r], C, -fa * (float)a1) : NEG_INF; }
      }
      float pmax = p0[0];
#pragma unroll
      for (int r = 1; r < 16; ++r) pmax = fmaxf(pmax, p0[r]);
#pragma unroll
      for (int r = 0; r < 16; ++r) pmax = fmaxf(pmax, p1[r]);
      { auto rr = __builtin_amdgcn_permlane32_swap(__float_as_uint(pmax), __float_as_uint(pmax), false, false);
        pmax = fmaxf(__uint_as_float(rr[0]), __uint_as_float(rr[1])); }
      const float mn = fmaxf(m_reg, pmax); const float alpha = __builtin_amdgcn_exp2f(m_reg - mn); m_reg = mn;
      float ps = 0.f;
#pragma unroll
      for (int r = 0; r < 16; ++r) { p0[r] = __builtin_amdgcn_exp2f(p0[r] - mn); p1[r] = __builtin_amdgcn_exp2f(p1[r] - mn); ps += p0[r] + p1[r]; }
      { auto rr = __builtin_amdgcn_permlane32_swap(__float_as_uint(ps), __float_as_uint(ps), false, false);
        ps = __uint_as_float(rr[0]) + __uint_as_float(rr[1]); }
      l_reg = l_reg * alpha + ps;
      RESC(alpha);
      bf16x8 pa0, pa1, pa2, pa3;
      pack_p(p0, p1, pa0, pa1, pa2, pa3);
      pv_d0(o, vb0 + b * (int)SHM_V, pa0, pa1, pa2, pa3);
    }
  }
  if (MODE == 2) l_reg += __builtin_amdgcn_exp2f(fb - m_reg);
  store_gated<ZP>(o, l_reg, li_l, (float*)(lds + ATT_OST_OFF) + wid * 2048, Gb, Yb, wid, lane, r32, hi);
#undef LLOAD
#undef LWRITE
#undef RESC
}
}
constexpr int NWAVES = 8;
constexpr int S = 8192, DM = 4096, HD = 128, DEPTH = 4;
constexpr int NIN_E = 13312, NIN_O = 10240;
constexpr int E_QA = 0, E_KA = 2048, E_VA = 2560, E_QB = 3072, E_KB = 5120, E_VB = 7168, E_G = 9216;
constexpr int O_Q = 0, O_K = 4096, O_V = 5120, O_G = 6144;
constexpr float NORM_EPS = 1e-6f;
constexpr size_t MiB = 1u << 20;
constexpr size_t WS_CTL = 0, CTL_ZERO_BYTES = 1 * MiB;
constexpr size_t WS_ROPE = 1 * MiB;
constexpr size_t WS_PART = 2 * MiB;
constexpr size_t WS_WIN_E = 8 * MiB, WIN_E_BYTES = (size_t)NIN_E * DM * 2;
constexpr size_t WS_WIN_O = WS_WIN_E + 2 * WIN_E_BYTES, WIN_O_BYTES = (size_t)NIN_O * DM * 2;
constexpr size_t WS_WOUT_E = WS_WIN_O + 2 * WIN_O_BYTES, WOUT_BYTES = (size_t)DM * DM * 2;
constexpr size_t WS_WOUT_O = WS_WOUT_E + 2 * WOUT_BYTES;
constexpr size_t WS_XB = WS_WOUT_O + 2 * WOUT_BYTES;
constexpr size_t WS_Y = WS_XB + (size_t)S * DM * 2;
constexpr size_t WS_Z = WS_Y + (size_t)S * DM * 2;
constexpr size_t WS_END = WS_Z + (size_t)S * NIN_E * 2;
constexpr int CW_BAR = 4096;
constexpr int RING_OFF = 0, RING_BYTES = 131072;
constexpr int LDSCTL_OFF = 143360, MISC_OFF = LDSCTL_OFF + 320;
constexpr int LDS_BYTES = 147456;
static_assert(MISC_OFF + 128 <= LDS_BYTES && att::ATT_LDS_BYTES <= LDSCTL_OFF && RING_BYTES <= LDSCTL_OFF, "LDS map");

#define GAS __attribute__((address_space(1)))
#define LAS __attribute__((address_space(3)))
typedef unsigned short bf16;
typedef unsigned v4u __attribute__((ext_vector_type(4)));
typedef float f32x4 __attribute__((ext_vector_type(4)));
typedef GAS unsigned gu32;
#define LDS_WAIT() asm volatile("s_waitcnt lgkmcnt(0)" ::: "memory")
#define VM_WAIT() asm volatile("s_waitcnt vmcnt(0)" ::: "memory")
__device__ __forceinline__ unsigned pk2(float lo, float hi) { unsigned r; asm volatile("v_cvt_pk_bf16_f32 %0, %1, %2" : "=v"(r) : "v"(lo), "v"(hi)); return r; }
#define XB_TMO      128
#define XB_XCNT(j)  (256  + 64 * (j))
#define XB_XSUB(j)  (1280 + 64 * (j))
#define XB_XGEN(j)  (2304 + 64 * (j))
#define XB_TOP      3328
#define XB_TOPGEN   3392
#define XCD_BAR_WORDS 3456
#define XB_SPIN_CAP (1u << 18)

__device__ __forceinline__ unsigned xb_ld(unsigned* p)              { return __hip_atomic_load(p, __ATOMIC_RELAXED, __HIP_MEMORY_SCOPE_AGENT); }
__device__ __forceinline__ unsigned xb_add(unsigned* p, unsigned v) { return __hip_atomic_fetch_add(p, v, __ATOMIC_RELAXED, __HIP_MEMORY_SCOPE_AGENT); }
__device__ __forceinline__ unsigned xb_xcc_id() { return (unsigned)__builtin_amdgcn_s_getreg((3 << 11) | 20) & 0xFu; }
#define XB_SPIN(cond, bar) do { unsigned _sp = 0; while (cond) { __builtin_amdgcn_s_sleep(1); \
    if ((++_sp & 255u) == 0u) { if (xb_ld(&(bar)[XB_TMO])) break; if (_sp > XB_SPIN_CAP) { atomicAdd(&(bar)[XB_TMO], 1u); break; } } } } while (0)

struct XcdBarrier {
    unsigned* bar; unsigned x;
    volatile LAS unsigned* st;
};

__device__ __forceinline__ XcdBarrier xcd_barrier_post(unsigned* bar, volatile LAS unsigned* st) {
    XcdBarrier b; b.bar = bar; b.x = xb_xcc_id(); b.st = st;
    if (threadIdx.x == 0) (void)xb_add(&bar[XB_XCNT(b.x)], 1u);
    return b;
}
__device__ __forceinline__ void xcd_barrier_complete(unsigned* bar, unsigned x, unsigned& nloc, unsigned& nx) {
    const unsigned G = gridDim.x * gridDim.y * gridDim.z;
    unsigned sum, cnt, mine, sp = 0u;
    for (;;) {
        sum = 0u; cnt = 0u; mine = 0u;
#pragma unroll
        for (unsigned j = 0; j < 16; ++j) { const unsigned c = xb_ld(&bar[XB_XCNT(j)]); sum += c; cnt += (c > 0u) ? 1u : 0u; mine = (j == x) ? c : mine; }
        if (sum == G) break;
        __builtin_amdgcn_s_sleep(1);
        if ((++sp & 255u) == 0u) { if (xb_ld(&bar[XB_TMO])) break; if (sp > XB_SPIN_CAP) { atomicAdd(&bar[XB_TMO], 1u); break; } }
    }
    nloc = mine > 0u ? mine : 1u; nx = cnt > 0u ? cnt : 1u;
}

__device__ __forceinline__ void xcd_barrier(const XcdBarrier& b) {
    asm volatile("s_waitcnt vmcnt(0)" ::: "memory");
    __syncthreads();
    if (threadIdx.x == 0) {
        unsigned* bar = b.bar;
        __builtin_amdgcn_s_waitcnt(0);
        unsigned nloc = b.st[0], nx = b.st[1];
        if (nloc == 0u) { xcd_barrier_complete(bar, b.x, nloc, nx); b.st[0] = nloc; b.st[1] = nx; }
        const unsigned old = xb_add(&bar[XB_XSUB(b.x)], 1u);
        const unsigned gen = old / nloc;
        if (old + 1u == (gen + 1u) * nloc) {
            __builtin_amdgcn_fence(__ATOMIC_RELEASE, "agent");
            asm volatile("s_waitcnt vmcnt(0)" ::: "memory");
            const unsigned og = xb_add(&bar[XB_TOP], 1u);
            const unsigned tg = og / nx;
            if (og + 1u == (tg + 1u) * nx) xb_add(&bar[XB_TOPGEN], 1u);
            else XB_SPIN(xb_ld(&bar[XB_TOPGEN]) == tg, bar);
            __builtin_amdgcn_fence(__ATOMIC_ACQUIRE, "agent");
            xb_add(&bar[XB_XGEN(b.x)], 1u);
            asm volatile("s_waitcnt vmcnt(0)" ::: "memory");
        } else {
            XB_SPIN(xb_ld(&bar[XB_XGEN(b.x)]) == gen, bar);
            __builtin_amdgcn_fence(__ATOMIC_ACQUIRE, "agent");
            asm volatile("s_waitcnt vmcnt(0)" ::: "memory");
        }
    }
    __syncthreads();
}
struct Frame {
    LAS unsigned char* lds;
    volatile LAS unsigned* MISC;
    gu32* ctl;
    int tid, lane, wave;
    int vcu, G;
};
__device__ __forceinline__ float wave_sum(float v) {
#pragma unroll
    for (int o = 1; o < 64; o <<= 1) v += __shfl_xor(v, o);
    return v;
}
__device__ __forceinline__ void transpose_item(const float* W, int N, const float* kscale, bf16* WT, LAS float* scr, int item, int lane) {
    const int nnb = N >> 6, kb = item / nnb, nb = item - kb * nnb, k0 = kb << 6, n0 = nb << 6;
    const int lr = lane >> 4, lc = (lane & 15) << 2;
    f32x4 v[16];
#pragma unroll
    for (int i = 0; i < 16; ++i) v[i] = *(const f32x4*)(W + (size_t)(k0 + 4 * i + lr) * N + n0 + lc);
#pragma unroll
    for (int i = 0; i < 16; ++i) { const int k = 4 * i + lr; const float s = kscale ? kscale[k0 + k] : 1.0f;
        *(LAS f32x4*)(scr + k * 64 + (lc ^ (((k >> 3) & 3) << 3))) = v[i] * s; }
    LDS_WAIT(); asm volatile("" ::: "memory");
    const int c = lane & 7, nn = lane >> 3, f = (c & 3) << 3;
#pragma unroll
    for (int j = 0; j < 8; ++j) { const int n = nn + 8 * j; const LAS float* s = scr + (8 * c) * 64 + (n ^ f);
        v4u o; o.x = pk2(s[0 * 64], s[1 * 64]); o.y = pk2(s[2 * 64], s[3 * 64]); o.z = pk2(s[4 * 64], s[5 * 64]); o.w = pk2(s[6 * 64], s[7 * 64]);
        *(GAS v4u*)(WT + (size_t)(n0 + n) * DM + k0 + 8 * c) = o; }
    LDS_WAIT(); asm volatile("" ::: "memory");
}

struct Args { const float* in[11]; float* out; unsigned char* ws; int ph_lo, ph_hi; };
constexpr int PH_FINAL = 1 + 4 * DEPTH, PH_END = PH_FINAL + 1;

__global__ void __launch_bounds__(NWAVES * 64, 2) mk_fwd(Args args) {
    extern __shared__ __attribute__((aligned(16))) unsigned char lds[];
    Frame F;
    F.lds = (LAS unsigned char*)lds;
    F.MISC = (volatile LAS unsigned*)(F.lds + MISC_OFF);
    F.tid = threadIdx.x; F.lane = F.tid & 63; F.wave = __builtin_amdgcn_readfirstlane(F.tid >> 6);
    F.G = gridDim.x; { const int bx = blockIdx.x; F.vcu = (F.G % 8 == 0) ? (bx % 8) * (F.G / 8) + bx / 8 : bx; }
    unsigned char* ws = args.ws;
    F.ctl = (gu32*)(ws + WS_CTL);
    for (int u = F.tid; u < (LDS_BYTES - LDSCTL_OFF) / 4; u += NWAVES * 64) ((LAS unsigned*)(F.lds + LDSCTL_OFF))[u] = 0u;
    __syncthreads();
    const int lo = args.ph_lo, hi = args.ph_hi;
    const bool use_bar = (hi - lo) > 1;
    XcdBarrier bar; bar.bar = (unsigned*)(F.ctl + CW_BAR); bar.x = 0; bar.st = nullptr;
    if (use_bar) bar = xcd_barrier_post((unsigned*)(F.ctl + CW_BAR), F.MISC + 8);
#define IN(k) (lo <= (k) && (k) < hi)
#define SEAM(k) do { if (IN(k) && IN((k) + 1)) xcd_barrier(bar); } while (0)

    const float* x_in = args.in[0];
    float* X = args.out;
    float* PART = (float*)(ws + WS_PART);
    bf16* XB = (bf16*)(ws + WS_XB); bf16* Y = (bf16*)(ws + WS_Y); bf16* Z = (bf16*)(ws + WS_Z);
    float* ROPE = (float*)(ws + WS_ROPE);
    const int gw = F.vcu * NWAVES + F.wave, NGW = F.G * NWAVES;

    if (IN(0)) {
        LAS float* scr = (LAS float*)(F.lds + RING_OFF + F.wave * 16384);
        constexpr int I_INE = 64 * (NIN_E / 64), I_INO = 64 * (NIN_O / 64), I_OUT = 64 * (DM / 64);
        constexpr int NITEMS = 2 * I_INE + 2 * I_INO + 4 * I_OUT;
        for (int it = gw; it < NITEMS; it += NGW) {
            int r = it;
            if (r < 2 * I_INE) { const int e = r / I_INE; r -= e * I_INE;
                transpose_item(args.in[2] + (size_t)e * DM * NIN_E, NIN_E, args.in[1] + (2 * e) * DM, (bf16*)(ws + WS_WIN_E + e * WIN_E_BYTES), scr, r, F.lane); continue; }
            r -= 2 * I_INE;
            if (r < 2 * I_INO) { const int e = r / I_INO; r -= e * I_INO;
                transpose_item(args.in[7] + (size_t)e * DM * NIN_O, NIN_O, args.in[1] + (2 * e + 1) * DM, (bf16*)(ws + WS_WIN_O + e * WIN_O_BYTES), scr, r, F.lane); continue; }
            r -= 2 * I_INO;
            if (r < 2 * I_OUT) { const int e = r / I_OUT; r -= e * I_OUT;
                transpose_item(args.in[3] + (size_t)e * DM * DM, DM, nullptr, (bf16*)(ws + WS_WOUT_E + e * WOUT_BYTES), scr, r, F.lane); continue; }
            r -= 2 * I_OUT;
            { const int e = r / I_OUT; r -= e * I_OUT;
                transpose_item(args.in[8] + (size_t)e * DM * DM, DM, nullptr, (bf16*)(ws + WS_WOUT_O + e * WOUT_BYTES), scr, r, F.lane); }
        }
        for (int m = gw; m < S; m += NGW) {
            const GAS f32x4* xr = (const GAS f32x4*)(x_in + (size_t)m * DM) + F.lane;
            GAS unsigned long long* o8 = (GAS unsigned long long*)(XB + (size_t)m * DM) + F.lane;
            float ss = 0.f;
#pragma unroll
            for (int j = 0; j < 16; ++j) { const f32x4 v = xr[64 * j]; ss += (v.x * v.x + v.y * v.y) + (v.z * v.z + v.w * v.w);
                o8[64 * j] = (unsigned long long)pk2(v.x, v.y) | ((unsigned long long)pk2(v.z, v.w) << 32); }
            ss = wave_sum(ss);
            PART[(size_t)m * 64 + F.lane] = F.lane == 0 ? ss : 0.f;
        }
        for (int i = blockIdx.x * 512 + F.tid; i < 128 * 32; i += F.G * 512) {
            const int p = i >> 5, k = i & 31;
            double inv = 1.0; for (int q = 0; q < k; ++q) inv *= 0.7498942093324558;
            const double ang = (double)p * inv, n = __builtin_rint(ang * 0.6366197723675814);
            double r = __builtin_fma(-n, 1.5707963267948966, ang); r = __builtin_fma(-n, 6.123233995736766e-17, r);
            const double r2 = r * r;
            double sp = 2.8114572543455206e-15; sp = sp * r2 - 7.647163731819816e-13; sp = sp * r2 + 1.6059043836821613e-10; sp = sp * r2 - 2.505210838544172e-08; sp = sp * r2 + 2.7557319223985893e-06;
            sp = sp * r2 - 0.0001984126984126984; sp = sp * r2 + 0.008333333333333333; sp = sp * r2 - 0.16666666666666666; sp = sp * r2 + 1.0; sp *= r;
            double cp = 1.5619206968586225e-16; cp = cp * r2 - 4.779477332387385e-14; cp = cp * r2 + 1.1470745597729725e-11; cp = cp * r2 - 2.08767569878681e-09; cp = cp * r2 + 2.755731922398589e-07;
            cp = cp * r2 - 2.48015873015873e-05; cp = cp * r2 + 0.001388888888888889; cp = cp * r2 - 0.041666666666666664; cp = cp * r2 + 0.5; cp = 1.0 - cp * r2;
            const int q4 = (int)n & 3;
            const double cv = q4 == 0 ? cp : (q4 == 1 ? -sp : (q4 == 2 ? -cp : sp)), sv = q4 == 0 ? sp : (q4 == 1 ? cp : (q4 == 2 ? -sp : -cp));
            ROPE[2 * i] = (float)cv; ROPE[2 * i + 1] = (float)sv;
        }
    }
    SEAM(0);

    for (int L = 0; L < DEPTH; ++L) {
        const int e = L >> 1; const bool even = (L & 1) == 0;
        const int NIN = even ? NIN_E : NIN_O;
        const int pb = 1 + 4 * L;
        if (IN(pb)) {
            const bf16* Wt = (const bf16*)(ws + (even ? WS_WIN_E + e * WIN_E_BYTES : WS_WIN_O + e * WIN_O_BYTES));
            pg8::Gemm g{XB, Wt, S, NIN, DM}; pg8::StaticOrder So; So.init(S, NIN, F.G, (int)blockIdx.x);
            pg8::EpiIn E{Z, NIN, PART};
#ifndef NO_GEMM_IN
            pg8::gemm_phase<pg8::EpiIn, pg8::StaticOrder, true, true>(F.lds + RING_OFF, g, So, E);
#endif
        }
        SEAM(pb);
        if (IN(pb + 1) && even) {
            const float* qn = args.in[4] + e * HD; const float* kn = args.in[5] + e * HD;
            int ln = F.lane; asm volatile("" : "+v"(ln));
            const int sub = ln >> 5, half = (ln >> 4) & 1, i0 = 2 * (ln & 15);
            for (int it = gw; it < S * 10; it += NGW) {
                const int t = it / 10, hp = it - t * 10, head = 2 * hp + sub;
                bf16* base = Z + (size_t)t * NIN_E + head * HD + 64 * half + i0;
                const unsigned a = *(const unsigned*)base, b = *(const unsigned*)(base + 32);
                float x1a = __uint_as_float(a << 16), x1b = __uint_as_float(a & 0xffff0000u), x2a = __uint_as_float(b << 16), x2b = __uint_as_float(b & 0xffff0000u);
                float ss = (x1a * x1a + x1b * x1b) + (x2a * x2a + x2b * x2b);
#pragma unroll
                for (int o = 1; o < 32; o <<= 1) ss += __shfl_xor(ss, o);
                const float rs = 1.0f / sqrtf(ss * (1.0f / 128.0f) + NORM_EPS);
                const float* w = (head < 16 ? qn : kn) + 64 * half + i0;
                x1a *= rs * w[0]; x1b *= rs * w[1]; x2a *= rs * w[32]; x2b *= rs * w[33];
                const int p = half ? (t & 63) : (t >> 6);
                const f32x4 cs = *(const f32x4*)(ROPE + (size_t)(p * 32 + i0) * 2);
                const float o1a = x1a * cs.x - x2a * cs.y, o2a = x2a * cs.x + x1a * cs.y, o1b = x1b * cs.z - x2b * cs.w, o2b = x2b * cs.z + x1b * cs.w;
                *(unsigned*)base = pk2(o1a, o1b); *(unsigned*)(base + 32) = pk2(o2a, o2b);
            }
        }
        if (even) SEAM(pb + 1);
        if (IN(pb + 2)) {
            const int xcd = (int)blockIdx.x & 7, slot = (int)blockIdx.x >> 3;
            char* al = (char*)lds + RING_OFF;
            if (even) {
                for (int u = (int)blockIdx.x; u < 512; u += F.G) {
                    const int h = (u / 256) * 8 + (u & 7), qb = (u & 255) >> 3, kvh = h >> 2;
                    const bf16* Zq = Z + (size_t)(qb * 256) * NIN_E;
#ifndef NO_DENSE
                    att::dense_unit<NIN_E>(Zq + E_QA + h * HD, Z + E_KA + kvh * HD, Z + E_VA + kvh * HD, Zq + E_G + h * HD, Y + (size_t)(qb * 256) * DM + h * HD, S, al);
#endif
                }
                for (int u = (int)blockIdx.x; u < 512; u += F.G) {
                    const int h = (u / 256) * 8 + (u & 7), blk = (u & 255) >> 3;
                    const int r0 = 4 * blk, rw = r0 + (F.wave >> 1);
                    int jlo = r0 - 4; jlo = jlo < 0 ? 0 : (jlo > 120 ? 120 : jlo);
                    int jh = r0 + 3 - 4; jh = jh < 0 ? 0 : (jh > 120 ? 120 : jh); jh += 8;
                    int wlo = rw - 4; wlo = wlo < 0 ? 0 : (wlo > 120 ? 120 : wlo);
                    const bf16* Zq = Z + (size_t)(blk * 256) * NIN_E;
#ifndef NO_NA
                    att::local_unit<1, NIN_E>(Zq + E_QB + h * HD, Z + E_KB + h * HD, Z + E_VB + h * HD, Zq + E_G + 2048 + h * HD, Y + (size_t)(blk * 256) * DM + 2048 + h * HD, al,
                                              jlo, jh, wlo, wlo + 8, rw, 0.f, 0.f, args.in[6] + ((size_t)e * 16 + h) * 465);
#endif
                }
                (void)xcd; (void)slot;
            } else {
                for (int u = (int)blockIdx.x; u < 1024; u += F.G) {
                    const int h = (u / 256) * 8 + (u & 7), qb = (u & 255) >> 3, kvh = h >> 2, i0 = qb * 256, q0 = i0 + F.wave * 32;
                    int klo = i0 - 128; klo = klo < 0 ? 0 : klo; int khi = i0 + 256 + 128; khi = khi > S ? S : khi;
                    int wl = q0 - 128; wl = wl < 0 ? 0 : wl; int wh = q0 + 31 + 128; wh = wh > S - 1 ? S - 1 : wh;
                    const float slope = exp2f(-8.0f * (float)(h + 1) / 32.0f);
                    const bf16* Zq = Z + (size_t)i0 * NIN_O;
#ifndef NO_WIN
                    att::local_unit<2, NIN_O>(Zq + O_Q + h * HD, Z + O_K + kvh * HD, Z + O_V + kvh * HD, Zq + O_G + h * HD, Y + (size_t)i0 * DM + h * HD, al,
                                              klo >> 6, khi >> 6, wl >> 6, (wh >> 6) + 1, i0, slope * att::LOG2E, args.in[9][e * 32 + h] * att::LOG2E, nullptr);
#endif
                }
            }
        }
        SEAM(pb + 2);
        if (IN(pb + 3)) {
            const bf16* Wt = (const bf16*)(ws + (even ? WS_WOUT_E : WS_WOUT_O) + e * WOUT_BYTES);
            pg8::Gemm g{Y, Wt, S, DM, DM}; pg8::StaticOrder So; So.init(S, DM, F.G, (int)blockIdx.x);
            pg8::EpiOut E{L == 0 ? x_in : X, X, XB, PART};
#ifndef NO_GEMM_OUT
            pg8::gemm_phase<pg8::EpiOut, pg8::StaticOrder, true, true>(F.lds + RING_OFF, g, So, E);
#endif
        }
        SEAM(pb + 3);
    }
    if (IN(PH_FINAL)) {
        const float* fw = args.in[10];
        for (int m = gw; m < S; m += NGW) {
            GAS f32x4* xr = (GAS f32x4*)(X + (size_t)m * DM) + F.lane;
            f32x4 v[16]; float ss = 0.f;
#pragma unroll
            for (int j = 0; j < 16; ++j) { v[j] = xr[64 * j]; ss += (v[j].x * v[j].x + v[j].y * v[j].y) + (v[j].z * v[j].z + v[j].w * v[j].w); }
            const float rs = 1.0f / sqrtf(wave_sum(ss) * (1.0f / DM) + NORM_EPS);
#pragma unroll
            for (int j = 0; j < 16; ++j) { const f32x4 w = ((const f32x4*)fw)[64 * j + F.lane]; xr[64 * j] = v[j] * rs * w; }
        }
    }
#undef IN
#undef SEAM
}

#ifndef MK_SPLIT
#define MK_SPLIT 0
#endif
extern "C" void kernel_launch(void* const* d_in, const int* in_sizes, int n_in, void* d_out, int out_size, void* d_ws, size_t ws_size, hipStream_t stream) {
    static int grid = 0;
    if (grid == 0) {
        if (n_in != 11 || in_sizes[0] != S * DM || out_size != S * DM || ws_size < WS_END) {
            fprintf(stderr, "kernel_launch: shape mismatch: n_in %d in0 %d out %d ws %zu (need %zu)\n", n_in, n_in > 0 ? in_sizes[0] : -1, out_size, ws_size, (size_t)WS_END); grid = -1; return; }
        int dev = 0, cus = 0, per_cu = 0;
        if (hipGetDevice(&dev) != hipSuccess || hipDeviceGetAttribute(&cus, hipDeviceAttributeMultiprocessorCount, dev) != hipSuccess) { grid = -1; return; }
        if (hipFuncSetAttribute((const void*)mk_fwd, hipFuncAttributeMaxDynamicSharedMemorySize, LDS_BYTES) != hipSuccess) { fprintf(stderr, "kernel_launch: hipFuncSetAttribute failed\n"); grid = -1; return; }
        if (hipOccupancyMaxActiveBlocksPerMultiprocessor(&per_cu, (const void*)mk_fwd, NWAVES * 64, LDS_BYTES) != hipSuccess || per_cu < 1)
            fprintf(stderr, "kernel_launch: note: occupancy query reports %d workgroups per CU\n", per_cu);
        (void)hipGetLastError();
        grid = cus;
    }
    if (grid < 0) return;
    if (hipMemsetAsync((char*)d_ws + WS_CTL, 0, CTL_ZERO_BYTES, stream) != hipSuccess) { fprintf(stderr, "kernel_launch: memset failed\n"); return; }
    Args a{};
    for (int i = 0; i < 11; ++i) a.in[i] = (const float*)d_in[i];
    a.out = (float*)d_out; a.ws = (unsigned char*)d_ws;
#if MK_SPLIT
    for (int p = 0; p < PH_END; ++p) { a.ph_lo = p; a.ph_hi = p + 1; hipLaunchKernelGGL(mk_fwd, dim3(grid), dim3(NWAVES * 64), LDS_BYTES, stream, a); }
#else
    a.ph_lo = 0; a.ph_hi = PH_END;
    hipLaunchKernelGGL(mk_fwd, dim3(grid), dim3(NWAVES * 64), LDS_BYTES, stream, a);
#endif
    const hipError_t le = hipPeekAtLastError();
    if (le != hipSuccess) fprintf(stderr, "kernel_launch: launch failed: %s\n", hipGetErrorName(le));
}
```

```cpp
#include <hip/hip_runtime.h>
#include <cstdio>
#include <cstdint>
namespace pg8 {
#define PG8_LAS __attribute__((address_space(3)))
typedef unsigned short bf16_t;
typedef short bf16x8 __attribute__((ext_vector_type(8)));
typedef float f32x4 __attribute__((ext_vector_type(4)));
typedef unsigned u32x4 __attribute__((ext_vector_type(4)));
constexpr int BM = 256, BK = 64, HALF = 128, HTB = HALF * BK * 2  , STAGE_BYTES = 8 * HTB, NXCD = 8, WGM = 8;

__host__ __device__ __forceinline__ int lds_byte(int r, int c) { const int st = (r >> 4) * 2 + (c >> 5), rr = r & 15, cc = c & 31, ob = rr * 64 + cc * 2; return st * 1024 + (ob ^ (((ob >> 9) & 1) << 5)); }
__host__ __device__ __forceinline__ void stage_rc(int b, int& R, int& C) { const int st = b / 1024, sb = b % 1024, swz = sb ^ (((sb >> 9) & 1) << 5); R = (st >> 1) * 16 + swz / 64; C = (st & 1) * 32 + (swz % 64) / 2; }
__host__ __device__ __forceinline__ int perm32(int rho) { const int n = rho >> 4, i = rho & 15; return 8 * (i >> 2) + 4 * n + (i & 3); }

struct Unit { int pm, pn; };
struct Gemm { const bf16_t* A; const bf16_t* Bt; int M, N, K; };

struct StaticOrder {
    int nM, nN, nwg, G, c;
    __host__ __device__ void init(int M, int N, int G_, int c_) { nM = M / BM; nN = N / BM; nwg = nM * nN; G = G_; c = c_; }
    __host__ __device__ bool next(int i, Unit& u) const {
        const long L = (long)i * G + c; if (L >= nwg) return false;
        int wgid = (int)L; { const int q = nwg / NXCD, r = nwg % NXCD, xcd = wgid % NXCD, off = wgid / NXCD; wgid = (xcd < r ? xcd * (q + 1) : r * (q + 1) + (xcd - r) * q) + off; }
        const int nig = WGM * nN, gid = wgid / nig, fm = gid * WGM, gsz = (nM - fm) < WGM ? (nM - fm) : WGM;
        u.pm = fm + ((wgid % nig) % gsz); u.pn = (wgid % nig) / gsz; return true;
    }
    __device__ __forceinline__ void a_ready(const Unit&) const {}
    __device__ __forceinline__ void done(const Unit&) const {}
};

__device__ __forceinline__ unsigned cvt_pk_bf16(float lo, float hi) { unsigned r; asm volatile("v_cvt_pk_bf16_f32 %0, %1, %2" : "=v"(r) : "v"(lo), "v"(hi)); return r; }
typedef float f32x2 __attribute__((ext_vector_type(2)));
struct EpiIn {
    static constexpr bool PERM = true, AFTER_DRAIN = false;
    bf16_t* Z; int ldz; const PG8_LAS float* rstd;
    __device__ __forceinline__ void operator()(const f32x4 (&acc)[2][2][4][2], const Unit& u, int wr, int wc, int fr, int fq) const {
        const int row0 = u.pm * BM + wr * 64 + fr, col0 = u.pn * BM + wc * 32 + 8 * fq;
        float rs[2][4];
#pragma unroll
        for (int ai = 0; ai < 2; ++ai)
#pragma unroll
            for (int m = 0; m < 4; ++m) rs[ai][m] = rstd[ai * HALF + wr * 64 + m * 16 + fr];
#pragma unroll
        for (int ai = 0; ai < 2; ++ai)
#pragma unroll
            for (int m = 0; m < 4; ++m) {
                bf16_t* rowp = Z + (size_t)(row0 + ai * HALF + m * 16) * ldz + col0;
#pragma unroll
                for (int bj = 0; bj < 2; ++bj) { const f32x4 v0 = acc[ai][bj][m][0] * rs[ai][m], v1 = acc[ai][bj][m][1] * rs[ai][m];
                    u32x4 w; w.x = cvt_pk_bf16(v0[0], v0[1]); w.y = cvt_pk_bf16(v0[2], v0[3]); w.z = cvt_pk_bf16(v1[0], v1[1]); w.w = cvt_pk_bf16(v1[2], v1[3]);
                    *(u32x4*)(rowp + bj * HALF) = w; }
            }
    }
};
struct EpiOut {
    static constexpr bool PERM = true, AFTER_DRAIN = false;
    const float* Xold; float* Xnew; bf16_t* XB; float* part;
    __device__ __forceinline__ void operator()(const f32x4 (&acc)[2][2][4][2], const Unit& u, int wr, int wc, int fr, int fq) const {
        const int row0 = u.pm * BM + wr * 64 + fr, col0 = u.pn * BM + wc * 32 + 8 * fq;
        f32x4 xs[2][2][2][2];
#define EO_LD(slot, g) do { _Pragma("unroll") for (int mi = 0; mi < 2; ++mi) _Pragma("unroll") for (int bj = 0; bj < 2; ++bj) { \
            const size_t off = (size_t)(row0 + ((g) >> 1) * HALF + (((g) & 1) * 2 + mi) * 16) * 4096 + col0 + bj * HALF; \
            xs[slot][mi][bj][0] = *(const f32x4*)(Xold + off); xs[slot][mi][bj][1] = *(const f32x4*)(Xold + off + 4); } } while (0)
#define EO_PR(slot, g) do { _Pragma("unroll") for (int mi = 0; mi < 2; ++mi) { const int ai = (g) >> 1, m = ((g) & 1) * 2 + mi; const int row = row0 + ai * HALF + m * 16; float ss = 0.f; \
            _Pragma("unroll") for (int bj = 0; bj < 2; ++bj) { const size_t off = (size_t)row * 4096 + col0 + bj * HALF; \
                const f32x4 x0 = xs[slot][mi][bj][0] + acc[ai][bj][m][0], x1 = xs[slot][mi][bj][1] + acc[ai][bj][m][1]; \
                *(f32x4*)(Xnew + off) = x0; *(f32x4*)(Xnew + off + 4) = x1; \
                u32x4 w; w.x = cvt_pk_bf16(x0[0], x0[1]); w.y = cvt_pk_bf16(x0[2], x0[3]); w.z = cvt_pk_bf16(x1[0], x1[1]); w.w = cvt_pk_bf16(x1[2], x1[3]); \
                *(u32x4*)(XB + off) = w; \
                ss += ((x0[0] * x0[0] + x0[1] * x0[1]) + (x0[2] * x0[2] + x0[3] * x0[3])) + ((x1[0] * x1[0] + x1[1] * x1[1]) + (x1[2] * x1[2] + x1[3] * x1[3])); } \
            ss += __shfl_xor(ss, 16); ss += __shfl_xor(ss, 32); \
            if (fq == 0) part[(size_t)row * 64 + u.pn * 4 + wc] = ss; } } while (0)
        EO_LD(0, 0); EO_LD(1, 1); asm volatile("" ::: "memory");
        EO_PR(0, 0); asm volatile("" ::: "memory"); EO_LD(0, 2); asm volatile("" ::: "memory");
        EO_PR(1, 1); asm volatile("" ::: "memory"); EO_LD(1, 3); asm volatile("" ::: "memory");
        EO_PR(0, 2); EO_PR(1, 3);
#undef EO_LD
#undef EO_PR
    }
};
template <class Epi, class Sched, bool ALIGN_EPI = false, bool SP2 = false>
__device__ __forceinline__ void gemm_phase(PG8_LAS unsigned char* lds, const Gemm g, const Sched& S, const Epi& E) {
    int tid_ = threadIdx.x; asm volatile("" : "+v"(tid_));
    const int tid = tid_, wid = __builtin_amdgcn_readfirstlane(tid >> 6), lane = tid & 63, wr = wid >> 2, wc = wid & 3, fr = lane & 15, fq = lane >> 4;
    const int K = g.K, nt = K / BK;
    unsigned voffA[2], voffB[2];
#pragma unroll
    for (int i = 0; i < 2; ++i) { int R, C; stage_rc(tid * 16 + i * 8192, R, C); const int Rb = Epi::PERM ? ((R & ~31) + perm32(R & 31)) : R;
        voffA[i] = (unsigned)(R * K + C) * 2u; voffB[i] = (unsigned)(Rb * K + C) * 2u; }
    const size_t kstep = (size_t)(BK * 2);
    const size_t hstep = (size_t)HALF * K * 2;
    const size_t tstep = 2 * hstep;
    const unsigned ldsw = (unsigned)wid * 1024u;
    const int aoff = lds_byte(wr * 64 + fr, fq * 8), boff = lds_byte(wc * 32 + fr, fq * 8);
#define PG8_SA(b, h) (((b) * 2 + (h)) * HTB)
#define PG8_SB(b, h) ((4 + (b) * 2 + (h)) * HTB)
#define PG8_STAGE(bufoff, gbase, voff) do { _Pragma("unroll") for (int _i = 0; _i < 2; ++_i) \
        __builtin_amdgcn_global_load_lds((const unsigned*)((const char*)(gbase) + (voff)[_i]), (PG8_LAS unsigned*)(lds + (bufoff) + ldsw + _i * 8192), 16, 0, 0); } while (0)
#define PG8_LDA(dst, b, h) do { _Pragma("unroll") for (int m = 0; m < 4; ++m) _Pragma("unroll") for (int k = 0; k < 2; ++k) dst[m][k] = *(const PG8_LAS bf16x8*)(lds + PG8_SA(b, h) + aoff + m * 2048 + k * 1024); } while (0)
#define PG8_LDB(dst, b, h) do { _Pragma("unroll") for (int n = 0; n < 2; ++n) _Pragma("unroll") for (int k = 0; k < 2; ++k) dst[n][k] = *(const PG8_LAS bf16x8*)(lds + PG8_SB(b, h) + boff + n * 2048 + k * 1024); } while (0)
#define PG8_MMA(ai, bj, At, Bt) do { __builtin_amdgcn_s_setprio(1); _Pragma("unroll") for (int m = 0; m < 4; ++m) _Pragma("unroll") for (int n = 0; n < 2; ++n) _Pragma("unroll") for (int k = 0; k < 2; ++k) \
        acc[ai][bj][m][n] = __builtin_amdgcn_mfma_f32_16x16x32_bf16(Bt[n][k], At[m][k], acc[ai][bj][m][n], 0, 0, 0); __builtin_amdgcn_s_setprio(0); } while (0)
#define PG8_WAIT_V(n) asm volatile("s_waitcnt vmcnt(" #n ")" ::: "memory")
#define PG8_WAIT_L(n) asm volatile("s_waitcnt lgkmcnt(" #n ")" ::: "memory")
#define PG8_BAR __builtin_amdgcn_s_barrier()
#define PG8_SCHED __builtin_amdgcn_sched_barrier(0)
    Unit cur, nxt; int ui = 0;
    if (!S.next(0, cur)) return;
    f32x4 acc[2][2][4][2];
#pragma unroll
    for (int a = 0; a < 2; ++a)
#pragma unroll
        for (int b = 0; b < 2; ++b)
#pragma unroll
            for (int m = 0; m < 4; ++m)
#pragma unroll
                for (int n = 0; n < 2; ++n) acc[a][b][m][n] = (f32x4){0.f, 0.f, 0.f, 0.f};
    bf16x8 At[4][2], B0[2][2], B1[2][2];
    const char* cA = (const char*)g.A + (size_t)cur.pm * tstep; const char* cB = (const char*)g.Bt + (size_t)cur.pn * tstep;
    S.a_ready(cur);
    if constexpr (SP2) {
        PG8_STAGE(PG8_SB(0, 0), cB, voffB); PG8_STAGE(PG8_SB(0, 1), cB + hstep, voffB); PG8_STAGE(PG8_SA(0, 0), cA, voffA); PG8_STAGE(PG8_SA(0, 1), cA + hstep, voffA);
        if (wr == 1) PG8_BAR;
        PG8_WAIT_V(2); PG8_BAR;
        PG8_STAGE(PG8_SB(1, 0), cB + kstep, voffB); PG8_STAGE(PG8_SA(1, 0), cA + kstep, voffA); PG8_STAGE(PG8_SB(1, 1), cB + hstep + kstep, voffB);
        PG8_WAIT_V(6); PG8_BAR;
    } else {
        PG8_STAGE(PG8_SB(0, 0), cB, voffB); PG8_STAGE(PG8_SA(0, 0), cA, voffA); PG8_STAGE(PG8_SB(0, 1), cB + hstep, voffB); PG8_STAGE(PG8_SA(0, 1), cA + hstep, voffA);
        if (wr == 1) PG8_BAR;
        PG8_WAIT_V(4); PG8_BAR;
        PG8_STAGE(PG8_SB(1, 0), cB + kstep, voffB); PG8_STAGE(PG8_SA(1, 0), cA + kstep, voffA); PG8_STAGE(PG8_SB(1, 1), cB + hstep + kstep, voffB);
        PG8_WAIT_V(6); PG8_BAR;
    }
    for (;;) {
        const bool has_next = S.next(ui + 1, nxt);
        const char* nA = has_next ? (const char*)g.A + (size_t)nxt.pm * tstep : cA; const char* nB = has_next ? (const char*)g.Bt + (size_t)nxt.pn * tstep : cB;
        for (int t = 0; t < nt; t += 2) {
            const bool last = (t == nt - 2);
            const char* a1 = cA + (size_t)(t + 1) * kstep;
            const char* a2 = last ? nA : cA + (size_t)(t + 2) * kstep; const char* b2 = last ? nB : cB + (size_t)(t + 2) * kstep;
            const char* a3 = a2 + kstep; const char* b3 = b2 + kstep;
            if (last && has_next) S.a_ready(nxt);
            if constexpr (SP2) {
            PG8_LDB(B0, 0, 0); PG8_LDB(B1, 0, 1); PG8_SCHED; PG8_LDA(At, 0, 0); PG8_STAGE(PG8_SA(1, 1), a1 + hstep, voffA);
            PG8_WAIT_V(8); PG8_WAIT_L(0); PG8_BAR; PG8_MMA(0, 0, At, B0); PG8_MMA(0, 1, At, B1); PG8_BAR; PG8_SCHED;
            PG8_LDA(At, 0, 1); PG8_STAGE(PG8_SB(0, 0), b2, voffB); PG8_STAGE(PG8_SB(0, 1), b2 + hstep, voffB); PG8_STAGE(PG8_SA(0, 0), a2, voffA);
            PG8_WAIT_V(8); PG8_WAIT_L(0); PG8_BAR; PG8_MMA(1, 0, At, B0); PG8_MMA(1, 1, At, B1); PG8_BAR; PG8_SCHED;
            PG8_LDB(B0, 1, 0); PG8_LDB(B1, 1, 1); PG8_SCHED; PG8_LDA(At, 1, 0); PG8_STAGE(PG8_SA(0, 1), a2 + hstep, voffA);
            PG8_WAIT_V(8); PG8_WAIT_L(0); PG8_BAR; PG8_MMA(0, 0, At, B0); PG8_MMA(0, 1, At, B1); PG8_BAR; PG8_SCHED;
            PG8_LDA(At, 1, 1); PG8_STAGE(PG8_SB(1, 0), b3, voffB); PG8_STAGE(PG8_SB(1, 1), b3 + hstep, voffB); PG8_STAGE(PG8_SA(1, 0), a3, voffA);
            PG8_WAIT_V(8); PG8_WAIT_L(0); PG8_BAR; PG8_MMA(1, 0, At, B0); PG8_MMA(1, 1, At, B1); PG8_BAR; PG8_SCHED;
            } else {
            PG8_LDB(B0, 0, 0); PG8_SCHED; PG8_LDA(At, 0, 0); PG8_STAGE(PG8_SA(1, 1), a1 + hstep, voffA);
            PG8_WAIT_L(8); PG8_BAR; PG8_WAIT_L(0); PG8_MMA(0, 0, At, B0); PG8_BAR; PG8_SCHED;
            PG8_LDB(B1, 0, 1); PG8_STAGE(PG8_SB(0, 0), b2, voffB);
            PG8_BAR; PG8_WAIT_L(0); PG8_MMA(0, 1, At, B1); PG8_BAR;
            PG8_LDA(At, 0, 1); PG8_STAGE(PG8_SA(0, 0), a2, voffA);
            PG8_BAR; PG8_WAIT_L(0); PG8_MMA(1, 0, At, B0); PG8_BAR; PG8_SCHED;
            PG8_STAGE(PG8_SB(0, 1), b2 + hstep, voffB);
            PG8_WAIT_V(6); PG8_BAR; PG8_MMA(1, 1, At, B1); PG8_BAR;
            PG8_LDB(B0, 1, 0); PG8_SCHED; PG8_LDA(At, 1, 0); PG8_STAGE(PG8_SA(0, 1), a2 + hstep, voffA);
            PG8_WAIT_L(8); PG8_BAR; PG8_WAIT_L(0); PG8_MMA(0, 0, At, B0); PG8_BAR; PG8_SCHED;
            PG8_LDB(B1, 1, 1); PG8_STAGE(PG8_SB(1, 0), b3, voffB);
            PG8_BAR; PG8_WAIT_L(0); PG8_MMA(0, 1, At, B1); PG8_BAR;
            PG8_LDA(At, 1, 1); PG8_STAGE(PG8_SA(1, 0), a3, voffA);
            PG8_BAR; PG8_WAIT_L(0); PG8_MMA(1, 0, At, B0); PG8_BAR; PG8_SCHED;
            PG8_STAGE(PG8_SB(1, 1), b3 + hstep, voffB);
            PG8_WAIT_V(6); PG8_BAR; PG8_MMA(1, 1, At, B1); PG8_BAR;
            }
        }
        if constexpr (ALIGN_EPI) { if (wr == 0) PG8_BAR; }
        if constexpr (!Epi::AFTER_DRAIN) { E(acc, cur, wr, wc, fr, fq); S.done(cur); }
        if (!has_next) break;
#pragma unroll
        for (int a = 0; a < 2; ++a)
#pragma unroll
            for (int b = 0; b < 2; ++b)
#pragma unroll
                for (int m = 0; m < 4; ++m)
#pragma unroll
                    for (int n = 0; n < 2; ++n) acc[a][b][m][n] = (f32x4){0.f, 0.f, 0.f, 0.f};
        cur = nxt; cA = nA; cB = nB; ++ui;
        if constexpr (ALIGN_EPI) { if (wr == 1) PG8_BAR; }
    }
    PG8_WAIT_V(0);
    if constexpr (!ALIGN_EPI) { if (wr == 0) PG8_BAR; }
    PG8_BAR;
    if constexpr (Epi::AFTER_DRAIN) { E.fused(acc, cur, wr, wc, fr, fq, lds, wid, lane); S.done(cur); }
#undef PG8_SA
#undef PG8_SB
#undef PG8_STAGE
#undef PG8_LDA
#undef PG8_LDB
#undef PG8_MMA
#undef PG8_WAIT_V
#undef PG8_WAIT_L
#undef PG8_BAR
#undef PG8_SCHED
}
}
namespace att {
using bf16 = unsigned short;
constexpr int D = 128, NW = 8, QBLK = 32, KVBLK = 64;
constexpr float SCALE = 0.088388347648318440f;
constexpr float THR = 8.f;
using f32x4 = __attribute__((ext_vector_type(4))) float;
using bf16x8 = __attribute__((ext_vector_type(8))) short;
using s16x4  = __attribute__((ext_vector_type(4))) short;
using f32x16 = __attribute__((ext_vector_type(16))) float;
using f32x8  = __attribute__((ext_vector_type(8))) float;
using u32x4  = __attribute__((ext_vector_type(4))) unsigned;
#define KSWZ(row, colB) ((row) * 256 + ((colB) ^ (((row) & 7) << 4)))
#define SBAR() __builtin_amdgcn_sched_barrier(0)
__device__ __forceinline__ int crow(int r, int hi) { return (r & 3) + 8 * (r >> 2) + 4 * hi; }
__device__ __forceinline__ unsigned cvtpk(float lo, float hi) {
  unsigned r; asm volatile("v_cvt_pk_bf16_f32 %0, %1, %2" : "=v"(r) : "v"(lo), "v"(hi)); return r;
}
__device__ __forceinline__ void partialSM(f32x16& p0, f32x16& p1, float& m_reg, float& mn, float& alpha) {
  constexpr float C = SCALE * 1.4426950408889634f;
  float pmax = p0[0]; for (int r = 1; r < 16; ++r) pmax = fmaxf(pmax, p0[r]); for (int r = 0; r < 16; ++r) pmax = fmaxf(pmax, p1[r]);
  { auto rr = __builtin_amdgcn_permlane32_swap(__float_as_uint(pmax), __float_as_uint(pmax), false, false);
    pmax = fmaxf(__uint_as_float(rr[0]), __uint_as_float(rr[1])); }
  if (__builtin_expect(__all(pmax - m_reg <= THR / SCALE), 1)) { mn = m_reg; alpha = 1.f; }
  else { mn = fmaxf(m_reg, pmax); alpha = __builtin_amdgcn_exp2f((m_reg - mn) * C); m_reg = mn; }
  float mnC = -mn * C;
  for (int r = 0; r < 16; ++r) p0[r] = fmaf(p0[r], C, mnC); for (int r = 0; r < 16; ++r) p1[r] = fmaf(p1[r], C, mnC);
  for (int r = 0; r < 16; ++r) p0[r] = __builtin_amdgcn_exp2f(p0[r]);
}
__device__ __forceinline__ void finishSM(f32x16& p0, f32x16& p1, float alpha, float& l_reg, bf16x8& pa0, bf16x8& pa1, bf16x8& pa2, bf16x8& pa3) {
  for (int r = 0; r < 16; ++r) p1[r] = __builtin_amdgcn_exp2f(p1[r]);
  float ps = 0; for (int r = 0; r < 16; ++r) ps += p0[r]; for (int r = 0; r < 16; ++r) ps += p1[r];
  { auto rr = __builtin_amdgcn_permlane32_swap(__float_as_uint(ps), __float_as_uint(ps), false, false);
    ps = __uint_as_float(rr[0]) + __uint_as_float(rr[1]); }
  l_reg = l_reg * alpha + ps;
#define PK4(P, BASE, OUT) do { unsigned a0 = cvtpk(P[BASE + 0], P[BASE + 1]), a1 = cvtpk(P[BASE + 2], P[BASE + 3]);   \
    unsigned b0 = cvtpk(P[BASE + 4], P[BASE + 5]), b1 = cvtpk(P[BASE + 6], P[BASE + 7]);                              \
    auto r0 = __builtin_amdgcn_permlane32_swap(a0, b0, false, false); auto r1 = __builtin_amdgcn_permlane32_swap(a1, b1, false, false); \
    u32x4 w = {r0[0], r1[0], r0[1], r1[1]}; OUT = *reinterpret_cast<bf16x8*>(&w); } while (0)
  PK4(p0, 0, pa0); PK4(p0, 8, pa1); PK4(p1, 0, pa2); PK4(p1, 8, pa3);
#undef PK4
}
__device__ __forceinline__ void qkt(f32x16& p0, f32x16& p1, const bf16* Ks, const bf16x8* qr, int r32, int hi) {
  p0 = f32x16{}; p1 = f32x16{};
  for (int d0 = 0; d0 < 8; ++d0) { int cb = (d0 * 16 + hi * 8) * 2;
    bf16x8 b0 = *reinterpret_cast<const bf16x8*>((const char*)Ks + KSWZ(r32, cb));
    bf16x8 b1 = *reinterpret_cast<const bf16x8*>((const char*)Ks + KSWZ(32 + r32, cb));
    p0 = __builtin_amdgcn_mfma_f32_32x32x16_bf16(b0, qr[d0], p0, 0, 0, 0);
    p1 = __builtin_amdgcn_mfma_f32_32x32x16_bf16(b1, qr[d0], p1, 0, 0, 0); }
}
__device__ __forceinline__ int v_st(int k, int c) { const int kk = (k & ~0xC) | ((k & 4) << 1) | ((k & 8) >> 1); return ((kk >> 3) * 4 + (c >> 5)) * 512 + ((kk & 7) * 32 + (c & 31)) * 2; }
__device__ __forceinline__ int v_rd_base(int lane) { return ((lane & 3) << 3) | (((lane >> 2) & 3) << 6) | (((lane >> 4) & 1) << 5) | (((lane >> 5) & 1) << 8); }
constexpr int v_rd_off(int d0, int ks, int half) { return d0 * 512 + ks * 4096 + half * 2048; }
template <int OFF> __device__ __forceinline__ s16x4 tr_read(int vb) {
  s16x4 r; asm volatile("ds_read_b64_tr_b16 %0, %1 offset:%2" : "=&v"(r) : "v"(vb), "i"(OFF) : "memory"); return r;
}
template <int D0> __device__ __forceinline__ void pv_one(f32x16& od, int vb, bf16x8 pa0, bf16x8 pa1, bf16x8 pa2, bf16x8 pa3) {
  const s16x4 l0 = tr_read<v_rd_off(D0, 0, 0)>(vb), h0 = tr_read<v_rd_off(D0, 0, 1)>(vb), l1 = tr_read<v_rd_off(D0, 1, 0)>(vb), h1 = tr_read<v_rd_off(D0, 1, 1)>(vb);
  const s16x4 l2 = tr_read<v_rd_off(D0, 2, 0)>(vb), h2 = tr_read<v_rd_off(D0, 2, 1)>(vb), l3 = tr_read<v_rd_off(D0, 3, 0)>(vb), h3 = tr_read<v_rd_off(D0, 3, 1)>(vb);
  asm volatile("s_waitcnt lgkmcnt(0)" ::: "memory"); SBAR();
#define PK(L, H) (bf16x8){L[0], L[1], L[2], L[3], H[0], H[1], H[2], H[3]}
  od = __builtin_amdgcn_mfma_f32_32x32x16_bf16(pa0, PK(l0, h0), od, 0, 0, 0);
  od = __builtin_amdgcn_mfma_f32_32x32x16_bf16(pa1, PK(l1, h1), od, 0, 0, 0);
  od = __builtin_amdgcn_mfma_f32_32x32x16_bf16(pa2, PK(l2, h2), od, 0, 0, 0);
  od = __builtin_amdgcn_mfma_f32_32x32x16_bf16(pa3, PK(l3, h3), od, 0, 0, 0);
#undef PK
}
__device__ __forceinline__ void pv_d0(f32x16* o, int vb, bf16x8 pa0, bf16x8 pa1, bf16x8 pa2, bf16x8 pa3) {
  pv_one<0>(o[0], vb, pa0, pa1, pa2, pa3); pv_one<1>(o[1], vb, pa0, pa1, pa2, pa3); pv_one<2>(o[2], vb, pa0, pa1, pa2, pa3); pv_one<3>(o[3], vb, pa0, pa1, pa2, pa3);
}
constexpr int DMODEL = 4096;
constexpr size_t SHM_V = 64 * 128 * 2, SHM_K = 64 * 128 * 2;
constexpr int ATT_WS_OFF = 2 * SHM_V + 2 * SHM_K, ATT_TAB_OFF = ATT_WS_OFF + 8 * 256, ATT_OST_OFF = ATT_TAB_OFF + 704 * 4 + 256  , ATT_LDS_BYTES = ATT_OST_OFF + 8 * 8192;
constexpr float LOG2E = 1.4426950408889634f;
__device__ __forceinline__ float bf2f(bf16 v) { return __uint_as_float((unsigned)v << 16); }
__device__ __forceinline__ bf16 f2bf(float f) { return (bf16)(cvtpk(f, 0.f) & 0xffffu); }
__device__ __forceinline__ float silu_f(float g) { return g * __builtin_amdgcn_rcpf(1.0f + __builtin_amdgcn_exp2f(-g * LOG2E)); }
__device__ __forceinline__ void pack_p(const f32x16& p0, const f32x16& p1, bf16x8& pa0, bf16x8& pa1, bf16x8& pa2, bf16x8& pa3) {
#define PK4(P, BASE, OUT) do { unsigned a0 = cvtpk(P[BASE + 0], P[BASE + 1]), a1 = cvtpk(P[BASE + 2], P[BASE + 3]);   \
    unsigned b0 = cvtpk(P[BASE + 4], P[BASE + 5]), b1 = cvtpk(P[BASE + 6], P[BASE + 7]);                              \
    auto r0 = __builtin_amdgcn_permlane32_swap(a0, b0, false, false); auto r1 = __builtin_amdgcn_permlane32_swap(a1, b1, false, false); \
    u32x4 w = {r0[0], r1[0], r0[1], r1[1]}; OUT = *reinterpret_cast<bf16x8*>(&w); } while (0)
  PK4(p0, 0, pa0); PK4(p0, 8, pa1); PK4(p1, 0, pa2); PK4(p1, 8, pa3);
#undef PK4
}
template <int ZP>
__device__ __forceinline__ void store_gated(const f32x16* o, float l_reg, float* li_l, float* ost, const bf16* Gb, bf16* Yb, int wid, int lane, int r32, int hi) {
  if (hi == 0) li_l[r32] = l_reg;
  const int rr = lane >> 3, c8 = (lane & 7) * 8;
  u32x4 g[2][4];
#pragma unroll
  for (int h = 0; h < 2; ++h)
#pragma unroll
    for (int i = 0; i < 4; ++i) g[h][i] = *reinterpret_cast<const u32x4*>((const char*)Gb + (unsigned)(((wid * 32 + 8 * i + rr) * ZP + h * 64 + c8) * 2));
#pragma unroll
  for (int h = 0; h < 2; ++h) {
#pragma unroll
    for (int d = 0; d < 2; ++d)
#pragma unroll
      for (int r = 0; r < 16; ++r) ost[crow(r, hi) * 64 + d * 32 + r32] = o[2 * h + d][r];
    asm volatile("s_waitcnt lgkmcnt(0)" ::: "memory");
#pragma unroll
    for (int i = 0; i < 4; ++i) { const int row = 8 * i + rr;
      const f32x4 a = *reinterpret_cast<const f32x4*>(ost + row * 64 + c8), b = *reinterpret_cast<const f32x4*>(ost + row * 64 + c8 + 4);
      const float rl = __builtin_amdgcn_rcpf(li_l[row]); const u32x4 gg = g[h][i];
      u32x4 w;
      w.x = cvtpk(a[0] * rl * silu_f(__uint_as_float(gg.x << 16)), a[1] * rl * silu_f(__uint_as_float(gg.x & 0xffff0000u)));
      w.y = cvtpk(a[2] * rl * silu_f(__uint_as_float(gg.y << 16)), a[3] * rl * silu_f(__uint_as_float(gg.y & 0xffff0000u)));
      w.z = cvtpk(b[0] * rl * silu_f(__uint_as_float(gg.z << 16)), b[1] * rl * silu_f(__uint_as_float(gg.z & 0xffff0000u)));
      w.w = cvtpk(b[2] * rl * silu_f(__uint_as_float(gg.w << 16)), b[3] * rl * silu_f(__uint_as_float(gg.w & 0xffff0000u)));
      *reinterpret_cast<u32x4*>((char*)Yb + (unsigned)(((wid * 32 + row) * DMODEL + h * 64 + c8) * 2)) = w; }
    asm volatile("s_waitcnt lgkmcnt(0)" ::: "memory");
  }
}

template <int ZP>
__device__ __forceinline__ void dense_unit(const bf16* Qb, const bf16* Kh, const bf16* Vh, const bf16* Gb, bf16* Yb, int seq, char* lds) {
  int tid_ = threadIdx.x; asm volatile("" : "+v"(tid_));
  const int tid = tid_, wid = __builtin_amdgcn_readfirstlane(tid >> 6), lane = tid & 63, r32 = lane & 31, hi = lane >> 5;
  bf16* V_lds = (bf16*)lds; bf16* K_lds = (bf16*)(lds + 2 * SHM_V);
  float* ws = (float*)(lds + ATT_WS_OFF) + wid * 64; float* li_l = ws; float* al_l = ws + 32;
  float m_reg = -1e30f, l_reg = 0; f32x16 o[4] = {}; bf16x8 qr[8];
  { const unsigned qoff = (unsigned)((wid * QBLK + r32) * ZP + hi * 8) * 2u;
#pragma unroll
    for (int d0 = 0; d0 < 8; ++d0) qr[d0] = *reinterpret_cast<const bf16x8*>((const char*)Qb + qoff + d0 * 32); }
  const int sr = tid >> 4, sc = (tid & 15) * 8, vst0 = v_st(sr, sc), vst1 = v_st(32 + sr, sc);
  const int vb0 = (int)(uintptr_t)V_lds + v_rd_base(lane);
  struct { bf16x8 vs0, vs1, ks0, ks1; } sr_[2];
  const unsigned soff = (unsigned)(sr * ZP + sc) * 2u;
#define SLOAD(i, k0) do { const char* vp_ = (const char*)Vh + (size_t)(k0) * (ZP * 2); const char* kp_ = (const char*)Kh + (size_t)(k0) * (ZP * 2); \
    sr_[i].vs0 = *reinterpret_cast<const bf16x8*>(vp_ + soff); sr_[i].vs1 = *reinterpret_cast<const bf16x8*>(vp_ + 32 * ZP * 2 + soff); \
    sr_[i].ks0 = *reinterpret_cast<const bf16x8*>(kp_ + soff); sr_[i].ks1 = *reinterpret_cast<const bf16x8*>(kp_ + 32 * ZP * 2 + soff); } while (0)
#define SWRITE(b, i) do { *(bf16x8*)((char*)V_lds + (b) * SHM_V + vst0) = sr_[i].vs0;          \
    *(bf16x8*)((char*)V_lds + (b) * SHM_V + vst1) = sr_[i].vs1; int kc = sc * 2;               \
    *(bf16x8*)((char*)K_lds + (b) * SHM_K + KSWZ(sr, kc)) = sr_[i].ks0;                       \
    *(bf16x8*)((char*)K_lds + (b) * SHM_K + KSWZ(32 + sr, kc)) = sr_[i].ks1; } while (0)
#define SWAIT() asm volatile("s_waitcnt vmcnt(4)" ::: "memory")
#define RESC(a) do { if (__any((a) < 1.f)) { if (hi == 0) al_l[r32] = (a); asm volatile("s_waitcnt lgkmcnt(0)" ::: "memory"); \
    for (int d = 0; d < 4; ++d) for (int r = 0; r < 16; ++r) o[d][r] *= al_l[crow(r, hi)]; } } while (0)
  f32x16 pA0, pA1, pB0, pB1; float mnA, mnB, alA, alB; bf16x8 pa0, pa1, pa2, pa3; const int NT = seq / KVBLK;
  constexpr int SE = 0, SO = 1;
  SLOAD(SE, 0); asm volatile("s_waitcnt vmcnt(0)" ::: "memory"); SWRITE(0, SE); __syncthreads();
  qkt(pA0, pA1, K_lds, qr, r32, hi); partialSM(pA0, pA1, m_reg, mnA, alA);
  SLOAD(SO, KVBLK); if (2 < NT) SLOAD(SE, 2 * KVBLK);
  SWAIT(); SWRITE(1, SO); __syncthreads();
  for (int j = 1; j + 1 < NT; j += 2) {
    SBAR(); qkt(pB0, pB1, (bf16*)((char*)K_lds + SHM_K), qr, r32, hi);
    finishSM(pA0, pA1, alA, l_reg, pa0, pa1, pa2, pa3); SBAR();
    SLOAD(SO, (j + 2) * KVBLK); SBAR();
    pv_d0(o, vb0, pa0, pa1, pa2, pa3); partialSM(pB0, pB1, m_reg, mnB, alB);
    __syncthreads(); SWAIT(); SWRITE(0, SE);
    RESC(alB); __syncthreads();
    SBAR(); qkt(pA0, pA1, K_lds, qr, r32, hi);
    finishSM(pB0, pB1, alB, l_reg, pa0, pa1, pa2, pa3); SBAR();
    if (j + 3 < NT) SLOAD(SE, (j + 3) * KVBLK); SBAR();
    pv_d0(o, vb0 + (int)SHM_V, pa0, pa1, pa2, pa3); partialSM(pA0, pA1, m_reg, mnA, alA);
    __syncthreads(); SWAIT(); SWRITE(1, SO);
    RESC(alA); __syncthreads();
  }
  SBAR(); qkt(pB0, pB1, (bf16*)((char*)K_lds + SHM_K), qr, r32, hi);
  finishSM(pA0, pA1, alA, l_reg, pa0, pa1, pa2, pa3); SBAR();
  pv_d0(o, vb0, pa0, pa1, pa2, pa3); partialSM(pB0, pB1, m_reg, mnB, alB);
  __syncthreads(); RESC(alB);
  finishSM(pB0, pB1, alB, l_reg, pa0, pa1, pa2, pa3); SBAR();
  pv_d0(o, vb0 + (int)SHM_V, pa0, pa1, pa2, pa3);
  store_gated<ZP>(o, l_reg, li_l, (float*)(lds + ATT_OST_OFF) + wid * 2048, Gb, Yb, wid, lane, r32, hi);
#undef SLOAD
#undef SWRITE
#undef SWAIT
}

template <int MODE, int ZP>
__device__ __forceinline__ void local_unit(const bf16* Qb, const bf16* Kh, const bf16* Vh, const bf16* Gb, bf16* Yb, char* lds,
                                           int jlo, int jhi, int wlo, int whi, int pa, float fa, float fb, const float* rpbh) {
  int tid_ = threadIdx.x; asm volatile("" : "+v"(tid_));
  const int tid = tid_, wid = __builtin_amdgcn_readfirstlane(tid >> 6), lane = tid & 63, r32 = lane & 31, hi = lane >> 5;
  bf16* V_lds = (bf16*)lds; bf16* K_lds = (bf16*)(lds + 2 * SHM_V);
  float* ws = (float*)(lds + ATT_WS_OFF) + wid * 64; float* li_l = ws; float* al_l = ws + 32;
  float* tab = (float*)(lds + ATT_TAB_OFF);
  __syncthreads();
  if (MODE == 1) { for (int i = tid; i < 465; i += 512) tab[64 + i] = rpbh[i] * LOG2E; }
  float m_reg = -1e30f, l_reg = 0; f32x16 o[4] = {}; bf16x8 qr[8];
  { const unsigned qoff = (unsigned)((wid * QBLK + r32) * ZP + hi * 8) * 2u;
#pragma unroll
    for (int d0 = 0; d0 < 8; ++d0) qr[d0] = *reinterpret_cast<const bf16x8*>((const char*)Qb + qoff + d0 * 32); }
  const int sr = tid >> 4, sc = (tid & 15) * 8, vst0 = v_st(sr, sc), vst1 = v_st(32 + sr, sc);
  const int vb0 = (int)(uintptr_t)V_lds + v_rd_base(lane);
  bf16x8 vs0, vs1, ks0, ks1;
  const unsigned soff = (unsigned)(sr * ZP + sc) * 2u;
#define LLOAD(k0) do { const char* vp_ = (const char*)Vh + (size_t)(k0) * (ZP * 2); const char* kp_ = (const char*)Kh + (size_t)(k0) * (ZP * 2); \
    vs0 = *reinterpret_cast<const bf16x8*>(vp_ + soff); vs1 = *reinterpret_cast<const bf16x8*>(vp_ + 32 * ZP * 2 + soff); \
    ks0 = *reinterpret_cast<const bf16x8*>(kp_ + soff); ks1 = *reinterpret_cast<const bf16x8*>(kp_ + 32 * ZP * 2 + soff); } while (0)
#define LWRITE(b) do { *(bf16x8*)((char*)V_lds + (b) * SHM_V + vst0) = vs0; *(bf16x8*)((char*)V_lds + (b) * SHM_V + vst1) = vs1; int kc = sc * 2;               \
    *(bf16x8*)((char*)K_lds + (b) * SHM_K + KSWZ(sr, kc)) = ks0; *(bf16x8*)((char*)K_lds + (b) * SHM_K + KSWZ(32 + sr, kc)) = ks1; } while (0)
  constexpr float C = SCALE * LOG2E;
  const float NEG_INF = -__builtin_inff();
  int cq = 0, cs = 0, tq = 0;
  if (MODE == 1) { cq = 32 * (wid & 1) + r32; cs = cq - 8; cs = cs < 0 ? 0 : (cs > 48 ? 48 : cs); }
  else { tq = pa + wid * QBLK + r32; }
  LLOAD(jlo * KVBLK);
  for (int j = jlo; j < jhi; ++j) {
    const int b = (j - jlo) & 1;
    asm volatile("s_waitcnt vmcnt(0)" ::: "memory"); LWRITE(b);
    if (j + 1 < jhi) LLOAD((j + 1) * KVBLK);
    __syncthreads();
    if (j >= wlo && j < whi) {
      f32x16 p0, p1;
      qkt(p0, p1, (bf16*)((char*)K_lds + b * SHM_K), qr, r32, hi);
      if (MODE == 1) {
        const float* trow = tab + 64 + (j - pa + 7) * 31 + 15 + 4 * hi - cq;
        const int cb = 4 * hi - cs;
#pragma unroll
        for (int r = 0; r < 16; ++r) { const int kc0 = (r & 3) + 8 * (r >> 2);
          p0[r] = ((unsigned)(kc0 + cb) < 16u) ? fmaf(p0[r], C, trow[kc0]) : NEG_INF;
          p1[r] = ((unsigned)(kc0 + 32 + cb) < 16u) ? fmaf(p1[r], C, trow[kc0 + 32]) : NEG_INF; }
      } else {
        const int base = j * KVBLK + 4 * hi - tq;
#pragma unroll
        for (int r = 0; r < 16; ++r) { const int kc0 = (r & 3) + 8 * (r >> 2);
          const int d0 = kc0 + base, d1 = d0 + 32; const int a0 = d0 < 0 ? -d0 : d0, a1 = d1 < 0 ? -d1 : d1;
          p0[r] = (a0 <= 128) ? fmaf(p0[r], C, -fa * (float)a0) : NEG_INF;
          p1[r] = (a1 <= 128) ? fmaf(p1[r], C, -fa * (float)a1) : NEG_INF; }
      }
      float pmax = p0[0];
#pragma unroll
      for (int r = 1; r < 16; ++r) pmax = fmaxf(pmax, p0[r]);
#pragma unroll
      for (int r = 0; r < 16; ++r) pmax = fmaxf(pmax, p1[r]);
      { auto rr = __builtin_amdgcn_permlane32_swap(__float_as_uint(pmax), __float_as_uint(pmax), false, false);
        pmax = fmaxf(__uint_as_float(rr[0]), __uint_as_float(rr[1])); }
      const float mn = fmaxf(m_reg, pmax); const float alpha = __builtin_amdgcn_exp2f(m_reg - mn); m_reg = mn;
      float ps = 0.f;
#pragma unroll
      for (int r = 0; r < 16; ++r) { p0[r] = __builtin_amdgcn_exp2f(p0[r] - mn); p1[r] = __builtin_amdgcn_exp2f(p1[r] - mn); ps += p0[r] + p1[r]; }
      { auto rr = __builtin_amdgcn_permlane32_swap(__float_as_uint(ps), __float_as_uint(ps), false, false);
        ps = __uint_as_float(rr[0]) + __uint_as_float(rr[1]); }
      l_reg = l_reg * alpha + ps;
      RESC(alpha);
      bf16x8 pa0, pa1, pa2, pa3;
      pack_p(p0, p1, pa0, pa1, pa2, pa3);
      pv_d0(o, vb0 + b * (int)SHM_V, pa0, pa1, pa2, pa3);
    }
  }
  if (MODE == 2) l_reg += __builtin_amdgcn_exp2f(fb - m_reg);
  store_gated<ZP>(o, l_reg, li_l, (float*)(lds + ATT_OST_OFF) + wid * 2048, Gb, Yb, wid, lane, r32, hi);
#undef LLOAD
#undef LWRITE
#undef RESC
}
}
constexpr int NWAVES = 8;
constexpr int S = 8192, DM = 4096, HD = 128, DEPTH = 4;
constexpr int NIN_E = 13312, NIN_O = 10240;
constexpr int E_QA = 0, E_KA = 2048, E_VA = 2560, E_QB = 3072, E_KB = 5120, E_VB = 7168, E_G = 9216;
constexpr int O_Q = 0, O_K = 4096, O_V = 5120, O_G = 6144;
constexpr float NORM_EPS = 1e-6f;
constexpr size_t MiB = 1u << 20;
constexpr size_t WS_CTL = 0, CTL_ZERO_BYTES = 1 * MiB;
constexpr size_t WS_ROPE = 1 * MiB;
constexpr size_t WS_PART = 2 * MiB;
constexpr size_t WS_WIN_E = 8 * MiB, WIN_E_BYTES = (size_t)NIN_E * DM * 2;
constexpr size_t WS_WIN_O = WS_WIN_E + 2 * WIN_E_BYTES, WIN_O_BYTES = (size_t)NIN_O * DM * 2;
constexpr size_t WS_WOUT_E = WS_WIN_O + 2 * WIN_O_BYTES, WOUT_BYTES = (size_t)DM * DM * 2;
constexpr size_t WS_WOUT_O = WS_WOUT_E + 2 * WOUT_BYTES;
constexpr size_t WS_XB = WS_WOUT_O + 2 * WOUT_BYTES;
constexpr size_t WS_Y = WS_XB + (size_t)S * DM * 2;
constexpr size_t WS_Z = WS_Y + (size_t)S * DM * 2;
constexpr size_t WS_END = WS_Z + (size_t)S * NIN_E * 2;
constexpr int CW_BAR = 4096;
constexpr int RING_OFF = 0, RING_BYTES = 131072;
constexpr int LDSCTL_OFF = 143360, MISC_OFF = LDSCTL_OFF + 320;
constexpr int RSTD_OFF = 139264;
constexpr int LDS_BYTES = 147456;
static_assert(MISC_OFF + 128 <= LDS_BYTES && att::ATT_LDS_BYTES <= LDSCTL_OFF && RING_BYTES <= RSTD_OFF && RSTD_OFF + 1024 <= LDSCTL_OFF, "LDS map");

#define GAS __attribute__((address_space(1)))
#define LAS __attribute__((address_space(3)))
typedef unsigned short bf16;
typedef unsigned v4u __attribute__((ext_vector_type(4)));
typedef float f32x4 __attribute__((ext_vector_type(4)));
typedef GAS unsigned gu32;
#define LDS_WAIT() asm volatile("s_waitcnt lgkmcnt(0)" ::: "memory")
#define VM_WAIT() asm volatile("s_waitcnt vmcnt(0)" ::: "memory")
__device__ __forceinline__ unsigned pk2(float lo, float hi) { unsigned r; asm volatile("v_cvt_pk_bf16_f32 %0, %1, %2" : "=v"(r) : "v"(lo), "v"(hi)); return r; }
#define XB_TMO      128
#define XB_XCNT(j)  (256  + 64 * (j))
#define XB_XSUB(j)  (1280 + 64 * (j))
#define XB_XGEN(j)  (2304 + 64 * (j))
#define XB_TOP      3328
#define XB_TOPGEN   3392
#define XCD_BAR_WORDS 3456
#define XB_SPIN_CAP (1u << 18)

__device__ __forceinline__ unsigned xb_ld(unsigned* p)              { return __hip_atomic_load(p, __ATOMIC_RELAXED, __HIP_MEMORY_SCOPE_AGENT); }
__device__ __forceinline__ unsigned xb_add(unsigned* p, unsigned v) { return __hip_atomic_fetch_add(p, v, __ATOMIC_RELAXED, __HIP_MEMORY_SCOPE_AGENT); }
__device__ __forceinline__ unsigned xb_xcc_id() { return (unsigned)__builtin_amdgcn_s_getreg((3 << 11) | 20) & 0xFu; }
#define XB_SPIN(cond, bar) do { unsigned _sp = 0; while (cond) { __builtin_amdgcn_s_sleep(1); \
    if ((++_sp & 255u) == 0u) { if (xb_ld(&(bar)[XB_TMO])) break; if (_sp > XB_SPIN_CAP) { atomicAdd(&(bar)[XB_TMO], 1u); break; } } } } while (0)

struct XcdBarrier {
    unsigned* bar; unsigned x;
    volatile LAS unsigned* st;
};

__device__ __forceinline__ XcdBarrier xcd_barrier_post(unsigned* bar, volatile LAS unsigned* st) {
    XcdBarrier b; b.bar = bar; b.x = xb_xcc_id(); b.st = st;
    if (threadIdx.x == 0) (void)xb_add(&bar[XB_XCNT(b.x)], 1u);
    return b;
}
__device__ __forceinline__ void xcd_barrier_complete(unsigned* bar, unsigned x, unsigned& nloc, unsigned& nx) {
    const unsigned G = gridDim.x * gridDim.y * gridDim.z;
    unsigned sum, cnt, mine, sp = 0u;
    for (;;) {
        sum = 0u; cnt = 0u; mine = 0u;
#pragma unroll
        for (unsigned j = 0; j < 16; ++j) { const unsigned c = xb_ld(&bar[XB_XCNT(j)]); sum += c; cnt += (c > 0u) ? 1u : 0u; mine = (j == x) ? c : mine; }
        if (sum == G) break;
        __builtin_amdgcn_s_sleep(1);
        if ((++sp & 255u) == 0u) { if (xb_ld(&bar[XB_TMO])) break; if (sp > XB_SPIN_CAP) { atomicAdd(&bar[XB_TMO], 1u); break; } }
    }
    nloc = mine > 0u ? mine : 1u; nx = cnt > 0u ? cnt : 1u;
}

__device__ __forceinline__ void xcd_barrier(const XcdBarrier& b) {
    asm volatile("s_waitcnt vmcnt(0)" ::: "memory");
    __syncthreads();
    if (threadIdx.x == 0) {
        unsigned* bar = b.bar;
        __builtin_amdgcn_s_waitcnt(0);
        unsigned nloc = b.st[0], nx = b.st[1];
        if (nloc == 0u) { xcd_barrier_complete(bar, b.x, nloc, nx); b.st[0] = nloc; b.st[1] = nx; }
        const unsigned old = xb_add(&bar[XB_XSUB(b.x)], 1u);
        const unsigned gen = old / nloc;
        if (old + 1u == (gen + 1u) * nloc) {
            __builtin_amdgcn_fence(__ATOMIC_RELEASE, "agent");
            asm volatile("s_waitcnt vmcnt(0)" ::: "memory");
            const unsigned og = xb_add(&bar[XB_TOP], 1u);
            const unsigned tg = og / nx;
            if (og + 1u == (tg + 1u) * nx) xb_add(&bar[XB_TOPGEN], 1u);
            else XB_SPIN(xb_ld(&bar[XB_TOPGEN]) == tg, bar);
            __builtin_amdgcn_fence(__ATOMIC_ACQUIRE, "agent");
            xb_add(&bar[XB_XGEN(b.x)], 1u);
            asm volatile("s_waitcnt vmcnt(0)" ::: "memory");
        } else {
            XB_SPIN(xb_ld(&bar[XB_XGEN(b.x)]) == gen, bar);
            __builtin_amdgcn_fence(__ATOMIC_ACQUIRE, "agent");
            asm volatile("s_waitcnt vmcnt(0)" ::: "memory");
        }
    }
    __syncthreads();
}
struct Frame {
    LAS unsigned char* lds;
    volatile LAS unsigned* MISC;
    gu32* ctl;
    int tid, lane, wave;
    int vcu, G;
};
__device__ __forceinline__ float wave_sum(float v) {
#pragma unroll
    for (int o = 1; o < 64; o <<= 1) v += __shfl_xor(v, o);
    return v;
}
__device__ __forceinline__ void transpose_item(const float* W, int N, const float* kscale, bf16* WT, LAS float* scr, int item, int lane) {
    const int nnb = N >> 6, kb = item / nnb, nb = item - kb * nnb, k0 = kb << 6, n0 = nb << 6;
    const int lr = lane >> 4, lc = (lane & 15) << 2;
    f32x4 v[16];
#pragma unroll
    for (int i = 0; i < 16; ++i) v[i] = *(const f32x4*)(W + (size_t)(k0 + 4 * i + lr) * N + n0 + lc);
#pragma unroll
    for (int i = 0; i < 16; ++i) { const int k = 4 * i + lr; const float s = kscale ? kscale[k0 + k] : 1.0f;
        *(LAS f32x4*)(scr + k * 64 + (lc ^ (((k >> 3) & 3) << 3))) = v[i] * s; }
    LDS_WAIT(); asm volatile("" ::: "memory");
    const int c = lane & 7, nn = lane >> 3, f = (c & 3) << 3;
#pragma unroll
    for (int j = 0; j < 8; ++j) { const int n = nn + 8 * j; const LAS float* s = scr + (8 * c) * 64 + (n ^ f);
        v4u o; o.x = pk2(s[0 * 64], s[1 * 64]); o.y = pk2(s[2 * 64], s[3 * 64]); o.z = pk2(s[4 * 64], s[5 * 64]); o.w = pk2(s[6 * 64], s[7 * 64]);
        *(GAS v4u*)(WT + (size_t)(n0 + n) * DM + k0 + 8 * c) = o; }
    LDS_WAIT(); asm volatile("" ::: "memory");
}

struct Args { const float* in[11]; float* out; unsigned char* ws; int ph_lo, ph_hi; };
constexpr int PH_FINAL = 1 + 4 * DEPTH, PH_END = PH_FINAL + 1;
#ifndef REP_PRO
#define REP_PRO 1
#endif
#ifndef REP_IN
#define REP_IN 1
#endif
#ifndef REP_OUT0
#define REP_OUT0 1
#endif
#ifndef REP_DENSE
#define REP_DENSE 1
#endif
#ifndef REP_LOCAL
#define REP_LOCAL 1
#endif

__global__ void __launch_bounds__(NWAVES * 64, 2) mk_fwd(Args args) {
    extern __shared__ __attribute__((aligned(16))) unsigned char lds[];
    Frame F;
    F.lds = (LAS unsigned char*)lds;
    F.MISC = (volatile LAS unsigned*)(F.lds + MISC_OFF);
    F.tid = threadIdx.x; F.lane = F.tid & 63; F.wave = __builtin_amdgcn_readfirstlane(F.tid >> 6);
    F.G = gridDim.x; { const int bx = blockIdx.x; F.vcu = (F.G % 8 == 0) ? (bx % 8) * (F.G / 8) + bx / 8 : bx; }
    unsigned char* ws = args.ws;
    F.ctl = (gu32*)(ws + WS_CTL);
    for (int u = F.tid; u < (LDS_BYTES - LDSCTL_OFF) / 4; u += NWAVES * 64) ((LAS unsigned*)(F.lds + LDSCTL_OFF))[u] = 0u;
    __syncthreads();
    const int lo = args.ph_lo, hi = args.ph_hi;
    const bool use_bar = (hi - lo) > 1;
    XcdBarrier bar; bar.bar = (unsigned*)(F.ctl + CW_BAR); bar.x = 0; bar.st = nullptr;
    if (use_bar) bar = xcd_barrier_post((unsigned*)(F.ctl + CW_BAR), F.MISC + 8);
#define IN(k) (lo <= (k) && (k) < hi)
#define SEAM(k) do { if (IN(k) && IN((k) + 1)) xcd_barrier(bar); } while (0)

    const float* x_in = args.in[0];
    float* X = args.out;
    float* PART = (float*)(ws + WS_PART);
    bf16* XB = (bf16*)(ws + WS_XB); bf16* Y = (bf16*)(ws + WS_Y); bf16* Z = (bf16*)(ws + WS_Z);
    float* ROPE = (float*)(ws + WS_ROPE);
    const int gw = F.vcu * NWAVES + F.wave, NGW = F.G * NWAVES;

    if (IN(0)) {
      _Pragma("nounroll") for (int rep = 0; rep < REP_PRO; ++rep) {
        LAS float* scr = (LAS float*)(F.lds + RING_OFF + F.wave * 16384);
        constexpr int I_INE = 64 * (NIN_E / 64), I_INO = 64 * (NIN_O / 64), I_OUT = 64 * (DM / 64);
        constexpr int NITEMS = 2 * I_INE + 2 * I_INO + 4 * I_OUT;
        for (int it = gw; it < NITEMS; it += NGW) {
            int r = it;
            if (r < 2 * I_INE) { const int e = r / I_INE; r -= e * I_INE;
                transpose_item(args.in[2] + (size_t)e * DM * NIN_E, NIN_E, args.in[1] + (2 * e) * DM, (bf16*)(ws + WS_WIN_E + e * WIN_E_BYTES), scr, r, F.lane); continue; }
            r -= 2 * I_INE;
            if (r < 2 * I_INO) { const int e = r / I_INO; r -= e * I_INO;
                transpose_item(args.in[7] + (size_t)e * DM * NIN_O, NIN_O, args.in[1] + (2 * e + 1) * DM, (bf16*)(ws + WS_WIN_O + e * WIN_O_BYTES), scr, r, F.lane); continue; }
            r -= 2 * I_INO;
            if (r < 2 * I_OUT) { const int e = r / I_OUT; r -= e * I_OUT;
                transpose_item(args.in[3] + (size_t)e * DM * DM, DM, nullptr, (bf16*)(ws + WS_WOUT_E + e * WOUT_BYTES), scr, r, F.lane); continue; }
            r -= 2 * I_OUT;
            { const int e = r / I_OUT; r -= e * I_OUT;
                transpose_item(args.in[8] + (size_t)e * DM * DM, DM, nullptr, (bf16*)(ws + WS_WOUT_O + e * WOUT_BYTES), scr, r, F.lane); }
        }
        for (int m = gw; m < S; m += NGW) {
            const GAS f32x4* xr = (const GAS f32x4*)(x_in + (size_t)m * DM) + F.lane;
            GAS unsigned long long* o8 = (GAS unsigned long long*)(XB + (size_t)m * DM) + F.lane;
            float ss = 0.f;
#pragma unroll
            for (int j = 0; j < 16; ++j) { const f32x4 v = xr[64 * j]; ss += (v.x * v.x + v.y * v.y) + (v.z * v.z + v.w * v.w);
                o8[64 * j] = (unsigned long long)pk2(v.x, v.y) | ((unsigned long long)pk2(v.z, v.w) << 32); }
            ss = wave_sum(ss);
            PART[(size_t)m * 64 + F.lane] = F.lane == 0 ? ss : 0.f;
        }
        for (int i = blockIdx.x * 512 + F.tid; i < 128 * 32; i += F.G * 512) {
            const int p = i >> 5, k = i & 31;
            double inv = 1.0; for (int q = 0; q < k; ++q) inv *= 0.7498942093324558;
            const double ang = (double)p * inv, n = __builtin_rint(ang * 0.6366197723675814);
            double r = __builtin_fma(-n, 1.5707963267948966, ang); r = __builtin_fma(-n, 6.123233995736766e-17, r);
            const double r2 = r * r;
            double sp = 2.8114572543455206e-15; sp = sp * r2 - 7.647163731819816e-13; sp = sp * r2 + 1.6059043836821613e-10; sp = sp * r2 - 2.505210838544172e-08; sp = sp * r2 + 2.7557319223985893e-06;
            sp = sp * r2 - 0.0001984126984126984; sp = sp * r2 + 0.008333333333333333; sp = sp * r2 - 0.16666666666666666; sp = sp * r2 + 1.0; sp *= r;
            double cp = 1.5619206968586225e-16; cp = cp * r2 - 4.779477332387385e-14; cp = cp * r2 + 1.1470745597729725e-11; cp = cp * r2 - 2.08767569878681e-09; cp = cp * r2 + 2.755731922398589e-07;
            cp = cp * r2 - 2.48015873015873e-05; cp = cp * r2 + 0.001388888888888889; cp = cp * r2 - 0.041666666666666664; cp = cp * r2 + 0.5; cp = 1.0 - cp * r2;
            const int q4 = (int)n & 3;
            const double cv = q4 == 0 ? cp : (q4 == 1 ? -sp : (q4 == 2 ? -cp : sp)), sv = q4 == 0 ? sp : (q4 == 1 ? cp : (q4 == 2 ? -sp : -cp));
            ROPE[2 * i] = (float)cv; ROPE[2 * i + 1] = (float)sv;
        }
      }
    }
    SEAM(0);

    for (int L = 0; L < DEPTH; ++L) {
        const int e = L >> 1; const bool even = (L & 1) == 0;
        const int NIN = even ? NIN_E : NIN_O;
        const int pb = 1 + 4 * L;
        if (IN(pb)) {
            const bf16* Wt = (const bf16*)(ws + (even ? WS_WIN_E + e * WIN_E_BYTES : WS_WIN_O + e * WIN_O_BYTES));
            pg8::Gemm g{XB, Wt, S, NIN, DM}; pg8::StaticOrder So; So.init(S, NIN, F.G, (int)blockIdx.x);
            LAS float* rstd = (LAS float*)(F.lds + RSTD_OFF);
            { pg8::Unit u0; So.next(0, u0);
                int t_ = F.tid; asm volatile("" : "+v"(t_));
                const f32x4* pp = (const f32x4*)(PART + (size_t)(u0.pm * 256 + (t_ >> 1)) * 64 + (t_ & 1) * 32);
                f32x4 a = pp[0] + pp[1], b = pp[2] + pp[3], c = pp[4] + pp[5], d = pp[6] + pp[7]; a = (a + b) + (c + d);
                float s = (a[0] + a[1]) + (a[2] + a[3]); s += __shfl_xor(s, 1);
                if (!(t_ & 1)) rstd[t_ >> 1] = 1.0f / sqrtf(s * (1.0f / DM) + NORM_EPS);
                __syncthreads(); }
            pg8::EpiIn E{Z, NIN, rstd};
#ifndef NO_GEMM_IN
            _Pragma("nounroll") for (int rep = 0; rep < REP_IN; ++rep)
            pg8::gemm_phase<pg8::EpiIn, pg8::StaticOrder, true, true>(F.lds + RING_OFF, g, So, E);
#endif
        }
        SEAM(pb);
        if (IN(pb + 1) && even) {
            const float* qn = args.in[4] + e * HD; const float* kn = args.in[5] + e * HD;
            int ln = F.lane; asm volatile("" : "+v"(ln));
            const int sub = ln >> 5, half = (ln >> 4) & 1, i0 = 2 * (ln & 15);
            for (int it = gw; it < S * 10; it += NGW) {
                const int t = it / 10, hp = it - t * 10, head = 2 * hp + sub;
                bf16* base = Z + (size_t)t * NIN_E + head * HD + 64 * half + i0;
                const unsigned a = *(const unsigned*)base, b = *(const unsigned*)(base + 32);
                float x1a = __uint_as_float(a << 16), x1b = __uint_as_float(a & 0xffff0000u), x2a = __uint_as_float(b << 16), x2b = __uint_as_float(b & 0xffff0000u);
                float ss = (x1a * x1a + x1b * x1b) + (x2a * x2a + x2b * x2b);
#pragma unroll
                for (int o = 1; o < 32; o <<= 1) ss += __shfl_xor(ss, o);
                const float rs = 1.0f / sqrtf(ss * (1.0f / 128.0f) + NORM_EPS);
                const float* w = (head < 16 ? qn : kn) + 64 * half + i0;
                x1a *= rs * w[0]; x1b *= rs * w[1]; x2a *= rs * w[32]; x2b *= rs * w[33];
                const int p = half ? (t & 63) : (t >> 6);
                const f32x4 cs = *(const f32x4*)(ROPE + (size_t)(p * 32 + i0) * 2);
                const float o1a = x1a * cs.x - x2a * cs.y, o2a = x2a * cs.x + x1a * cs.y, o1b = x1b * cs.z - x2b * cs.w, o2b = x2b * cs.z + x1b * cs.w;
                *(unsigned*)base = pk2(o1a, o1b); *(unsigned*)(base + 32) = pk2(o2a, o2b);
            }
        }
        if (even) SEAM(pb + 1);
        if (IN(pb + 2)) {
            const int xcd = (int)blockIdx.x & 7, slot = (int)blockIdx.x >> 3;
            char* al = (char*)lds + RING_OFF;
            if (even) {
                _Pragma("nounroll") for (int rep = 0; rep < REP_DENSE; ++rep)
                for (int u = (int)blockIdx.x; u < 512; u += F.G) {
                    const int h = (u / 256) * 8 + (u & 7), qb = (u & 255) >> 3, kvh = h >> 2;
                    const bf16* Zq = Z + (size_t)(qb * 256) * NIN_E;
#ifndef NO_DENSE
                    att::dense_unit<NIN_E>(Zq + E_QA + h * HD, Z + E_KA + kvh * HD, Z + E_VA + kvh * HD, Zq + E_G + h * HD, Y + (size_t)(qb * 256) * DM + h * HD, S, al);
#endif
                }
                _Pragma("nounroll") for (int rep = 0; rep < REP_LOCAL; ++rep)
                for (int u = (int)blockIdx.x; u < 512; u += F.G) {
                    const int h = (u / 256) * 8 + (u & 7), blk = (u & 255) >> 3;
                    const int r0 = 4 * blk, rw = r0 + (F.wave >> 1);
                    int jlo = r0 - 4; jlo = jlo < 0 ? 0 : (jlo > 120 ? 120 : jlo);
                    int jh = r0 + 3 - 4; jh = jh < 0 ? 0 : (jh > 120 ? 120 : jh); jh += 8;
                    int wlo = rw - 4; wlo = wlo < 0 ? 0 : (wlo > 120 ? 120 : wlo);
                    const bf16* Zq = Z + (size_t)(blk * 256) * NIN_E;
#ifndef NO_NA
                    att::local_unit<1, NIN_E>(Zq + E_QB + h * HD, Z + E_KB + h * HD, Z + E_VB + h * HD, Zq + E_G + 2048 + h * HD, Y + (size_t)(blk * 256) * DM + 2048 + h * HD, al,
                                              jlo, jh, wlo, wlo + 8, rw, 0.f, 0.f, args.in[6] + ((size_t)e * 16 + h) * 465);
#endif
                }
                (void)xcd; (void)slot;
            } else {
                _Pragma("nounroll") for (int rep = 0; rep < REP_LOCAL; ++rep)
                for (int u = (int)blockIdx.x; u < 1024; u += F.G) {
                    const int h = (u / 256) * 8 + (u & 7), qb = (u & 255) >> 3, kvh = h >> 2, i0 = qb * 256, q0 = i0 + F.wave * 32;
                    int klo = i0 - 128; klo = klo < 0 ? 0 : klo; int khi = i0 + 256 + 128; khi = khi > S ? S : khi;
                    int wl = q0 - 128; wl = wl < 0 ? 0 : wl; int wh = q0 + 31 + 128; wh = wh > S - 1 ? S - 1 : wh;
                    const float slope = exp2f(-8.0f * (float)(h + 1) / 32.0f);
                    const bf16* Zq = Z + (size_t)i0 * NIN_O;
#ifndef NO_WIN
                    att::local_unit<2, NIN_O>(Zq + O_Q + h * HD, Z + O_K + kvh * HD, Z + O_V + kvh * HD, Zq + O_G + h * HD, Y + (size_t)i0 * DM + h * HD, al,
                                              klo >> 6, khi >> 6, wl >> 6, (wh >> 6) + 1, i0, slope * att::LOG2E, args.in[9][e * 32 + h] * att::LOG2E, nullptr);
#endif
                }
            }
        }
        SEAM(pb + 2);
        if (IN(pb + 3)) {
            const bf16* Wt = (const bf16*)(ws + (even ? WS_WOUT_E : WS_WOUT_O) + e * WOUT_BYTES);
            pg8::Gemm g{Y, Wt, S, DM, DM}; pg8::StaticOrder So; So.init(S, DM, F.G, (int)blockIdx.x);
            pg8::EpiOut E{L == 0 ? x_in : X, X, XB, PART};
#ifndef NO_GEMM_OUT
            _Pragma("nounroll") for (int rep = 0; rep < (L == 0 ? REP_OUT0 : 1); ++rep)
            pg8::gemm_phase<pg8::EpiOut, pg8::StaticOrder, true, true>(F.lds + RING_OFF, g, So, E);
#endif
        }
        SEAM(pb + 3);
    }
    if (IN(PH_FINAL)) {
        const float* fw = args.in[10];
        for (int m = gw; m < S; m += NGW) {
            GAS f32x4* xr = (GAS f32x4*)(X + (size_t)m * DM) + F.lane;
            f32x4 v[16]; float ss = 0.f;
#pragma unroll
            for (int j = 0; j < 16; ++j) { v[j] = xr[64 * j]; ss += (v[j].x * v[j].x + v[j].y * v[j].y) + (v[j].z * v[j].z + v[j].w * v[j].w); }
            const float rs = 1.0f / sqrtf(wave_sum(ss) * (1.0f / DM) + NORM_EPS);
#pragma unroll
            for (int j = 0; j < 16; ++j) { const f32x4 w = ((const f32x4*)fw)[64 * j + F.lane]; xr[64 * j] = v[j] * rs * w; }
        }
    }
#undef IN
#undef SEAM
}

#ifndef MK_SPLIT
#define MK_SPLIT 0
#endif
extern "C" void kernel_launch(void* const* d_in, const int* in_sizes, int n_in, void* d_out, int out_size, void* d_ws, size_t ws_size, hipStream_t stream) {
    static int grid = 0;
    if (grid == 0) {
        if (n_in != 11 || in_sizes[0] != S * DM || out_size != S * DM || ws_size < WS_END) {
            fprintf(stderr, "kernel_launch: shape mismatch: n_in %d in0 %d out %d ws %zu (need %zu)\n", n_in, n_in > 0 ? in_sizes[0] : -1, out_size, ws_size, (size_t)WS_END); grid = -1; return; }
        int dev = 0, cus = 0, per_cu = 0;
        if (hipGetDevice(&dev) != hipSuccess || hipDeviceGetAttribute(&cus, hipDeviceAttributeMultiprocessorCount, dev) != hipSuccess) { grid = -1; return; }
        if (hipFuncSetAttribute((const void*)mk_fwd, hipFuncAttributeMaxDynamicSharedMemorySize, LDS_BYTES) != hipSuccess) { fprintf(stderr, "kernel_launch: hipFuncSetAttribute failed\n"); grid = -1; return; }
        if (hipOccupancyMaxActiveBlocksPerMultiprocessor(&per_cu, (const void*)mk_fwd, NWAVES * 64, LDS_BYTES) != hipSuccess || per_cu < 1)
            fprintf(stderr, "kernel_launch: note: occupancy query reports %d workgroups per CU\n", per_cu);
        (void)hipGetLastError();
        grid = cus;
        { const int Ns[3] = {NIN_E, NIN_O, DM};
            for (int k = 0; k < 3; ++k) for (int c = 0; c < grid; ++c) { pg8::StaticOrder So; So.init(S, Ns[k], grid, c); pg8::Unit u0, u; if (!So.next(0, u0)) continue;
                for (int i = 1; So.next(i, u); ++i) if (u.pm != u0.pm) { fprintf(stderr, "kernel_launch: unit order gives workgroup %d two row panels (N %d); nothing launched\n", c, Ns[k]); grid = -1; return; } } }
    }
    if (grid < 0) return;
    if (hipMemsetAsync((char*)d_ws + WS_CTL, 0, CTL_ZERO_BYTES, stream) != hipSuccess) { fprintf(stderr, "kernel_launch: memset failed\n"); return; }
    Args a{};
    for (int i = 0; i < 11; ++i) a.in[i] = (const float*)d_in[i];
    a.out = (float*)d_out; a.ws = (unsigned char*)d_ws;
#if MK_SPLIT
    for (int p = 0; p < PH_END; ++p) { a.ph_lo = p; a.ph_hi = p + 1; hipLaunchKernelGGL(mk_fwd, dim3(grid), dim3(NWAVES * 64), LDS_BYTES, stream, a); }
#else
    a.ph_lo = 0; a.ph_hi = PH_END;
    hipLaunchKernelGGL(mk_fwd, dim3(grid), dim3(NWAVES * 64), LDS_BYTES, stream, a);
#endif
    const hipError_t le = hipPeekAtLastError();
    if (le != hipSuccess) fprintf(stderr, "kernel_launch: launch failed: %s\n", hipGetErrorName(le));
}
```

```cpp
#include <hip/hip_runtime.h>
#include <cstdio>
#include <cstdint>
namespace pg8 {
#define PG8_LAS __attribute__((address_space(3)))
typedef unsigned short bf16_t;
typedef short bf16x8 __attribute__((ext_vector_type(8)));
typedef float f32x4 __attribute__((ext_vector_type(4)));
typedef unsigned u32x4 __attribute__((ext_vector_type(4)));
constexpr int BM = 256, BK = 64, HALF = 128, HTB = HALF * BK * 2  , STAGE_BYTES = 8 * HTB, NXCD = 8, WGM = 8;

__host__ __device__ __forceinline__ int lds_byte(int r, int c) { const int st = (r >> 4) * 2 + (c >> 5), rr = r & 15, cc = c & 31, ob = rr * 64 + cc * 2; return st * 1024 + (ob ^ (((ob >> 9) & 1) << 5)); }
__host__ __device__ __forceinline__ void stage_rc(int b, int& R, int& C) { const int st = b / 1024, sb = b % 1024, swz = sb ^ (((sb >> 9) & 1) << 5); R = (st >> 1) * 16 + swz / 64; C = (st & 1) * 32 + (swz % 64) / 2; }
__host__ __device__ __forceinline__ int perm32(int rho) { const int n = rho >> 4, i = rho & 15; return 8 * (i >> 2) + 4 * n + (i & 3); }

struct Unit { int pm, pn; };
struct Gemm { const bf16_t* A; const bf16_t* Bt; int M, N, K; };

struct StaticOrder {
    int nM, nN, nwg, G, c;
    __host__ __device__ void init(int M, int N, int G_, int c_) { nM = M / BM; nN = N / BM; nwg = nM * nN; G = G_; c = c_; }
    __host__ __device__ bool next(int i, Unit& u) const {
        const long L = (long)i * G + c; if (L >= nwg) return false;
        int wgid = (int)L; { const int q = nwg / NXCD, r = nwg % NXCD, xcd = wgid % NXCD, off = wgid / NXCD; wgid = (xcd < r ? xcd * (q + 1) : r * (q + 1) + (xcd - r) * q) + off; }
        const int nig = WGM * nN, gid = wgid / nig, fm = gid * WGM, gsz = (nM - fm) < WGM ? (nM - fm) : WGM;
        u.pm = fm + ((wgid % nig) % gsz); u.pn = (wgid % nig) / gsz; return true;
    }
    __device__ __forceinline__ void a_ready(const Unit&) const {}
    __device__ __forceinline__ void done(const Unit&) const {}
};

__device__ __forceinline__ unsigned cvt_pk_bf16(float lo, float hi) { unsigned r; asm volatile("v_cvt_pk_bf16_f32 %0, %1, %2" : "=v"(r) : "v"(lo), "v"(hi)); return r; }
typedef float f32x2 __attribute__((ext_vector_type(2)));
struct EpiIn {
    static constexpr bool PERM = true, AFTER_DRAIN = false;
    bf16_t* Z; int ldz; const PG8_LAS float* rstd;
    int nr_tiles; const float* qn; const float* kn; const float* rope; PG8_LAS float* P;
    __device__ __forceinline__ void operator()(const f32x4 (&acc)[2][2][4][2], const Unit& u, int wr, int wc, int fr, int fq) const {
        const int row0 = u.pm * BM + wr * 64 + fr, col0 = u.pn * BM + wc * 32 + 8 * fq;
        float rs[2][4];
#pragma unroll
        for (int ai = 0; ai < 2; ++ai)
#pragma unroll
            for (int m = 0; m < 4; ++m) rs[ai][m] = rstd[ai * HALF + wr * 64 + m * 16 + fr];
        if (u.pn >= nr_tiles) {
#pragma unroll
            for (int ai = 0; ai < 2; ++ai)
#pragma unroll
                for (int m = 0; m < 4; ++m) {
                    bf16_t* rowp = Z + (size_t)(row0 + ai * HALF + m * 16) * ldz + col0;
#pragma unroll
                    for (int bj = 0; bj < 2; ++bj) { const f32x4 v0 = acc[ai][bj][m][0] * rs[ai][m], v1 = acc[ai][bj][m][1] * rs[ai][m];
                        u32x4 w; w.x = cvt_pk_bf16(v0[0], v0[1]); w.y = cvt_pk_bf16(v0[2], v0[3]); w.z = cvt_pk_bf16(v1[0], v1[1]); w.w = cvt_pk_bf16(v1[2], v1[3]);
                        *(u32x4*)(rowp + bj * HALF) = w; }
                }
        } else {
#pragma unroll
            for (int ai = 0; ai < 2; ++ai)
#pragma unroll
                for (int m = 0; m < 4; ++m)
#pragma unroll
                    for (int bj = 0; bj < 2; ++bj) { const f32x4 a = acc[ai][bj][m][0] * rs[ai][m], b = acc[ai][bj][m][1] * rs[ai][m];
                        float ss = ((a[0] * a[0] + a[1] * a[1]) + (a[2] * a[2] + a[3] * a[3])) + ((b[0] * b[0] + b[1] * b[1]) + (b[2] * b[2] + b[3] * b[3]));
                        ss += __shfl_xor(ss, 16); ss += __shfl_xor(ss, 32);
                        if (fq == 0) P[(ai * HALF + wr * 64 + m * 16 + fr) * 8 + bj * 4 + wc] = ss; }
            asm volatile("s_waitcnt lgkmcnt(0)" ::: "memory"); __builtin_amdgcn_s_barrier(); asm volatile("" ::: "memory");
            const int hf = wc >> 1, i0 = (16 * wc + 4 * fq) & 31;
            const float* wn = (u.pn < 8 ? qn : kn) + 64 * hf + i0;
            const f32x4 w1 = *(const f32x4*)wn, w2 = *(const f32x4*)(wn + 32);
#pragma unroll
            for (int ai = 0; ai < 2; ++ai)
#pragma unroll
                for (int m = 0; m < 4; ++m) {
                    const int row = row0 + ai * HALF + m * 16, pos = hf ? (row & 63) : (row >> 6);
                    const f32x4 cs0 = *(const f32x4*)(rope + (size_t)(pos * 32 + i0) * 2), cs1 = *(const f32x4*)(rope + (size_t)(pos * 32 + i0) * 2 + 4);
                    bf16_t* rowp = Z + (size_t)row * ldz + col0;
#pragma unroll
                    for (int bj = 0; bj < 2; ++bj) {
                        const f32x4 pp = *(const PG8_LAS f32x4*)(P + (ai * HALF + wr * 64 + m * 16 + fr) * 8 + bj * 4);
                        const float hr = rs[ai][m] / sqrtf(((pp[0] + pp[1]) + (pp[2] + pp[3])) * (1.0f / 128.0f) + 1e-6f);
                        const f32x4 x1 = acc[ai][bj][m][0] * hr * w1, x2 = acc[ai][bj][m][1] * hr * w2;
                        const float a0 = x1[0] * cs0[0] - x2[0] * cs0[1], b0 = x2[0] * cs0[0] + x1[0] * cs0[1];
                        const float a1 = x1[1] * cs0[2] - x2[1] * cs0[3], b1 = x2[1] * cs0[2] + x1[1] * cs0[3];
                        const float a2 = x1[2] * cs1[0] - x2[2] * cs1[1], b2 = x2[2] * cs1[0] + x1[2] * cs1[1];
                        const float a3 = x1[3] * cs1[2] - x2[3] * cs1[3], b3 = x2[3] * cs1[2] + x1[3] * cs1[3];
                        u32x4 w; w.x = cvt_pk_bf16(a0, a1); w.y = cvt_pk_bf16(a2, a3); w.z = cvt_pk_bf16(b0, b1); w.w = cvt_pk_bf16(b2, b3);
                        *(u32x4*)(rowp + bj * HALF) = w; }
                }
        }
    }
};
struct EpiOut {
    static constexpr bool PERM = true, AFTER_DRAIN = false;
    const float* Xold; float* Xnew; bf16_t* XB; float* part;
    __device__ __forceinline__ void operator()(const f32x4 (&acc)[2][2][4][2], const Unit& u, int wr, int wc, int fr, int fq) const {
        const int row0 = u.pm * BM + wr * 64 + fr, col0 = u.pn * BM + wc * 32 + 8 * fq;
        f32x4 xs[2][2][2][2];
#define EO_LD(slot, g) do { _Pragma("unroll") for (int mi = 0; mi < 2; ++mi) _Pragma("unroll") for (int bj = 0; bj < 2; ++bj) { \
            const size_t off = (size_t)(row0 + ((g) >> 1) * HALF + (((g) & 1) * 2 + mi) * 16) * 4096 + col0 + bj * HALF; \
            xs[slot][mi][bj][0] = *(const f32x4*)(Xold + off); xs[slot][mi][bj][1] = *(const f32x4*)(Xold + off + 4); } } while (0)
#define EO_PR(slot, g) do { _Pragma("unroll") for (int mi = 0; mi < 2; ++mi) { const int ai = (g) >> 1, m = ((g) & 1) * 2 + mi; const int row = row0 + ai * HALF + m * 16; float ss = 0.f; \
            _Pragma("unroll") for (int bj = 0; bj < 2; ++bj) { const size_t off = (size_t)row * 4096 + col0 + bj * HALF; \
                const f32x4 x0 = xs[slot][mi][bj][0] + acc[ai][bj][m][0], x1 = xs[slot][mi][bj][1] + acc[ai][bj][m][1]; \
                *(f32x4*)(Xnew + off) = x0; *(f32x4*)(Xnew + off + 4) = x1; \
                u32x4 w; w.x = cvt_pk_bf16(x0[0], x0[1]); w.y = cvt_pk_bf16(x0[2], x0[3]); w.z = cvt_pk_bf16(x1[0], x1[1]); w.w = cvt_pk_bf16(x1[2], x1[3]); \
                *(u32x4*)(XB + off) = w; \
                ss += ((x0[0] * x0[0] + x0[1] * x0[1]) + (x0[2] * x0[2] + x0[3] * x0[3])) + ((x1[0] * x1[0] + x1[1] * x1[1]) + (x1[2] * x1[2] + x1[3] * x1[3])); } \
            ss += __shfl_xor(ss, 16); ss += __shfl_xor(ss, 32); \
            if (fq == 0) part[(size_t)row * 64 + u.pn * 4 + wc] = ss; } } while (0)
        EO_LD(0, 0); EO_LD(1, 1); asm volatile("" ::: "memory");
        EO_PR(0, 0); asm volatile("" ::: "memory"); EO_LD(0, 2); asm volatile("" ::: "memory");
        EO_PR(1, 1); asm volatile("" ::: "memory"); EO_LD(1, 3); asm volatile("" ::: "memory");
        EO_PR(0, 2); EO_PR(1, 3);
#undef EO_LD
#undef EO_PR
    }
};
template <class Epi, class Sched, bool ALIGN_EPI = false, bool SP2 = false>
__device__ __forceinline__ void gemm_phase(PG8_LAS unsigned char* lds, const Gemm g, const Sched& S, const Epi& E) {
    int tid_ = threadIdx.x; asm volatile("" : "+v"(tid_));
    const int tid = tid_, wid = __builtin_amdgcn_readfirstlane(tid >> 6), lane = tid & 63, wr = wid >> 2, wc = wid & 3, fr = lane & 15, fq = lane >> 4;
    const int K = g.K, nt = K / BK;
    unsigned voffA[2], voffB[2];
#pragma unroll
    for (int i = 0; i < 2; ++i) { int R, C; stage_rc(tid * 16 + i * 8192, R, C); const int Rb = Epi::PERM ? ((R & ~31) + perm32(R & 31)) : R;
        voffA[i] = (unsigned)(R * K + C) * 2u; voffB[i] = (unsigned)(Rb * K + C) * 2u; }
    const size_t kstep = (size_t)(BK * 2);
    const size_t hstep = (size_t)HALF * K * 2;
    const size_t tstep = 2 * hstep;
    const unsigned ldsw = (unsigned)wid * 1024u;
    const int aoff = lds_byte(wr * 64 + fr, fq * 8), boff = lds_byte(wc * 32 + fr, fq * 8);
#define PG8_SA(b, h) (((b) * 2 + (h)) * HTB)
#define PG8_SB(b, h) ((4 + (b) * 2 + (h)) * HTB)
#define PG8_STAGE(bufoff, gbase, voff) do { _Pragma("unroll") for (int _i = 0; _i < 2; ++_i) \
        __builtin_amdgcn_global_load_lds((const unsigned*)((const char*)(gbase) + (voff)[_i]), (PG8_LAS unsigned*)(lds + (bufoff) + ldsw + _i * 8192), 16, 0, 0); } while (0)
#define PG8_LDA(dst, b, h) do { _Pragma("unroll") for (int m = 0; m < 4; ++m) _Pragma("unroll") for (int k = 0; k < 2; ++k) dst[m][k] = *(const PG8_LAS bf16x8*)(lds + PG8_SA(b, h) + aoff + m * 2048 + k * 1024); } while (0)
#define PG8_LDB(dst, b, h) do { _Pragma("unroll") for (int n = 0; n < 2; ++n) _Pragma("unroll") for (int k = 0; k < 2; ++k) dst[n][k] = *(const PG8_LAS bf16x8*)(lds + PG8_SB(b, h) + boff + n * 2048 + k * 1024); } while (0)
#define PG8_MMA(ai, bj, At, Bt) do { __builtin_amdgcn_s_setprio(1); _Pragma("unroll") for (int m = 0; m < 4; ++m) _Pragma("unroll") for (int n = 0; n < 2; ++n) _Pragma("unroll") for (int k = 0; k < 2; ++k) \
        acc[ai][bj][m][n] = __builtin_amdgcn_mfma_f32_16x16x32_bf16(Bt[n][k], At[m][k], acc[ai][bj][m][n], 0, 0, 0); __builtin_amdgcn_s_setprio(0); } while (0)
#define PG8_WAIT_V(n) asm volatile("s_waitcnt vmcnt(" #n ")" ::: "memory")
#define PG8_WAIT_L(n) asm volatile("s_waitcnt lgkmcnt(" #n ")" ::: "memory")
#define PG8_BAR __builtin_amdgcn_s_barrier()
#define PG8_SCHED __builtin_amdgcn_sched_barrier(0)
    Unit cur, nxt; int ui = 0;
    if (!S.next(0, cur)) return;
    f32x4 acc[2][2][4][2];
#pragma unroll
    for (int a = 0; a < 2; ++a)
#pragma unroll
        for (int b = 0; b < 2; ++b)
#pragma unroll
            for (int m = 0; m < 4; ++m)
#pragma unroll
                for (int n = 0; n < 2; ++n) acc[a][b][m][n] = (f32x4){0.f, 0.f, 0.f, 0.f};
    bf16x8 At[4][2], B0[2][2], B1[2][2];
    const char* cA = (const char*)g.A + (size_t)cur.pm * tstep; const char* cB = (const char*)g.Bt + (size_t)cur.pn * tstep;
    S.a_ready(cur);
    if constexpr (SP2) {
        PG8_STAGE(PG8_SB(0, 0), cB, voffB); PG8_STAGE(PG8_SB(0, 1), cB + hstep, voffB); PG8_STAGE(PG8_SA(0, 0), cA, voffA); PG8_STAGE(PG8_SA(0, 1), cA + hstep, voffA);
        if (wr == 1) PG8_BAR;
        PG8_WAIT_V(2); PG8_BAR;
        PG8_STAGE(PG8_SB(1, 0), cB + kstep, voffB); PG8_STAGE(PG8_SA(1, 0), cA + kstep, voffA); PG8_STAGE(PG8_SB(1, 1), cB + hstep + kstep, voffB);
        PG8_WAIT_V(6); PG8_BAR;
    } else {
        PG8_STAGE(PG8_SB(0, 0), cB, voffB); PG8_STAGE(PG8_SA(0, 0), cA, voffA); PG8_STAGE(PG8_SB(0, 1), cB + hstep, voffB); PG8_STAGE(PG8_SA(0, 1), cA + hstep, voffA);
        if (wr == 1) PG8_BAR;
        PG8_WAIT_V(4); PG8_BAR;
        PG8_STAGE(PG8_SB(1, 0), cB + kstep, voffB); PG8_STAGE(PG8_SA(1, 0), cA + kstep, voffA); PG8_STAGE(PG8_SB(1, 1), cB + hstep + kstep, voffB);
        PG8_WAIT_V(6); PG8_BAR;
    }
    for (;;) {
        const bool has_next = S.next(ui + 1, nxt);
        const char* nA = has_next ? (const char*)g.A + (size_t)nxt.pm * tstep : cA; const char* nB = has_next ? (const char*)g.Bt + (size_t)nxt.pn * tstep : cB;
        for (int t = 0; t < nt; t += 2) {
            const bool last = (t == nt - 2);
            const char* a1 = cA + (size_t)(t + 1) * kstep;
            const char* a2 = last ? nA : cA + (size_t)(t + 2) * kstep; const char* b2 = last ? nB : cB + (size_t)(t + 2) * kstep;
            const char* a3 = a2 + kstep; const char* b3 = b2 + kstep;
            if (last && has_next) S.a_ready(nxt);
            if constexpr (SP2) {
            PG8_LDB(B0, 0, 0); PG8_LDB(B1, 0, 1); PG8_SCHED; PG8_LDA(At, 0, 0); PG8_STAGE(PG8_SA(1, 1), a1 + hstep, voffA);
            PG8_WAIT_V(8); PG8_WAIT_L(0); PG8_BAR; PG8_MMA(0, 0, At, B0); PG8_MMA(0, 1, At, B1); PG8_BAR; PG8_SCHED;
            PG8_LDA(At, 0, 1); PG8_STAGE(PG8_SB(0, 0), b2, voffB); PG8_STAGE(PG8_SB(0, 1), b2 + hstep, voffB); PG8_STAGE(PG8_SA(0, 0), a2, voffA);
            PG8_WAIT_V(8); PG8_WAIT_L(0); PG8_BAR; PG8_MMA(1, 0, At, B0); PG8_MMA(1, 1, At, B1); PG8_BAR; PG8_SCHED;
            PG8_LDB(B0, 1, 0); PG8_LDB(B1, 1, 1); PG8_SCHED; PG8_LDA(At, 1, 0); PG8_STAGE(PG8_SA(0, 1), a2 + hstep, voffA);
            PG8_WAIT_V(8); PG8_WAIT_L(0); PG8_BAR; PG8_MMA(0, 0, At, B0); PG8_MMA(0, 1, At, B1); PG8_BAR; PG8_SCHED;
            PG8_LDA(At, 1, 1); PG8_STAGE(PG8_SB(1, 0), b3, voffB); PG8_STAGE(PG8_SB(1, 1), b3 + hstep, voffB); PG8_STAGE(PG8_SA(1, 0), a3, voffA);
            PG8_WAIT_V(8); PG8_WAIT_L(0); PG8_BAR; PG8_MMA(1, 0, At, B0); PG8_MMA(1, 1, At, B1); PG8_BAR; PG8_SCHED;
            } else {
            PG8_LDB(B0, 0, 0); PG8_SCHED; PG8_LDA(At, 0, 0); PG8_STAGE(PG8_SA(1, 1), a1 + hstep, voffA);
            PG8_WAIT_L(8); PG8_BAR; PG8_WAIT_L(0); PG8_MMA(0, 0, At, B0); PG8_BAR; PG8_SCHED;
            PG8_LDB(B1, 0, 1); PG8_STAGE(PG8_SB(0, 0), b2, voffB);
            PG8_BAR; PG8_WAIT_L(0); PG8_MMA(0, 1, At, B1); PG8_BAR;
            PG8_LDA(At, 0, 1); PG8_STAGE(PG8_SA(0, 0), a2, voffA);
            PG8_BAR; PG8_WAIT_L(0); PG8_MMA(1, 0, At, B0); PG8_BAR; PG8_SCHED;
            PG8_STAGE(PG8_SB(0, 1), b2 + hstep, voffB);
            PG8_WAIT_V(6); PG8_BAR; PG8_MMA(1, 1, At, B1); PG8_BAR;
            PG8_LDB(B0, 1, 0); PG8_SCHED; PG8_LDA(At, 1, 0); PG8_STAGE(PG8_SA(0, 1), a2 + hstep, voffA);
            PG8_WAIT_L(8); PG8_BAR; PG8_WAIT_L(0); PG8_MMA(0, 0, At, B0); PG8_BAR; PG8_SCHED;
            PG8_LDB(B1, 1, 1); PG8_STAGE(PG8_SB(1, 0), b3, voffB);
            PG8_BAR; PG8_WAIT_L(0); PG8_MMA(0, 1, At, B1); PG8_BAR;
            PG8_LDA(At, 1, 1); PG8_STAGE(PG8_SA(1, 0), a3, voffA);
            PG8_BAR; PG8_WAIT_L(0); PG8_MMA(1, 0, At, B0); PG8_BAR; PG8_SCHED;
            PG8_STAGE(PG8_SB(1, 1), b3 + hstep, voffB);
            PG8_WAIT_V(6); PG8_BAR; PG8_MMA(1, 1, At, B1); PG8_BAR;
            }
        }
        if constexpr (ALIGN_EPI) { if (wr == 0) PG8_BAR; }
        if constexpr (!Epi::AFTER_DRAIN) { E(acc, cur, wr, wc, fr, fq); S.done(cur); }
        if (!has_next) break;
#pragma unroll
        for (int a = 0; a < 2; ++a)
#pragma unroll
            for (int b = 0; b < 2; ++b)
#pragma unroll
                for (int m = 0; m < 4; ++m)
#pragma unroll
                    for (int n = 0; n < 2; ++n) acc[a][b][m][n] = (f32x4){0.f, 0.f, 0.f, 0.f};
        cur = nxt; cA = nA; cB = nB; ++ui;
        if constexpr (ALIGN_EPI) { if (wr == 1) PG8_BAR; }
    }
    PG8_WAIT_V(0);
    if constexpr (!ALIGN_EPI) { if (wr == 0) PG8_BAR; }
    PG8_BAR;
    if constexpr (Epi::AFTER_DRAIN) { E.fused(acc, cur, wr, wc, fr, fq, lds, wid, lane); S.done(cur); }
#undef PG8_SA
#undef PG8_SB
#undef PG8_STAGE
#undef PG8_LDA
#undef PG8_LDB
#undef PG8_MMA
#undef PG8_WAIT_V
#undef PG8_WAIT_L
#undef PG8_BAR
#undef PG8_SCHED
}
}
namespace att {
using bf16 = unsigned short;
constexpr int D = 128, NW = 8, QBLK = 32, KVBLK = 64;
constexpr float SCALE = 0.088388347648318440f;
constexpr float THR = 8.f;
using f32x4 = __attribute__((ext_vector_type(4))) float;
using bf16x8 = __attribute__((ext_vector_type(8))) short;
using s16x4  = __attribute__((ext_vector_type(4))) short;
using f32x16 = __attribute__((ext_vector_type(16))) float;
using f32x8  = __attribute__((ext_vector_type(8))) float;
using u32x4  = __attribute__((ext_vector_type(4))) unsigned;
#define KSWZ(row, colB) ((row) * 256 + ((colB) ^ (((row) & 7) << 4)))
#define SBAR() __builtin_amdgcn_sched_barrier(0)
__device__ __forceinline__ int crow(int r, int hi) { return (r & 3) + 8 * (r >> 2) + 4 * hi; }
__device__ __forceinline__ unsigned cvtpk(float lo, float hi) {
  unsigned r; asm volatile("v_cvt_pk_bf16_f32 %0, %1, %2" : "=v"(r) : "v"(lo), "v"(hi)); return r;
}
__device__ __forceinline__ void partialSM(f32x16& p0, f32x16& p1, float& m_reg, float& mn, float& alpha) {
  constexpr float C = SCALE * 1.4426950408889634f;
  float pmax = p0[0]; for (int r = 1; r < 16; ++r) pmax = fmaxf(pmax, p0[r]); for (int r = 0; r < 16; ++r) pmax = fmaxf(pmax, p1[r]);
  { auto rr = __builtin_amdgcn_permlane32_swap(__float_as_uint(pmax), __float_as_uint(pmax), false, false);
    pmax = fmaxf(__uint_as_float(rr[0]), __uint_as_float(rr[1])); }
  if (__builtin_expect(__all(pmax - m_reg <= THR / SCALE), 1)) { mn = m_reg; alpha = 1.f; }
  else { mn = fmaxf(m_reg, pmax); alpha = __builtin_amdgcn_exp2f((m_reg - mn) * C); m_reg = mn; }
  float mnC = -mn * C;
  for (int r = 0; r < 16; ++r) p0[r] = fmaf(p0[r], C, mnC); for (int r = 0; r < 16; ++r) p1[r] = fmaf(p1[r], C, mnC);
  for (int r = 0; r < 16; ++r) p0[r] = __builtin_amdgcn_exp2f(p0[r]);
}
__device__ __forceinline__ void finishSM(f32x16& p0, f32x16& p1, float alpha, float& l_reg, bf16x8& pa0, bf16x8& pa1, bf16x8& pa2, bf16x8& pa3) {
  for (int r = 0; r < 16; ++r) p1[r] = __builtin_amdgcn_exp2f(p1[r]);
  float ps = 0; for (int r = 0; r < 16; ++r) ps += p0[r]; for (int r = 0; r < 16; ++r) ps += p1[r];
  { auto rr = __builtin_amdgcn_permlane32_swap(__float_as_uint(ps), __float_as_uint(ps), false, false);
    ps = __uint_as_float(rr[0]) + __uint_as_float(rr[1]); }
  l_reg = l_reg * alpha + ps;
#define PK4(P, BASE, OUT) do { unsigned a0 = cvtpk(P[BASE + 0], P[BASE + 1]), a1 = cvtpk(P[BASE + 2], P[BASE + 3]);   \
    unsigned b0 = cvtpk(P[BASE + 4], P[BASE + 5]), b1 = cvtpk(P[BASE + 6], P[BASE + 7]);                              \
    auto r0 = __builtin_amdgcn_permlane32_swap(a0, b0, false, false); auto r1 = __builtin_amdgcn_permlane32_swap(a1, b1, false, false); \
    u32x4 w = {r0[0], r1[0], r0[1], r1[1]}; OUT = *reinterpret_cast<bf16x8*>(&w); } while (0)
  PK4(p0, 0, pa0); PK4(p0, 8, pa1); PK4(p1, 0, pa2); PK4(p1, 8, pa3);
#undef PK4
}
__device__ __forceinline__ void qkt(f32x16& p0, f32x16& p1, const bf16* Ks, const bf16x8* qr, int r32, int hi) {
  p0 = f32x16{}; p1 = f32x16{};
  for (int d0 = 0; d0 < 8; ++d0) { int cb = (d0 * 16 + hi * 8) * 2;
    bf16x8 b0 = *reinterpret_cast<const bf16x8*>((const char*)Ks + KSWZ(r32, cb));
    bf16x8 b1 = *reinterpret_cast<const bf16x8*>((const char*)Ks + KSWZ(32 + r32, cb));
    p0 = __builtin_amdgcn_mfma_f32_32x32x16_bf16(b0, qr[d0], p0, 0, 0, 0);
    p1 = __builtin_amdgcn_mfma_f32_32x32x16_bf16(b1, qr[d0], p1, 0, 0, 0); }
}
__device__ __forceinline__ int v_st(int k, int c) { const int kk = (k & ~0xC) | ((k & 4) << 1) | ((k & 8) >> 1); return ((kk >> 3) * 4 + (c >> 5)) * 512 + ((kk & 7) * 32 + (c & 31)) * 2; }
__device__ __forceinline__ int v_rd_base(int lane) { return ((lane & 3) << 3) | (((lane >> 2) & 3) << 6) | (((lane >> 4) & 1) << 5) | (((lane >> 5) & 1) << 8); }
constexpr int v_rd_off(int d0, int ks, int half) { return d0 * 512 + ks * 4096 + half * 2048; }
template <int OFF> __device__ __forceinline__ s16x4 tr_read(int vb) {
  s16x4 r; asm volatile("ds_read_b64_tr_b16 %0, %1 offset:%2" : "=&v"(r) : "v"(vb), "i"(OFF) : "memory"); return r;
}
template <int D0> __device__ __forceinline__ void pv_one(f32x16& od, int vb, bf16x8 pa0, bf16x8 pa1, bf16x8 pa2, bf16x8 pa3) {
  const s16x4 l0 = tr_read<v_rd_off(D0, 0, 0)>(vb), h0 = tr_read<v_rd_off(D0, 0, 1)>(vb), l1 = tr_read<v_rd_off(D0, 1, 0)>(vb), h1 = tr_read<v_rd_off(D0, 1, 1)>(vb);
  const s16x4 l2 = tr_read<v_rd_off(D0, 2, 0)>(vb), h2 = tr_read<v_rd_off(D0, 2, 1)>(vb), l3 = tr_read<v_rd_off(D0, 3, 0)>(vb), h3 = tr_read<v_rd_off(D0, 3, 1)>(vb);
  asm volatile("s_waitcnt lgkmcnt(0)" ::: "memory"); SBAR();
#define PK(L, H) (bf16x8){L[0], L[1], L[2], L[3], H[0], H[1], H[2], H[3]}
  od = __builtin_amdgcn_mfma_f32_32x32x16_bf16(pa0, PK(l0, h0), od, 0, 0, 0);
  od = __builtin_amdgcn_mfma_f32_32x32x16_bf16(pa1, PK(l1, h1), od, 0, 0, 0);
  od = __builtin_amdgcn_mfma_f32_32x32x16_bf16(pa2, PK(l2, h2), od, 0, 0, 0);
  od = __builtin_amdgcn_mfma_f32_32x32x16_bf16(pa3, PK(l3, h3), od, 0, 0, 0);
#undef PK
}
__device__ __forceinline__ void pv_d0(f32x16* o, int vb, bf16x8 pa0, bf16x8 pa1, bf16x8 pa2, bf16x8 pa3) {
  pv_one<0>(o[0], vb, pa0, pa1, pa2, pa3); pv_one<1>(o[1], vb, pa0, pa1, pa2, pa3); pv_one<2>(o[2], vb, pa0, pa1, pa2, pa3); pv_one<3>(o[3], vb, pa0, pa1, pa2, pa3);
}
constexpr int DMODEL = 4096;
constexpr size_t SHM_V = 64 * 128 * 2, SHM_K = 64 * 128 * 2;
constexpr int ATT_WS_OFF = 2 * SHM_V + 2 * SHM_K, ATT_TAB_OFF = ATT_WS_OFF + 8 * 256, ATT_OST_OFF = ATT_TAB_OFF + 704 * 4 + 256  , ATT_LDS_BYTES = ATT_OST_OFF + 8 * 8192;
constexpr float LOG2E = 1.4426950408889634f;
__device__ __forceinline__ float bf2f(bf16 v) { return __uint_as_float((unsigned)v << 16); }
__device__ __forceinline__ bf16 f2bf(float f) { return (bf16)(cvtpk(f, 0.f) & 0xffffu); }
__device__ __forceinline__ float silu_f(float g) { return g * __builtin_amdgcn_rcpf(1.0f + __builtin_amdgcn_exp2f(-g * LOG2E)); }
__device__ __forceinline__ void pack_p(const f32x16& p0, const f32x16& p1, bf16x8& pa0, bf16x8& pa1, bf16x8& pa2, bf16x8& pa3) {
#define PK4(P, BASE, OUT) do { unsigned a0 = cvtpk(P[BASE + 0], P[BASE + 1]), a1 = cvtpk(P[BASE + 2], P[BASE + 3]);   \
    unsigned b0 = cvtpk(P[BASE + 4], P[BASE + 5]), b1 = cvtpk(P[BASE + 6], P[BASE + 7]);                              \
    auto r0 = __builtin_amdgcn_permlane32_swap(a0, b0, false, false); auto r1 = __builtin_amdgcn_permlane32_swap(a1, b1, false, false); \
    u32x4 w = {r0[0], r1[0], r0[1], r1[1]}; OUT = *reinterpret_cast<bf16x8*>(&w); } while (0)
  PK4(p0, 0, pa0); PK4(p0, 8, pa1); PK4(p1, 0, pa2); PK4(p1, 8, pa3);
#undef PK4
}
template <int ZP>
__device__ __forceinline__ void store_gated(const f32x16* o, float l_reg, float* li_l, float* ost, const bf16* Gb, bf16* Yb, int wid, int lane, int r32, int hi) {
  if (hi == 0) li_l[r32] = l_reg;
  const int rr = lane >> 3, c8 = (lane & 7) * 8;
  u32x4 g[2][4];
#pragma unroll
  for (int h = 0; h < 2; ++h)
#pragma unroll
    for (int i = 0; i < 4; ++i) g[h][i] = *reinterpret_cast<const u32x4*>((const char*)Gb + (unsigned)(((wid * 32 + 8 * i + rr) * ZP + h * 64 + c8) * 2));
#pragma unroll
  for (int h = 0; h < 2; ++h) {
#pragma unroll
    for (int d = 0; d < 2; ++d)
#pragma unroll
      for (int r = 0; r < 16; ++r) ost[crow(r, hi) * 64 + d * 32 + r32] = o[2 * h + d][r];
    asm volatile("s_waitcnt lgkmcnt(0)" ::: "memory");
#pragma unroll
    for (int i = 0; i < 4; ++i) { const int row = 8 * i + rr;
      const f32x4 a = *reinterpret_cast<const f32x4*>(ost + row * 64 + c8), b = *reinterpret_cast<const f32x4*>(ost + row * 64 + c8 + 4);
      const float rl = __builtin_amdgcn_rcpf(li_l[row]); const u32x4 gg = g[h][i];
      u32x4 w;
      w.x = cvtpk(a[0] * rl * silu_f(__uint_as_float(gg.x << 16)), a[1] * rl * silu_f(__uint_as_float(gg.x & 0xffff0000u)));
      w.y = cvtpk(a[2] * rl * silu_f(__uint_as_float(gg.y << 16)), a[3] * rl * silu_f(__uint_as_float(gg.y & 0xffff0000u)));
      w.z = cvtpk(b[0] * rl * silu_f(__uint_as_float(gg.z << 16)), b[1] * rl * silu_f(__uint_as_float(gg.z & 0xffff0000u)));
      w.w = cvtpk(b[2] * rl * silu_f(__uint_as_float(gg.w << 16)), b[3] * rl * silu_f(__uint_as_float(gg.w & 0xffff0000u)));
      *reinterpret_cast<u32x4*>((char*)Yb + (unsigned)(((wid * 32 + row) * DMODEL + h * 64 + c8) * 2)) = w; }
    asm volatile("s_waitcnt lgkmcnt(0)" ::: "memory");
  }
}

template <int ZP>
__device__ __forceinline__ void dense_unit(const bf16* Qb, const bf16* Kh, const bf16* Vh, const bf16* Gb, bf16* Yb, int seq, char* lds) {
  int tid_ = threadIdx.x; asm volatile("" : "+v"(tid_));
  const int tid = tid_, wid = __builtin_amdgcn_readfirstlane(tid >> 6), lane = tid & 63, r32 = lane & 31, hi = lane >> 5;
  bf16* V_lds = (bf16*)lds; bf16* K_lds = (bf16*)(lds + 2 * SHM_V);
  float* ws = (float*)(lds + ATT_WS_OFF) + wid * 64; float* li_l = ws; float* al_l = ws + 32;
  float m_reg = -1e30f, l_reg = 0; f32x16 o[4] = {}; bf16x8 qr[8];
  { const unsigned qoff = (unsigned)((wid * QBLK + r32) * ZP + hi * 8) * 2u;
#pragma unroll
    for (int d0 = 0; d0 < 8; ++d0) qr[d0] = *reinterpret_cast<const bf16x8*>((const char*)Qb + qoff + d0 * 32); }
  const int sr = tid >> 4, sc = (tid & 15) * 8, vst0 = v_st(sr, sc), vst1 = v_st(32 + sr, sc);
  const int vb0 = (int)(uintptr_t)V_lds + v_rd_base(lane);
  struct { bf16x8 vs0, vs1, ks0, ks1; } sr_[2];
  const unsigned soff = (unsigned)(sr * ZP + sc) * 2u;
#define SLOAD(i, k0) do { const char* vp_ = (const char*)Vh + (size_t)(k0) * (ZP * 2); const char* kp_ = (const char*)Kh + (size_t)(k0) * (ZP * 2); \
    sr_[i].vs0 = *reinterpret_cast<const bf16x8*>(vp_ + soff); sr_[i].vs1 = *reinterpret_cast<const bf16x8*>(vp_ + 32 * ZP * 2 + soff); \
    sr_[i].ks0 = *reinterpret_cast<const bf16x8*>(kp_ + soff); sr_[i].ks1 = *reinterpret_cast<const bf16x8*>(kp_ + 32 * ZP * 2 + soff); } while (0)
#define SWRITE(b, i) do { *(bf16x8*)((char*)V_lds + (b) * SHM_V + vst0) = sr_[i].vs0;          \
    *(bf16x8*)((char*)V_lds + (b) * SHM_V + vst1) = sr_[i].vs1; int kc = sc * 2;               \
    *(bf16x8*)((char*)K_lds + (b) * SHM_K + KSWZ(sr, kc)) = sr_[i].ks0;                       \
    *(bf16x8*)((char*)K_lds + (b) * SHM_K + KSWZ(32 + sr, kc)) = sr_[i].ks1; } while (0)
#define SWAIT() asm volatile("s_waitcnt vmcnt(4)" ::: "memory")
#define RESC(a) do { if (__any((a) < 1.f)) { if (hi == 0) al_l[r32] = (a); asm volatile("s_waitcnt lgkmcnt(0)" ::: "memory"); \
    for (int d = 0; d < 4; ++d) for (int r = 0; r < 16; ++r) o[d][r] *= al_l[crow(r, hi)]; } } while (0)
  f32x16 pA0, pA1, pB0, pB1; float mnA, mnB, alA, alB; bf16x8 pa0, pa1, pa2, pa3; const int NT = seq / KVBLK;
  constexpr int SE = 0, SO = 1;
  SLOAD(SE, 0); asm volatile("s_waitcnt vmcnt(0)" ::: "memory"); SWRITE(0, SE); __syncthreads();
  qkt(pA0, pA1, K_lds, qr, r32, hi); partialSM(pA0, pA1, m_reg, mnA, alA);
  SLOAD(SO, KVBLK); if (2 < NT) SLOAD(SE, 2 * KVBLK);
  SWAIT(); SWRITE(1, SO); __syncthreads();
  for (int j = 1; j + 1 < NT; j += 2) {
    SBAR(); qkt(pB0, pB1, (bf16*)((char*)K_lds + SHM_K), qr, r32, hi);
    finishSM(pA0, pA1, alA, l_reg, pa0, pa1, pa2, pa3); SBAR();
    SLOAD(SO, (j + 2) * KVBLK); SBAR();
    pv_d0(o, vb0, pa0, pa1, pa2, pa3); partialSM(pB0, pB1, m_reg, mnB, alB);
    __syncthreads(); SWAIT(); SWRITE(0, SE);
    RESC(alB); __syncthreads();
    SBAR(); qkt(pA0, pA1, K_lds, qr, r32, hi);
    finishSM(pB0, pB1, alB, l_reg, pa0, pa1, pa2, pa3); SBAR();
    if (j + 3 < NT) SLOAD(SE, (j + 3) * KVBLK); SBAR();
    pv_d0(o, vb0 + (int)SHM_V, pa0, pa1, pa2, pa3); partialSM(pA0, pA1, m_reg, mnA, alA);
    __syncthreads(); SWAIT(); SWRITE(1, SO);
    RESC(alA); __syncthreads();
  }
  SBAR(); qkt(pB0, pB1, (bf16*)((char*)K_lds + SHM_K), qr, r32, hi);
  finishSM(pA0, pA1, alA, l_reg, pa0, pa1, pa2, pa3); SBAR();
  pv_d0(o, vb0, pa0, pa1, pa2, pa3); partialSM(pB0, pB1, m_reg, mnB, alB);
  __syncthreads(); RESC(alB);
  finishSM(pB0, pB1, alB, l_reg, pa0, pa1, pa2, pa3); SBAR();
  pv_d0(o, vb0 + (int)SHM_V, pa0, pa1, pa2, pa3);
  store_gated<ZP>(o, l_reg, li_l, (float*)(lds + ATT_OST_OFF) + wid * 2048, Gb, Yb, wid, lane, r32, hi);
#undef SLOAD
#undef SWRITE
#undef SWAIT
}

template <int MODE, int ZP>
__device__ __forceinline__ void local_unit(const bf16* Qb, const bf16* Kh, const bf16* Vh, const bf16* Gb, bf16* Yb, char* lds,
                                           int jlo, int jhi, int wlo, int whi, int pa, float fa, float fb, const float* rpbh) {
  int tid_ = threadIdx.x; asm volatile("" : "+v"(tid_));
  const int tid = tid_, wid = __builtin_amdgcn_readfirstlane(tid >> 6), lane = tid & 63, r32 = lane & 31, hi = lane >> 5;
  bf16* V_lds = (bf16*)lds; bf16* K_lds = (bf16*)(lds + 2 * SHM_V);
  float* ws = (float*)(lds + ATT_WS_OFF) + wid * 64; float* li_l = ws; float* al_l = ws + 32;
  float* tab = (float*)(lds + ATT_TAB_OFF);
  __syncthreads();
  if (MODE == 1) { for (int i = tid; i < 465; i += 512) tab[64 + i] = rpbh[i] * LOG2E; }
  float m_reg = -1e30f, l_reg = 0; f32x16 o[4] = {}; bf16x8 qr[8];
  { const unsigned qoff = (unsigned)((wid * QBLK + r32) * ZP + hi * 8) * 2u;
#pragma unroll
    for (int d0 = 0; d0 < 8; ++d0) qr[d0] = *reinterpret_cast<const bf16x8*>((const char*)Qb + qoff + d0 * 32); }
  const int sr = tid >> 4, sc = (tid & 15) * 8, vst0 = v_st(sr, sc), vst1 = v_st(32 + sr, sc);
  const int vb0 = (int)(uintptr_t)V_lds + v_rd_base(lane);
  bf16x8 vs0, vs1, ks0, ks1;
  const unsigned soff = (unsigned)(sr * ZP + sc) * 2u;
#define LLOAD(k0) do { const char* vp_ = (const char*)Vh + (size_t)(k0) * (ZP * 2); const char* kp_ = (const char*)Kh + (size_t)(k0) * (ZP * 2); \
    vs0 = *reinterpret_cast<const bf16x8*>(vp_ + soff); vs1 = *reinterpret_cast<const bf16x8*>(vp_ + 32 * ZP * 2 + soff); \
    ks0 = *reinterpret_cast<const bf16x8*>(kp_ + soff); ks1 = *reinterpret_cast<const bf16x8*>(kp_ + 32 * ZP * 2 + soff); } while (0)
#define LWRITE(b) do { *(bf16x8*)((char*)V_lds + (b) * SHM_V + vst0) = vs0; *(bf16x8*)((char*)V_lds + (b) * SHM_V + vst1) = vs1; int kc = sc * 2;               \
    *(bf16x8*)((char*)K_lds + (b) * SHM_K + KSWZ(sr, kc)) = ks0; *(bf16x8*)((char*)K_lds + (b) * SHM_K + KSWZ(32 + sr, kc)) = ks1; } while (0)
  constexpr float C = SCALE * LOG2E;
  const float NEG_INF = -__builtin_inff();
  int cq = 0, cs = 0, tq = 0;
  if (MODE == 1) { cq = 32 * (wid & 1) + r32; cs = cq - 8; cs = cs < 0 ? 0 : (cs > 48 ? 48 : cs); }
  else { tq = pa + wid * QBLK + r32; }
  LLOAD(jlo * KVBLK);
  for (int j = jlo; j < jhi; ++j) {
    const int b = (j - jlo) & 1;
    asm volatile("s_waitcnt vmcnt(0)" ::: "memory"); LWRITE(b);
    if (j + 1 < jhi) LLOAD((j + 1) * KVBLK);
    __syncthreads();
    if (j >= wlo && j < whi) {
      f32x16 p0, p1;
      qkt(p0, p1, (bf16*)((char*)K_lds + b * SHM_K), qr, r32, hi);
      if (MODE == 1) {
        const float* trow = tab + 64 + (j - pa + 7) * 31 + 15 + 4 * hi - cq;
        const int cb = 4 * hi - cs;
#pragma unroll
        for (int r = 0; r < 16; ++r) { const int kc0 = (r & 3) + 8 * (r >> 2);
          p0[r] = ((unsigned)(kc0 + cb) < 16u) ? fmaf(p0[r], C, trow[kc0]) : NEG_INF;
          p1[r] = ((unsigned)(kc0 + 32 + cb) < 16u) ? fmaf(p1[r], C, trow[kc0 + 32]) : NEG_INF; }
      } else {
        const int base = j * KVBLK + 4 * hi - tq;
#pragma unroll
        for (int r = 0; r < 16; ++r) { const int kc0 = (r & 3) + 8 * (r >> 2);
          const int d0 = kc0 + base, d1 = d0 + 32; const int a0 = d0 < 0 ? -d0 : d0, a1 = d1 < 0 ? -d1 : d1;
          p0[r] = (a0 <= 128) ? fmaf(p0[r], C, -fa * (float)a0) : NEG_INF;
          p1[r] = (a1 <= 128) ? fmaf(p1[r], C, -fa * (float)a1) : NEG_INF; }
      }
      float pmax = p0[0];
#pragma unroll
      for (int r = 1; r < 16; ++r) pmax = fmaxf(pmax, p0[r]);
#pragma unroll
      for (int r = 0; r < 16; ++r) pmax = fmaxf(pmax, p1[r]);
      { auto rr = __builtin_amdgcn_permlane32_swap(__float_as_uint(pmax), __float_as_uint(pmax), false, false);
        pmax = fmaxf(__uint_as_float(rr[0]), __uint_as_float(rr[1])); }
      const float mn = fmaxf(m_reg, pmax); const float alpha = __builtin_amdgcn_exp2f(m_reg - mn); m_reg = mn;
      float ps = 0.f;
#pragma unroll
      for (int r = 0; r < 16; ++r) { p0[r] = __builtin_amdgcn_exp2f(p0[r] - mn); p1[r] = __builtin_amdgcn_exp2f(p1[r] - mn); ps += p0[r] + p1[r]; }
      { auto rr = __builtin_amdgcn_permlane32_swap(__float_as_uint(ps), __float_as_uint(ps), false, false);
        ps = __uint_as_float(rr[0]) + __uint_as_float(rr[1]); }
      l_reg = l_reg * alpha + ps;
      RESC(alpha);
      bf16x8 pa0, pa1, pa2, pa3;
      pack_p(p0, p1, pa0, pa1, pa2, pa3);
      pv_d0(o, vb0 + b * (int)SHM_V, pa0, pa1, pa2, pa3);
    }
  }
  if (MODE == 2) l_reg += __builtin_amdgcn_exp2f(fb - m_reg);
  store_gated<ZP>(o, l_reg, li_l, (float*)(lds + ATT_OST_OFF) + wid * 2048, Gb, Yb, wid, lane, r32, hi);
#undef LLOAD
#undef LWRITE
#undef RESC
}
}
constexpr int NWAVES = 8;
constexpr int S = 8192, DM = 4096, HD = 128, DEPTH = 4;
constexpr int NIN_E = 13312, NIN_O = 10240;
constexpr int E_QA = 0, E_KA = 2048, E_VA = 2560, E_QB = 3072, E_KB = 5120, E_VB = 7168, E_G = 9216;
constexpr int O_Q = 0, O_K = 4096, O_V = 5120, O_G = 6144;
constexpr float NORM_EPS = 1e-6f;
constexpr size_t MiB = 1u << 20;
constexpr size_t WS_CTL = 0, CTL_ZERO_BYTES = 1 * MiB;
constexpr size_t WS_ROPE = 1 * MiB;
constexpr size_t WS_PART = 2 * MiB;
constexpr size_t WS_WIN_E = 8 * MiB, WIN_E_BYTES = (size_t)NIN_E * DM * 2;
constexpr size_t WS_WIN_O = WS_WIN_E + 2 * WIN_E_BYTES, WIN_O_BYTES = (size_t)NIN_O * DM * 2;
constexpr size_t WS_WOUT_E = WS_WIN_O + 2 * WIN_O_BYTES, WOUT_BYTES = (size_t)DM * DM * 2;
constexpr size_t WS_WOUT_O = WS_WOUT_E + 2 * WOUT_BYTES;
constexpr size_t WS_XB = WS_WOUT_O + 2 * WOUT_BYTES;
constexpr size_t WS_Y = WS_XB + (size_t)S * DM * 2;
constexpr size_t WS_Z = WS_Y + (size_t)S * DM * 2;
constexpr size_t WS_END = WS_Z + (size_t)S * NIN_E * 2;
constexpr int CW_BAR = 4096;
constexpr int RING_OFF = 0, RING_BYTES = 131072;
constexpr int LDSCTL_OFF = 143360, MISC_OFF = LDSCTL_OFF + 320;
constexpr int NRP_OFF = 131072;
constexpr int RSTD_OFF = 139264;
constexpr int LDS_BYTES = 147456;
static_assert(MISC_OFF + 128 <= LDS_BYTES && att::ATT_LDS_BYTES <= LDSCTL_OFF && RING_BYTES <= NRP_OFF && NRP_OFF + 8192 <= RSTD_OFF && RSTD_OFF + 1024 <= LDSCTL_OFF, "LDS map");

#define GAS __attribute__((address_space(1)))
#define LAS __attribute__((address_space(3)))
typedef unsigned short bf16;
typedef unsigned v4u __attribute__((ext_vector_type(4)));
typedef float f32x4 __attribute__((ext_vector_type(4)));
typedef GAS unsigned gu32;
#define LDS_WAIT() asm volatile("s_waitcnt lgkmcnt(0)" ::: "memory")
#define VM_WAIT() asm volatile("s_waitcnt vmcnt(0)" ::: "memory")
__device__ __forceinline__ unsigned pk2(float lo, float hi) { unsigned r; asm volatile("v_cvt_pk_bf16_f32 %0, %1, %2" : "=v"(r) : "v"(lo), "v"(hi)); return r; }
#define XB_TMO      128
#define XB_XCNT(j)  (256  + 64 * (j))
#define XB_XSUB(j)  (1280 + 64 * (j))
#define XB_XGEN(j)  (2304 + 64 * (j))
#define XB_TOP      3328
#define XB_TOPGEN   3392
#define XCD_BAR_WORDS 3456
#define XB_SPIN_CAP (1u << 18)

__device__ __forceinline__ unsigned xb_ld(unsigned* p)              { return __hip_atomic_load(p, __ATOMIC_RELAXED, __HIP_MEMORY_SCOPE_AGENT); }
__device__ __forceinline__ unsigned xb_add(unsigned* p, unsigned v) { return __hip_atomic_fetch_add(p, v, __ATOMIC_RELAXED, __HIP_MEMORY_SCOPE_AGENT); }
__device__ __forceinline__ unsigned xb_xcc_id() { return (unsigned)__builtin_amdgcn_s_getreg((3 << 11) | 20) & 0xFu; }
#define XB_SPIN(cond, bar) do { unsigned _sp = 0; while (cond) { __builtin_amdgcn_s_sleep(1); \
    if ((++_sp & 255u) == 0u) { if (xb_ld(&(bar)[XB_TMO])) break; if (_sp > XB_SPIN_CAP) { atomicAdd(&(bar)[XB_TMO], 1u); break; } } } } while (0)

struct XcdBarrier {
    unsigned* bar; unsigned x;
    volatile LAS unsigned* st;
};

__device__ __forceinline__ XcdBarrier xcd_barrier_post(unsigned* bar, volatile LAS unsigned* st) {
    XcdBarrier b; b.bar = bar; b.x = xb_xcc_id(); b.st = st;
    if (threadIdx.x == 0) (void)xb_add(&bar[XB_XCNT(b.x)], 1u);
    return b;
}
__device__ __forceinline__ void xcd_barrier_complete(unsigned* bar, unsigned x, unsigned& nloc, unsigned& nx) {
    const unsigned G = gridDim.x * gridDim.y * gridDim.z;
    unsigned sum, cnt, mine, sp = 0u;
    for (;;) {
        sum = 0u; cnt = 0u; mine = 0u;
#pragma unroll
        for (unsigned j = 0; j < 16; ++j) { const unsigned c = xb_ld(&bar[XB_XCNT(j)]); sum += c; cnt += (c > 0u) ? 1u : 0u; mine = (j == x) ? c : mine; }
        if (sum == G) break;
        __builtin_amdgcn_s_sleep(1);
        if ((++sp & 255u) == 0u) { if (xb_ld(&bar[XB_TMO])) break; if (sp > XB_SPIN_CAP) { atomicAdd(&bar[XB_TMO], 1u); break; } }
    }
    nloc = mine > 0u ? mine : 1u; nx = cnt > 0u ? cnt : 1u;
}

__device__ __forceinline__ void xcd_barrier(const XcdBarrier& b) {
    asm volatile("s_waitcnt vmcnt(0)" ::: "memory");
    __syncthreads();
    if (threadIdx.x == 0) {
        unsigned* bar = b.bar;
        __builtin_amdgcn_s_waitcnt(0);
        unsigned nloc = b.st[0], nx = b.st[1];
        if (nloc == 0u) { xcd_barrier_complete(bar, b.x, nloc, nx); b.st[0] = nloc; b.st[1] = nx; }
        const unsigned old = xb_add(&bar[XB_XSUB(b.x)], 1u);
        const unsigned gen = old / nloc;
        if (old + 1u == (gen + 1u) * nloc) {
            __builtin_amdgcn_fence(__ATOMIC_RELEASE, "agent");
            asm volatile("s_waitcnt vmcnt(0)" ::: "memory");
            const unsigned og = xb_add(&bar[XB_TOP], 1u);
            const unsigned tg = og / nx;
            if (og + 1u == (tg + 1u) * nx) xb_add(&bar[XB_TOPGEN], 1u);
            else XB_SPIN(xb_ld(&bar[XB_TOPGEN]) == tg, bar);
            __builtin_amdgcn_fence(__ATOMIC_ACQUIRE, "agent");
            xb_add(&bar[XB_XGEN(b.x)], 1u);
            asm volatile("s_waitcnt vmcnt(0)" ::: "memory");
        } else {
            XB_SPIN(xb_ld(&bar[XB_XGEN(b.x)]) == gen, bar);
            __builtin_amdgcn_fence(__ATOMIC_ACQUIRE, "agent");
            asm volatile("s_waitcnt vmcnt(0)" ::: "memory");
        }
    }
    __syncthreads();
}
struct Frame {
    LAS unsigned char* lds;
    volatile LAS unsigned* MISC;
    gu32* ctl;
    int tid, lane, wave;
    int vcu, G;
};
__device__ __forceinline__ float wave_sum(float v) {
#pragma unroll
    for (int o = 1; o < 64; o <<= 1) v += __shfl_xor(v, o);
    return v;
}
__device__ __forceinline__ void transpose_item(const float* W, int N, const float* kscale, bf16* WT, LAS float* scr, int item, int lane, int nperm = 0) {
    const int nnb = N >> 6, kb = item / nnb, nb = item - kb * nnb, k0 = kb << 6, n0 = nb << 6;
    const int lr = lane >> 4, lc = (lane & 15) << 2;
    f32x4 v[16];
#pragma unroll
    for (int i = 0; i < 16; ++i) v[i] = *(const f32x4*)(W + (size_t)(k0 + 4 * i + lr) * N + n0 + lc);
#pragma unroll
    for (int i = 0; i < 16; ++i) { const int k = 4 * i + lr; const float s = kscale ? kscale[k0 + k] : 1.0f;
        *(LAS f32x4*)(scr + k * 64 + (lc ^ (((k >> 3) & 3) << 3))) = v[i] * s; }
    LDS_WAIT(); asm volatile("" ::: "memory");
    const int c = lane & 7, nn = lane >> 3, f = (c & 3) << 3;
#pragma unroll
    for (int j = 0; j < 8; ++j) { const int n = nn + 8 * j; const LAS float* s = scr + (8 * c) * 64 + (n ^ f);
        v4u o; o.x = pk2(s[0 * 64], s[1 * 64]); o.y = pk2(s[2 * 64], s[3 * 64]); o.z = pk2(s[4 * 64], s[5 * 64]); o.w = pk2(s[6 * 64], s[7 * 64]);
        const int cn = n0 + n, dn = cn < nperm ? (cn & ~63) + 8 * ((cn & 31) >> 2) + 4 * ((cn >> 5) & 1) + (cn & 3) : cn;
        *(GAS v4u*)(WT + (size_t)dn * DM + k0 + 8 * c) = o; }
    LDS_WAIT(); asm volatile("" ::: "memory");
}

struct Args { const float* in[11]; float* out; unsigned char* ws; int ph_lo, ph_hi; };
constexpr int PH_FINAL = 1 + 4 * DEPTH, PH_END = PH_FINAL + 1;
#ifndef GEMM_SP2
#define GEMM_SP2 true
#endif
#ifndef GEMM_ALIGN
#define GEMM_ALIGN true
#endif
#ifndef REP_PRO
#define REP_PRO 1
#endif
#ifndef REP_IN
#define REP_IN 1
#endif
#ifndef REP_OUT0
#define REP_OUT0 1
#endif
#ifndef REP_DENSE
#define REP_DENSE 1
#endif
#ifndef REP_LOCAL
#define REP_LOCAL 1
#endif

__global__ void __launch_bounds__(NWAVES * 64, 2) mk_fwd(Args args) {
    extern __shared__ __attribute__((aligned(16))) unsigned char lds[];
    Frame F;
    F.lds = (LAS unsigned char*)lds;
    F.MISC = (volatile LAS unsigned*)(F.lds + MISC_OFF);
    F.tid = threadIdx.x; F.lane = F.tid & 63; F.wave = __builtin_amdgcn_readfirstlane(F.tid >> 6);
    F.G = gridDim.x; { const int bx = blockIdx.x; F.vcu = (F.G % 8 == 0) ? (bx % 8) * (F.G / 8) + bx / 8 : bx; }
    unsigned char* ws = args.ws;
    F.ctl = (gu32*)(ws + WS_CTL);
    for (int u = F.tid; u < (LDS_BYTES - LDSCTL_OFF) / 4; u += NWAVES * 64) ((LAS unsigned*)(F.lds + LDSCTL_OFF))[u] = 0u;
    __syncthreads();
    const int lo = args.ph_lo, hi = args.ph_hi;
    const bool use_bar = (hi - lo) > 1;
    XcdBarrier bar; bar.bar = (unsigned*)(F.ctl + CW_BAR); bar.x = 0; bar.st = nullptr;
    if (use_bar) bar = xcd_barrier_post((unsigned*)(F.ctl + CW_BAR), F.MISC + 8);
#define IN(k) (lo <= (k) && (k) < hi)
#define SEAM(k) do { if (IN(k) && IN((k) + 1)) xcd_barrier(bar); } while (0)

    const float* x_in = args.in[0];
    float* X = args.out;
    float* PART = (float*)(ws + WS_PART);
    bf16* XB = (bf16*)(ws + WS_XB); bf16* Y = (bf16*)(ws + WS_Y); bf16* Z = (bf16*)(ws + WS_Z);
    float* ROPE = (float*)(ws + WS_ROPE);
    const int gw = F.vcu * NWAVES + F.wave, NGW = F.G * NWAVES;

    if (IN(0)) {
      _Pragma("nounroll") for (int rep = 0; rep < REP_PRO; ++rep) {
        LAS float* scr = (LAS float*)(F.lds + RING_OFF + F.wave * 16384);
        constexpr int I_INE = 64 * (NIN_E / 64), I_INO = 64 * (NIN_O / 64), I_OUT = 64 * (DM / 64);
        constexpr int NITEMS = 2 * I_INE + 2 * I_INO + 4 * I_OUT;
        for (int it = gw; it < NITEMS; it += NGW) {
            int r = it;
            if (r < 2 * I_INE) { const int e = r / I_INE; r -= e * I_INE;
                transpose_item(args.in[2] + (size_t)e * DM * NIN_E, NIN_E, args.in[1] + (2 * e) * DM, (bf16*)(ws + WS_WIN_E + e * WIN_E_BYTES), scr, r, F.lane, E_VA); continue; }
            r -= 2 * I_INE;
            if (r < 2 * I_INO) { const int e = r / I_INO; r -= e * I_INO;
                transpose_item(args.in[7] + (size_t)e * DM * NIN_O, NIN_O, args.in[1] + (2 * e + 1) * DM, (bf16*)(ws + WS_WIN_O + e * WIN_O_BYTES), scr, r, F.lane); continue; }
            r -= 2 * I_INO;
            if (r < 2 * I_OUT) { const int e = r / I_OUT; r -= e * I_OUT;
                transpose_item(args.in[3] + (size_t)e * DM * DM, DM, nullptr, (bf16*)(ws + WS_WOUT_E + e * WOUT_BYTES), scr, r, F.lane); continue; }
            r -= 2 * I_OUT;
            { const int e = r / I_OUT; r -= e * I_OUT;
                transpose_item(args.in[8] + (size_t)e * DM * DM, DM, nullptr, (bf16*)(ws + WS_WOUT_O + e * WOUT_BYTES), scr, r, F.lane); }
        }
        for (int m = gw; m < S; m += NGW) {
            const GAS f32x4* xr = (const GAS f32x4*)(x_in + (size_t)m * DM) + F.lane;
            GAS unsigned long long* o8 = (GAS unsigned long long*)(XB + (size_t)m * DM) + F.lane;
            float ss = 0.f;
#pragma unroll
            for (int j = 0; j < 16; ++j) { const f32x4 v = xr[64 * j]; ss += (v.x * v.x + v.y * v.y) + (v.z * v.z + v.w * v.w);
                o8[64 * j] = (unsigned long long)pk2(v.x, v.y) | ((unsigned long long)pk2(v.z, v.w) << 32); }
            ss = wave_sum(ss);
            PART[(size_t)m * 64 + F.lane] = F.lane == 0 ? ss : 0.f;
        }
        for (int i = blockIdx.x * 512 + F.tid; i < 128 * 32; i += F.G * 512) {
            const int p = i >> 5, k = i & 31;
            double inv = 1.0; for (int q = 0; q < k; ++q) inv *= 0.7498942093324558;
            const double ang = (double)p * inv, n = __builtin_rint(ang * 0.6366197723675814);
            double r = __builtin_fma(-n, 1.5707963267948966, ang); r = __builtin_fma(-n, 6.123233995736766e-17, r);
            const double r2 = r * r;
            double sp = 2.8114572543455206e-15; sp = sp * r2 - 7.647163731819816e-13; sp = sp * r2 + 1.6059043836821613e-10; sp = sp * r2 - 2.505210838544172e-08; sp = sp * r2 + 2.7557319223985893e-06;
            sp = sp * r2 - 0.0001984126984126984; sp = sp * r2 + 0.008333333333333333; sp = sp * r2 - 0.16666666666666666; sp = sp * r2 + 1.0; sp *= r;
            double cp = 1.5619206968586225e-16; cp = cp * r2 - 4.779477332387385e-14; cp = cp * r2 + 1.1470745597729725e-11; cp = cp * r2 - 2.08767569878681e-09; cp = cp * r2 + 2.755731922398589e-07;
            cp = cp * r2 - 2.48015873015873e-05; cp = cp * r2 + 0.001388888888888889; cp = cp * r2 - 0.041666666666666664; cp = cp * r2 + 0.5; cp = 1.0 - cp * r2;
            const int q4 = (int)n & 3;
            const double cv = q4 == 0 ? cp : (q4 == 1 ? -sp : (q4 == 2 ? -cp : sp)), sv = q4 == 0 ? sp : (q4 == 1 ? cp : (q4 == 2 ? -sp : -cp));
            ROPE[2 * i] = (float)cv; ROPE[2 * i + 1] = (float)sv;
        }
      }
    }
    SEAM(0);

    for (int L = 0; L < DEPTH; ++L) {
        const int e = L >> 1; const bool even = (L & 1) == 0;
        const int NIN = even ? NIN_E : NIN_O;
        const int pb = 1 + 4 * L;
        if (IN(pb)) {
            const bf16* Wt = (const bf16*)(ws + (even ? WS_WIN_E + e * WIN_E_BYTES : WS_WIN_O + e * WIN_O_BYTES));
            pg8::Gemm g{XB, Wt, S, NIN, DM}; pg8::StaticOrder So; So.init(S, NIN, F.G, (int)blockIdx.x);
            LAS float* rstd = (LAS float*)(F.lds + RSTD_OFF);
            { pg8::Unit u0; So.next(0, u0);
                int t_ = F.tid; asm volatile("" : "+v"(t_));
                const f32x4* pp = (const f32x4*)(PART + (size_t)(u0.pm * 256 + (t_ >> 1)) * 64 + (t_ & 1) * 32);
                f32x4 a = pp[0] + pp[1], b = pp[2] + pp[3], c = pp[4] + pp[5], d = pp[6] + pp[7]; a = (a + b) + (c + d);
                float s = (a[0] + a[1]) + (a[2] + a[3]); s += __shfl_xor(s, 1);
                if (!(t_ & 1)) rstd[t_ >> 1] = 1.0f / sqrtf(s * (1.0f / DM) + NORM_EPS);
                __syncthreads(); }
            pg8::EpiIn E{Z, NIN, rstd, even ? E_VA / 256 : 0, args.in[4] + e * HD, args.in[5] + e * HD, ROPE, (LAS float*)(F.lds + NRP_OFF)};
#ifndef NO_GEMM_IN
            _Pragma("nounroll") for (int rep = 0; rep < REP_IN; ++rep)
            pg8::gemm_phase<pg8::EpiIn, pg8::StaticOrder, GEMM_ALIGN, GEMM_SP2>(F.lds + RING_OFF, g, So, E);
#endif
        }
        SEAM(pb);
        if (IN(pb + 2)) {
            const int xcd = (int)blockIdx.x & 7, slot = (int)blockIdx.x >> 3;
            char* al = (char*)lds + RING_OFF;
            if (even) {
                _Pragma("nounroll") for (int rep = 0; rep < REP_DENSE; ++rep)
                for (int u = (int)blockIdx.x; u < 512; u += F.G) {
                    const int h = (u / 256) * 8 + (u & 7), qb = (u & 255) >> 3, kvh = h >> 2;
                    const bf16* Zq = Z + (size_t)(qb * 256) * NIN_E;
#ifndef NO_DENSE
                    att::dense_unit<NIN_E>(Zq + E_QA + h * HD, Z + E_KA + kvh * HD, Z + E_VA + kvh * HD, Zq + E_G + h * HD, Y + (size_t)(qb * 256) * DM + h * HD, S, al);
#endif
                }
                _Pragma("nounroll") for (int rep = 0; rep < REP_LOCAL; ++rep)
                for (int u = (int)blockIdx.x; u < 512; u += F.G) {
                    const int h = (u / 256) * 8 + (u & 7), blk = (u & 255) >> 3;
                    const int r0 = 4 * blk, rw = r0 + (F.wave >> 1);
                    int jlo = r0 - 4; jlo = jlo < 0 ? 0 : (jlo > 120 ? 120 : jlo);
                    int jh = r0 + 3 - 4; jh = jh < 0 ? 0 : (jh > 120 ? 120 : jh); jh += 8;
                    int wlo = rw - 4; wlo = wlo < 0 ? 0 : (wlo > 120 ? 120 : wlo);
                    const bf16* Zq = Z + (size_t)(blk * 256) * NIN_E;
#ifndef NO_NA
                    att::local_unit<1, NIN_E>(Zq + E_QB + h * HD, Z + E_KB + h * HD, Z + E_VB + h * HD, Zq + E_G + 2048 + h * HD, Y + (size_t)(blk * 256) * DM + 2048 + h * HD, al,
                                              jlo, jh, wlo, wlo + 8, rw, 0.f, 0.f, args.in[6] + ((size_t)e * 16 + h) * 465);
#endif
                }
                (void)xcd; (void)slot;
            } else {
                _Pragma("nounroll") for (int rep = 0; rep < REP_LOCAL; ++rep)
                for (int u = (int)blockIdx.x; u < 1024; u += F.G) {
                    const int h = (u / 256) * 8 + (u & 7), qb = (u & 255) >> 3, kvh = h >> 2, i0 = qb * 256, q0 = i0 + F.wave * 32;
                    int klo = i0 - 128; klo = klo < 0 ? 0 : klo; int khi = i0 + 256 + 128; khi = khi > S ? S : khi;
                    int wl = q0 - 128; wl = wl < 0 ? 0 : wl; int wh = q0 + 31 + 128; wh = wh > S - 1 ? S - 1 : wh;
                    const float slope = exp2f(-8.0f * (float)(h + 1) / 32.0f);
                    const bf16* Zq = Z + (size_t)i0 * NIN_O;
#ifndef NO_WIN
                    att::local_unit<2, NIN_O>(Zq + O_Q + h * HD, Z + O_K + kvh * HD, Z + O_V + kvh * HD, Zq + O_G + h * HD, Y + (size_t)i0 * DM + h * HD, al,
                                              klo >> 6, khi >> 6, wl >> 6, (wh >> 6) + 1, i0, slope * att::LOG2E, args.in[9][e * 32 + h] * att::LOG2E, nullptr);
#endif
                }
            }
        }
        SEAM(pb + 2);
        if (IN(pb + 3)) {
            const bf16* Wt = (const bf16*)(ws + (even ? WS_WOUT_E : WS_WOUT_O) + e * WOUT_BYTES);
            pg8::Gemm g{Y, Wt, S, DM, DM}; pg8::StaticOrder So; So.init(S, DM, F.G, (int)blockIdx.x);
            pg8::EpiOut E{L == 0 ? x_in : X, X, XB, PART};
#ifndef NO_GEMM_OUT
            _Pragma("nounroll") for (int rep = 0; rep < (L == 0 ? REP_OUT0 : 1); ++rep)
            pg8::gemm_phase<pg8::EpiOut, pg8::StaticOrder, GEMM_ALIGN, GEMM_SP2>(F.lds + RING_OFF, g, So, E);
#endif
        }
        SEAM(pb + 3);
    }
    if (IN(PH_FINAL)) {
        const float* fw = args.in[10];
        for (int m = gw; m < S; m += NGW) {
            GAS f32x4* xr = (GAS f32x4*)(X + (size_t)m * DM) + F.lane;
            f32x4 v[16]; float ss = 0.f;
#pragma unroll
            for (int j = 0; j < 16; ++j) { v[j] = xr[64 * j]; ss += (v[j].x * v[j].x + v[j].y * v[j].y) + (v[j].z * v[j].z + v[j].w * v[j].w); }
            const float rs = 1.0f / sqrtf(wave_sum(ss) * (1.0f / DM) + NORM_EPS);
#pragma unroll
            for (int j = 0; j < 16; ++j) { const f32x4 w = ((const f32x4*)fw)[64 * j + F.lane]; xr[64 * j] = v[j] * rs * w; }
        }
    }
#undef IN
#undef SEAM
}

#ifndef MK_SPLIT
#define MK_SPLIT 0
#endif
extern "C" void kernel_launch(void* const* d_in, const int* in_sizes, int n_in, void* d_out, int out_size, void* d_ws, size_t ws_size, hipStream_t stream) {
    static int grid = 0;
    if (grid == 0) {
        if (n_in != 11 || in_sizes[0] != S * DM || out_size != S * DM || ws_size < WS_END) {
            fprintf(stderr, "kernel_launch: shape mismatch: n_in %d in0 %d out %d ws %zu (need %zu)\n", n_in, n_in > 0 ? in_sizes[0] : -1, out_size, ws_size, (size_t)WS_END); grid = -1; return; }
        int dev = 0, cus = 0, per_cu = 0;
        if (hipGetDevice(&dev) != hipSuccess || hipDeviceGetAttribute(&cus, hipDeviceAttributeMultiprocessorCount, dev) != hipSuccess) { grid = -1; return; }
        if (hipFuncSetAttribute((const void*)mk_fwd, hipFuncAttributeMaxDynamicSharedMemorySize, LDS_BYTES) != hipSuccess) { fprintf(stderr, "kernel_launch: hipFuncSetAttribute failed\n"); grid = -1; return; }
        if (hipOccupancyMaxActiveBlocksPerMultiprocessor(&per_cu, (const void*)mk_fwd, NWAVES * 64, LDS_BYTES) != hipSuccess || per_cu < 1)
            fprintf(stderr, "kernel_launch: note: occupancy query reports %d workgroups per CU\n", per_cu);
        (void)hipGetLastError();
        grid = cus;
        { const int Ns[3] = {NIN_E, NIN_O, DM};
            for (int k = 0; k < 3; ++k) for (int c = 0; c < grid; ++c) { pg8::StaticOrder So; So.init(S, Ns[k], grid, c); pg8::Unit u0, u; if (!So.next(0, u0)) continue;
                for (int i = 1; So.next(i, u); ++i) if (u.pm != u0.pm) { fprintf(stderr, "kernel_launch: unit order gives workgroup %d two row panels (N %d); nothing launched\n", c, Ns[k]); grid = -1; return; } } }
    }
    if (grid < 0) return;
    if (hipMemsetAsync((char*)d_ws + WS_CTL, 0, CTL_ZERO_BYTES, stream) != hipSuccess) { fprintf(stderr, "kernel_launch: memset failed\n"); return; }
    Args a{};
    for (int i = 0; i < 11; ++i) a.in[i] = (const float*)d_in[i];
    a.out = (float*)d_out; a.ws = (unsigned char*)d_ws;
#if MK_SPLIT
    for (int p = 0; p < PH_END; ++p) { a.ph_lo = p; a.ph_hi = p + 1; hipLaunchKernelGGL(mk_fwd, dim3(grid), dim3(NWAVES * 64), LDS_BYTES, stream, a); }
#else
    a.ph_lo = 0; a.ph_hi = PH_END;
    hipLaunchKernelGGL(mk_fwd, dim3(grid), dim3(NWAVES * 64), LDS_BYTES, stream, a);
#endif
    const hipError_t le = hipPeekAtLastError();
    if (le != hipSuccess) fprintf(stderr, "kernel_launch: launch failed: %s\n", hipGetErrorName(le));
}
```

```cpp
#include <hip/hip_runtime.h>
#include <cstdio>
#include <cstdint>
namespace pg8 {
#define PG8_LAS __attribute__((address_space(3)))
typedef unsigned short bf16_t;
typedef short bf16x8 __attribute__((ext_vector_type(8)));
typedef float f32x4 __attribute__((ext_vector_type(4)));
typedef unsigned u32x4 __attribute__((ext_vector_type(4)));
constexpr int BM = 256, BK = 64, HALF = 128, HTB = HALF * BK * 2  , STAGE_BYTES = 8 * HTB, NXCD = 8, WGM = 8;

__host__ __device__ __forceinline__ int lds_byte(int r, int c) { const int st = (r >> 4) * 2 + (c >> 5), rr = r & 15, cc = c & 31, ob = rr * 64 + cc * 2; return st * 1024 + (ob ^ (((ob >> 9) & 1) << 5)); }
__host__ __device__ __forceinline__ void stage_rc(int b, int& R, int& C) { const int st = b / 1024, sb = b % 1024, swz = sb ^ (((sb >> 9) & 1) << 5); R = (st >> 1) * 16 + swz / 64; C = (st & 1) * 32 + (swz % 64) / 2; }
__host__ __device__ __forceinline__ int perm32(int rho) { const int n = rho >> 4, i = rho & 15; return 8 * (i >> 2) + 4 * n + (i & 3); }

struct Unit { int pm, pn; };
struct Gemm { const bf16_t* A; const bf16_t* Bt; int M, N, K; };

struct StaticOrder {
    int nM, nN, nwg, G, c;
    __host__ __device__ void init(int M, int N, int G_, int c_) { nM = M / BM; nN = N / BM; nwg = nM * nN; G = G_; c = c_; }
    __host__ __device__ bool next(int i, Unit& u) const {
        const long L = (long)i * G + c; if (L >= nwg) return false;
        int wgid = (int)L; { const int q = nwg / NXCD, r = nwg % NXCD, xcd = wgid % NXCD, off = wgid / NXCD; wgid = (xcd < r ? xcd * (q + 1) : r * (q + 1) + (xcd - r) * q) + off; }
        const int nig = WGM * nN, gid = wgid / nig, fm = gid * WGM, gsz = (nM - fm) < WGM ? (nM - fm) : WGM;
        u.pm = fm + ((wgid % nig) % gsz); u.pn = (wgid % nig) / gsz; return true;
    }
    __device__ __forceinline__ void a_ready(const Unit&) const {}
    __device__ __forceinline__ void done(const Unit&) const {}
};

__device__ __forceinline__ unsigned cvt_pk_bf16(float lo, float hi) { unsigned r; asm volatile("v_cvt_pk_bf16_f32 %0, %1, %2" : "=v"(r) : "v"(lo), "v"(hi)); return r; }
typedef float f32x2 __attribute__((ext_vector_type(2)));
#ifndef NT_Z
#define NT_Z 0
#endif
#ifndef NT_X
#define NT_X 0
#endif
#if NT_Z
#define ST_Z(p, v) __builtin_nontemporal_store((v), (p))
#else
#define ST_Z(p, v) (*(p) = (v))
#endif
#if NT_X
#define ST_X(p, v) __builtin_nontemporal_store((v), (p))
#else
#define ST_X(p, v) (*(p) = (v))
#endif
struct EpiIn {
    static constexpr bool PERM = true, AFTER_DRAIN = false;
    bf16_t* Z; int ldz; const PG8_LAS float* rstd; float qscale; int sc_tiles;
    bf16_t* kv; int kv_t0, kv_t1;
    __device__ __forceinline__ void operator()(const f32x4 (&acc)[2][2][4][2], const Unit& u, int wr, int wc, int fr, int fq) const {
        const float cs = u.pn < sc_tiles ? qscale : 1.0f;
        const bool tokv = u.pn >= kv_t0 && u.pn < kv_t1;
        char* base = tokv ? (char*)(kv + (size_t)(u.pn - kv_t0) * 2 * 8192 * 128) : (char*)(Z + u.pn * BM);
        const unsigned pitch = tokv ? 256u : (unsigned)ldz * 2u, bjs = tokv ? 8192u * 256u : (unsigned)HALF * 2u;
        const unsigned lane_off = (unsigned)(u.pm * BM + wr * 64 + fr) * pitch + (unsigned)(wc * 32 + 8 * fq) * 2u;
#pragma unroll
        for (int ai = 0; ai < 2; ++ai)
#pragma unroll
            for (int m = 0; m < 4; ++m) {
                const float rs = rstd[ai * HALF + wr * 64 + m * 16 + fr] * cs;
                char* rowp = base + (lane_off + (unsigned)(ai * HALF + m * 16) * pitch);
#pragma unroll
                for (int bj = 0; bj < 2; ++bj) { const f32x4 v0 = acc[ai][bj][m][0] * rs, v1 = acc[ai][bj][m][1] * rs;
                    u32x4 w; w.x = cvt_pk_bf16(v0[0], v0[1]); w.y = cvt_pk_bf16(v0[2], v0[3]); w.z = cvt_pk_bf16(v1[0], v1[1]); w.w = cvt_pk_bf16(v1[2], v1[3]);
                    ST_Z((u32x4*)(rowp + bj * bjs), w); }
            }
    }
};
struct EpiInA {
    static constexpr bool PERM = true, AFTER_DRAIN = false;
    bf16_t* Z; int ldz; const PG8_LAS float* rstd; float zmul;
    const float* qn; const float* kn; const float* rope; PG8_LAS float* P; float qscale; unsigned char* q8; unsigned char* k8; unsigned char* vt8; int vt_pitch;
    __device__ __forceinline__ void operator()(const f32x4 (&acc)[2][2][4][2], const Unit& u, int wr, int wc, int fr_, int fq_) const {
        int fr = fr_, fq = fq_; asm volatile("" : "+v"(fr), "+v"(fq));
        const int row0 = u.pm * BM + wr * 64 + fr, col0 = (u.pn < 12 ? u.pn * BM : 9216 + (u.pn - 12) * BM) + wc * 32 + 8 * fq;
        const PG8_LAS float* rsp = rstd + wr * 64 + fr;
#define RS_(ai, m) (rsp[(ai) * HALF + (m) * 16] * zmul)
        if (vt8 && (u.pn == 10 || u.pn == 11)) {
            const int c0 = (u.pn - 10) * BM + wc * 32 + 8 * fq;
#pragma unroll
            for (int ai = 0; ai < 2; ++ai)
#pragma unroll
                for (int m = 0; m < 4; ++m) { const float r_ = RS_(ai, m); const int row = row0 + ai * HALF + m * 16;
#pragma unroll
                    for (int bj = 0; bj < 2; ++bj) { const f32x4 v0 = acc[ai][bj][m][0] * r_, v1 = acc[ai][bj][m][1] * r_;
                        int e0 = __builtin_amdgcn_cvt_pk_fp8_f32(v0[0], v0[1], 0, false); e0 = __builtin_amdgcn_cvt_pk_fp8_f32(v0[2], v0[3], e0, true);
                        int e1 = __builtin_amdgcn_cvt_pk_fp8_f32(v1[0], v1[1], 0, false); e1 = __builtin_amdgcn_cvt_pk_fp8_f32(v1[2], v1[3], e1, true);
                        unsigned char* dp = vt8 + (size_t)(c0 + bj * HALF) * vt_pitch + row;
                        dp[0] = (unsigned char)e0; dp[vt_pitch] = (unsigned char)(e0 >> 8); dp[2 * (size_t)vt_pitch] = (unsigned char)(e0 >> 16); dp[3 * (size_t)vt_pitch] = (unsigned char)((unsigned)e0 >> 24);
                        dp[4 * (size_t)vt_pitch] = (unsigned char)e1; dp[5 * (size_t)vt_pitch] = (unsigned char)(e1 >> 8); dp[6 * (size_t)vt_pitch] = (unsigned char)(e1 >> 16); dp[7 * (size_t)vt_pitch] = (unsigned char)((unsigned)e1 >> 24); } }
        } else if (u.pn >= 10) {
#pragma unroll
            for (int ai = 0; ai < 2; ++ai)
#pragma unroll
                for (int m = 0; m < 4; ++m) {
                    bf16_t* rowp = Z + (size_t)(row0 + ai * HALF + m * 16) * ldz + col0;
                    const float r_ = RS_(ai, m);
#pragma unroll
                    for (int bj = 0; bj < 2; ++bj) { const f32x4 v0 = acc[ai][bj][m][0] * r_, v1 = acc[ai][bj][m][1] * r_;
                        u32x4 w; w.x = cvt_pk_bf16(v0[0], v0[1]); w.y = cvt_pk_bf16(v0[2], v0[3]); w.z = cvt_pk_bf16(v1[0], v1[1]); w.w = cvt_pk_bf16(v1[2], v1[3]);
                        ST_Z((u32x4*)(rowp + bj * HALF), w); }
                }
        } else {
#pragma unroll
            for (int ai = 0; ai < 2; ++ai)
#pragma unroll
                for (int m = 0; m < 4; ++m) { const float r_ = RS_(ai, m);
#pragma unroll
                    for (int bj = 0; bj < 2; ++bj) { const f32x4 a = acc[ai][bj][m][0] * r_, b = acc[ai][bj][m][1] * r_;
                        float ss = ((a[0] * a[0] + a[1] * a[1]) + (a[2] * a[2] + a[3] * a[3])) + ((b[0] * b[0] + b[1] * b[1]) + (b[2] * b[2] + b[3] * b[3]));
                        ss += __shfl_xor(ss, 16); ss += __shfl_xor(ss, 32);
                        if (fq == 0) P[(ai * HALF + wr * 64 + m * 16 + fr) * 8 + bj * 4 + wc] = ss; } }
            asm volatile("s_waitcnt lgkmcnt(0)" ::: "memory"); __builtin_amdgcn_s_barrier(); asm volatile("" ::: "memory");
            const int hf = wc >> 1, i0 = (16 * wc + 4 * fq) & 31;
            const float* wn = (u.pn < 8 ? qn : kn) + 64 * hf + i0;
            const float qsc = u.pn < 8 ? qscale : 1.0f;
            const f32x4 w1 = *(const f32x4*)wn * qsc, w2 = *(const f32x4*)(wn + 32) * qsc;
            unsigned char* dst0 = u.pn < 8 ? q8 + col0 : k8 + (col0 - 2048);
            const int dpitch = u.pn < 8 ? 2048 : 512;
#pragma unroll
            for (int ai = 0; ai < 2; ++ai)
#pragma unroll
                for (int m = 0; m < 4; ++m) {
                    const int row = row0 + ai * HALF + m * 16, pos = hf ? (row & 63) : (row >> 6); const float r_ = RS_(ai, m);
                    const f32x4 cs0 = *(const f32x4*)(rope + (size_t)(pos * 32 + i0) * 2), cs1 = *(const f32x4*)(rope + (size_t)(pos * 32 + i0) * 2 + 4);
#pragma unroll
                    for (int bj = 0; bj < 2; ++bj) {
                        const f32x4 pp = *(const PG8_LAS f32x4*)(P + (ai * HALF + wr * 64 + m * 16 + fr) * 8 + bj * 4);
                        const float hr = r_ / sqrtf(((pp[0] + pp[1]) + (pp[2] + pp[3])) * (1.0f / 128.0f) + 1e-6f);
                        const f32x4 x1 = acc[ai][bj][m][0] * hr * w1, x2 = acc[ai][bj][m][1] * hr * w2;
                        const float a0 = x1[0] * cs0[0] - x2[0] * cs0[1], b0 = x2[0] * cs0[0] + x1[0] * cs0[1];
                        const float a1 = x1[1] * cs0[2] - x2[1] * cs0[3], b1 = x2[1] * cs0[2] + x1[1] * cs0[3];
                        const float a2 = x1[2] * cs1[0] - x2[2] * cs1[1], b2 = x2[2] * cs1[0] + x1[2] * cs1[1];
                        const float a3 = x1[3] * cs1[2] - x2[3] * cs1[3], b3 = x2[3] * cs1[2] + x1[3] * cs1[3];
                        int w0 = __builtin_amdgcn_cvt_pk_fp8_f32(a0, a1, 0, false); w0 = __builtin_amdgcn_cvt_pk_fp8_f32(a2, a3, w0, true);
                        int w1_ = __builtin_amdgcn_cvt_pk_fp8_f32(b0, b1, 0, false); w1_ = __builtin_amdgcn_cvt_pk_fp8_f32(b2, b3, w1_, true);
                        typedef int i32x2v __attribute__((ext_vector_type(2))); *(i32x2v*)(dst0 + (size_t)row * dpitch + bj * HALF) = (i32x2v){w0, w1_}; }
                }
        }
#undef RS_
    }
};
typedef _Float16 h16x2 __attribute__((ext_vector_type(2)));
__device__ __forceinline__ unsigned pk_h2(float a, float b) { const h16x2 h = {(_Float16)a, (_Float16)b}; return __builtin_bit_cast(unsigned, h); }
__device__ __forceinline__ float h_lo(unsigned u) { return (float)__builtin_bit_cast(h16x2, u)[0]; }
__device__ __forceinline__ float h_hi(unsigned u) { return (float)__builtin_bit_cast(h16x2, u)[1]; }
template <bool OLDB, bool NEWF>
struct EpiOutT {
    static constexpr bool PERM = true, AFTER_DRAIN = false;
    const float* Xold; float* Xnew; bf16_t* XB  ; float* part  ; unsigned char* xb8; unsigned short* XH;
    __device__ __forceinline__ void operator()(const f32x4 (&acc)[2][2][4][2], const Unit& u, int wr, int wc, int fr, int fq) const {
        const int row0 = u.pm * BM + wr * 64 + fr, col0 = u.pn * BM + wc * 32 + 8 * fq;
        f32x4 xs[2][2][2][2];
#define EO_LD(slot, g) do { _Pragma("unroll") for (int mi = 0; mi < 2; ++mi) _Pragma("unroll") for (int bj = 0; bj < 2; ++bj) { \
            const size_t off = (size_t)(row0 + ((g) >> 1) * HALF + (((g) & 1) * 2 + mi) * 16) * 4096 + col0 + bj * HALF; \
            if (OLDB) { const u32x4 t_ = *(const u32x4*)(XH + off); \
                xs[slot][mi][bj][0] = f32x4{h_lo(t_.x), h_hi(t_.x), h_lo(t_.y), h_hi(t_.y)}; \
                xs[slot][mi][bj][1] = f32x4{h_lo(t_.z), h_hi(t_.z), h_lo(t_.w), h_hi(t_.w)}; } \
            else { xs[slot][mi][bj][0] = *(const f32x4*)(Xold + off); xs[slot][mi][bj][1] = *(const f32x4*)(Xold + off + 4); } } } while (0)
#define EO_PR(slot, g) do { _Pragma("unroll") for (int mi = 0; mi < 2; ++mi) { const int ai = (g) >> 1, m = ((g) & 1) * 2 + mi; const int row = row0 + ai * HALF + m * 16; float ss = 0.f; \
            _Pragma("unroll") for (int bj = 0; bj < 2; ++bj) { const size_t off = (size_t)row * 4096 + col0 + bj * HALF; \
                const f32x4 x0 = xs[slot][mi][bj][0] + acc[ai][bj][m][0], x1 = xs[slot][mi][bj][1] + acc[ai][bj][m][1]; \
                if (NEWF) { ST_X((f32x4*)(Xnew + off), x0); ST_X((f32x4*)(Xnew + off + 4), x1); } \
                else { u32x4 hh; hh.x = pk_h2(x0[0], x0[1]); hh.y = pk_h2(x0[2], x0[3]); hh.z = pk_h2(x1[0], x1[1]); hh.w = pk_h2(x1[2], x1[3]); *(u32x4*)(XH + off) = hh; } \
                u32x4 w; w.x = cvt_pk_bf16(x0[0], x0[1]); w.y = cvt_pk_bf16(x0[2], x0[3]); w.z = cvt_pk_bf16(x1[0], x1[1]); w.w = cvt_pk_bf16(x1[2], x1[3]); \
                if (XB) *(u32x4*)(XB + off) = w; \
                if (xb8) { int e0 = __builtin_amdgcn_cvt_pk_fp8_f32(x0[0], x0[1], 0, false); e0 = __builtin_amdgcn_cvt_pk_fp8_f32(x0[2], x0[3], e0, true); int e1 = __builtin_amdgcn_cvt_pk_fp8_f32(x1[0], x1[1], 0, false); e1 = __builtin_amdgcn_cvt_pk_fp8_f32(x1[2], x1[3], e1, true); \
                    typedef int i32x2e __attribute__((ext_vector_type(2))); *(i32x2e*)(xb8 + off) = (i32x2e){e0, e1}; } \
                ss += ((x0[0] * x0[0] + x0[1] * x0[1]) + (x0[2] * x0[2] + x0[3] * x0[3])) + ((x1[0] * x1[0] + x1[1] * x1[1]) + (x1[2] * x1[2] + x1[3] * x1[3])); } \
            ss += __shfl_xor(ss, 16); ss += __shfl_xor(ss, 32); \
            if (part && fq == 0) part[(size_t)row * 64 + u.pn * 4 + wc] = ss; } } while (0)
        EO_LD(0, 0); EO_LD(1, 1); asm volatile("" ::: "memory");
        EO_PR(0, 0); asm volatile("" ::: "memory"); EO_LD(0, 2); asm volatile("" ::: "memory");
        EO_PR(1, 1); asm volatile("" ::: "memory"); EO_LD(1, 3); asm volatile("" ::: "memory");
        EO_PR(0, 2); EO_PR(1, 3);
#undef EO_LD
#undef EO_PR
    }
};
typedef EpiOutT<false, true> EpiOut;

struct EpiLight {
    static constexpr bool PERM = true, AFTER_DRAIN = false;
    bf16_t* O;
    __device__ __forceinline__ void operator()(const f32x4 (&acc)[2][2][4][2], const Unit& u, int wr, int wc, int fr, int fq) const {
        const int row0 = u.pm * BM + wr * 64 + fr, col0 = u.pn * BM + wc * 32 + 8 * fq;
#pragma unroll
        for (int ai = 0; ai < 2; ++ai)
#pragma unroll
            for (int m = 0; m < 4; ++m) { bf16_t* rowp = O + (size_t)(row0 + ai * HALF + m * 16) * 4096 + col0;
#pragma unroll
                for (int bj = 0; bj < 2; ++bj) { const f32x4 v0 = acc[ai][bj][m][0], v1 = acc[ai][bj][m][1];
                    u32x4 w; w.x = cvt_pk_bf16(v0[0], v0[1]); w.y = cvt_pk_bf16(v0[2], v0[3]); w.z = cvt_pk_bf16(v1[0], v1[1]); w.w = cvt_pk_bf16(v1[2], v1[3]);
                    *(u32x4*)(rowp + bj * HALF) = w; } }
    }
};
template <class Epi, class Sched, bool ALIGN_EPI = false, bool SP2 = false, bool F8 = false, int SPLIT8 = 0, bool F16 = false>
__device__ __forceinline__ void gemm_phase(PG8_LAS unsigned char* lds, const Gemm g, const Sched& S, const Epi& E, float split_scale = 1.0f) {
    int tid_ = threadIdx.x; asm volatile("" : "+v"(tid_));
    const int tid = tid_, wid = __builtin_amdgcn_readfirstlane(tid >> 6), lane = tid & 63, wr = wid >> 2, wc = wid & 3, fr = lane & 15, fq = lane >> 4;
    typedef int i32x4_ __attribute__((ext_vector_type(4)));
    typedef _Float16 f16x8_ __attribute__((ext_vector_type(8)));
    const int f8one = 0x7f7f7f7f;
    const int K = g.K, nt = K / BK - SPLIT8;
    unsigned voffA[2], voffB[2];
#pragma unroll
    for (int i = 0; i < 2; ++i) { int R, C; stage_rc(tid * 16 + i * 8192, R, C); const int Rb = Epi::PERM ? ((R & ~31) + perm32(R & 31)) : R;
        voffA[i] = (unsigned)(R * K + C) * 2u; voffB[i] = (unsigned)(Rb * K + C) * 2u; }
    const size_t kstep = (size_t)(BK * 2);
    const size_t hstep = (size_t)HALF * K * 2;
    const size_t tstep = 2 * hstep;
    const unsigned ldsw = (unsigned)wid * 1024u;
    const int aoff = lds_byte(wr * 64 + fr, fq * 8), boff = lds_byte(wc * 32 + fr, fq * 8);
#define PG8_SA(b, h) (((b) * 2 + (h)) * HTB)
#define PG8_SB(b, h) ((4 + (b) * 2 + (h)) * HTB)
#define PG8_STAGE(bufoff, gbase, voff) do { _Pragma("unroll") for (int _i = 0; _i < 2; ++_i) \
        __builtin_amdgcn_global_load_lds((const unsigned*)((const char*)(gbase) + (voff)[_i]), (PG8_LAS unsigned*)(lds + (bufoff) + ldsw + _i * 8192), 16, 0, 0); } while (0)
#define PG8_LDA(dst, b, h) do { _Pragma("unroll") for (int m = 0; m < 4; ++m) _Pragma("unroll") for (int k = 0; k < 2; ++k) dst[m][k] = *(const PG8_LAS bf16x8*)(lds + PG8_SA(b, h) + aoff + m * 2048 + k * 1024); } while (0)
#define PG8_LDB(dst, b, h) do { _Pragma("unroll") for (int n = 0; n < 2; ++n) _Pragma("unroll") for (int k = 0; k < 2; ++k) dst[n][k] = *(const PG8_LAS bf16x8*)(lds + PG8_SB(b, h) + boff + n * 2048 + k * 1024); } while (0)
#define PG8_CAT8(x, y) __builtin_shufflevector(__builtin_bit_cast(i32x4_, x), __builtin_bit_cast(i32x4_, y), 0, 1, 2, 3, 4, 5, 6, 7)
#define PG8_MMA(ai, bj, At, Bt) do { __builtin_amdgcn_s_setprio(1); _Pragma("unroll") for (int m = 0; m < 4; ++m) _Pragma("unroll") for (int n = 0; n < 2; ++n) { \
        if constexpr (f8t) { asm volatile("v_mfma_scale_f32_16x16x128_f8f6f4 %0, %1, %2, %0, %3, %3 op_sel_hi:[0,0,0]" : "+v"(acc[ai][bj][m][n]) : "v"(PG8_CAT8(Bt[n][0], Bt[n][1])), "v"(PG8_CAT8(At[m][0], At[m][1])), "v"(f8one)); } \
        else if constexpr (SPLIT8 > 0) { _Pragma("unroll") for (int k = 0; k < 2; ++k) asm volatile("v_mfma_f32_16x16x32_bf16 %0, %1, %2, %0" : "+v"(acc[ai][bj][m][n]) : "v"(Bt[n][k]), "v"(At[m][k])); } \
        else if constexpr (F16) { _Pragma("unroll") for (int k = 0; k < 2; ++k) acc[ai][bj][m][n] = __builtin_amdgcn_mfma_f32_16x16x32_f16(__builtin_bit_cast(f16x8_, Bt[n][k]), __builtin_bit_cast(f16x8_, At[m][k]), acc[ai][bj][m][n], 0, 0, 0); } \
        else { _Pragma("unroll") for (int k = 0; k < 2; ++k) acc[ai][bj][m][n] = __builtin_amdgcn_mfma_f32_16x16x32_bf16(Bt[n][k], At[m][k], acc[ai][bj][m][n], 0, 0, 0); } } \
        __builtin_amdgcn_s_setprio(0); } while (0)
#define PG8_WAIT_V(n) asm volatile("s_waitcnt vmcnt(" #n ")" ::: "memory")
#define PG8_WAIT_L(n) asm volatile("s_waitcnt lgkmcnt(" #n ")" ::: "memory")
#define PG8_BAR __builtin_amdgcn_s_barrier()
#define PG8_SCHED __builtin_amdgcn_sched_barrier(0)
#define PG8_KBODY(F8T) do { constexpr bool f8t = (F8T); (void)f8t; \
            const bool last = (t == nt - 2); \
            const size_t k1 = (size_t)((t + 1 < SPLIT8 || SPLIT8 == 0) ? t + 1 : t + 1 + SPLIT8) * kstep, k2 = (size_t)((t + 2 < SPLIT8 || SPLIT8 == 0) ? t + 2 : t + 2 + SPLIT8) * kstep; \
            const char* a1 = cA + k1; \
            const char* a2 = last ? nA : cA + k2; const char* b2 = last ? nB : cB + k2; \
            const char* a3 = a2 + kstep; const char* b3 = b2 + kstep; \
            if (last && has_next) S.a_ready(nxt); \
            if constexpr (SP2) { \
            PG8_LDB(B0, 0, 0); PG8_LDB(B1, 0, 1); PG8_SCHED; PG8_LDA(At, 0, 0); PG8_STAGE(PG8_SA(1, 1), a1 + hstep, voffA); \
            PG8_WAIT_V(8); PG8_WAIT_L(0); PG8_BAR; PG8_MMA(0, 0, At, B0); PG8_MMA(0, 1, At, B1); PG8_BAR; PG8_SCHED; \
            PG8_LDA(At, 0, 1); PG8_STAGE(PG8_SB(0, 0), b2, voffB); PG8_STAGE(PG8_SB(0, 1), b2 + hstep, voffB); PG8_STAGE(PG8_SA(0, 0), a2, voffA); \
            PG8_WAIT_V(8); PG8_WAIT_L(0); PG8_BAR; PG8_MMA(1, 0, At, B0); PG8_MMA(1, 1, At, B1); PG8_BAR; PG8_SCHED; \
            PG8_LDB(B0, 1, 0); PG8_LDB(B1, 1, 1); PG8_SCHED; PG8_LDA(At, 1, 0); PG8_STAGE(PG8_SA(0, 1), a2 + hstep, voffA); \
            PG8_WAIT_V(8); PG8_WAIT_L(0); PG8_BAR; PG8_MMA(0, 0, At, B0); PG8_MMA(0, 1, At, B1); PG8_BAR; PG8_SCHED; \
            PG8_LDA(At, 1, 1); PG8_STAGE(PG8_SB(1, 0), b3, voffB); PG8_STAGE(PG8_SB(1, 1), b3 + hstep, voffB); PG8_STAGE(PG8_SA(1, 0), a3, voffA); \
            PG8_WAIT_V(8); PG8_WAIT_L(0); PG8_BAR; PG8_MMA(1, 0, At, B0); PG8_MMA(1, 1, At, B1); PG8_BAR; PG8_SCHED; \
            } else { \
            PG8_LDB(B0, 0, 0); PG8_SCHED; PG8_LDA(At, 0, 0); PG8_STAGE(PG8_SA(1, 1), a1 + hstep, voffA); \
            PG8_WAIT_L(8); PG8_BAR; PG8_WAIT_L(0); PG8_MMA(0, 0, At, B0); PG8_BAR; PG8_SCHED; \
            PG8_LDB(B1, 0, 1); PG8_STAGE(PG8_SB(0, 0), b2, voffB); \
            PG8_BAR; PG8_WAIT_L(0); PG8_MMA(0, 1, At, B1); PG8_BAR; \
            PG8_LDA(At, 0, 1); PG8_STAGE(PG8_SA(0, 0), a2, voffA); \
            PG8_BAR; PG8_WAIT_L(0); PG8_MMA(1, 0, At, B0); PG8_BAR; PG8_SCHED; \
            PG8_STAGE(PG8_SB(0, 1), b2 + hstep, voffB); \
            PG8_WAIT_V(6); PG8_BAR; PG8_MMA(1, 1, At, B1); PG8_BAR; \
            PG8_LDB(B0, 1, 0); PG8_SCHED; PG8_LDA(At, 1, 0); PG8_STAGE(PG8_SA(0, 1), a2 + hstep, voffA); \
            PG8_WAIT_L(8); PG8_BAR; PG8_WAIT_L(0); PG8_MMA(0, 0, At, B0); PG8_BAR; PG8_SCHED; \
            PG8_LDB(B1, 1, 1); PG8_STAGE(PG8_SB(1, 0), b3, voffB); \
            PG8_BAR; PG8_WAIT_L(0); PG8_MMA(0, 1, At, B1); PG8_BAR; \
            PG8_LDA(At, 1, 1); PG8_STAGE(PG8_SA(1, 0), a3, voffA); \
            PG8_BAR; PG8_WAIT_L(0); PG8_MMA(1, 0, At, B0); PG8_BAR; PG8_SCHED; \
            PG8_STAGE(PG8_SB(1, 1), b3 + hstep, voffB); \
            PG8_WAIT_V(6); PG8_BAR; PG8_MMA(1, 1, At, B1); PG8_BAR; \
            } \
        } while (0)
    Unit cur, nxt; int ui = 0;
    if (!S.next(0, cur)) return;
    f32x4 acc[2][2][4][2];
#pragma unroll
    for (int a = 0; a < 2; ++a)
#pragma unroll
        for (int b = 0; b < 2; ++b)
#pragma unroll
            for (int m = 0; m < 4; ++m)
#pragma unroll
                for (int n = 0; n < 2; ++n) acc[a][b][m][n] = (f32x4){0.f, 0.f, 0.f, 0.f};
    bf16x8 At[4][2], B0[2][2], B1[2][2];
    const char* cA = (const char*)g.A + (size_t)cur.pm * tstep; const char* cB = (const char*)g.Bt + (size_t)cur.pn * tstep;
    S.a_ready(cur);
    if constexpr (SP2) {
        PG8_STAGE(PG8_SB(0, 0), cB, voffB); PG8_STAGE(PG8_SB(0, 1), cB + hstep, voffB); PG8_STAGE(PG8_SA(0, 0), cA, voffA); PG8_STAGE(PG8_SA(0, 1), cA + hstep, voffA);
        if (wr == 1) PG8_BAR;
        PG8_WAIT_V(2); PG8_BAR;
        PG8_STAGE(PG8_SB(1, 0), cB + kstep, voffB); PG8_STAGE(PG8_SA(1, 0), cA + kstep, voffA); PG8_STAGE(PG8_SB(1, 1), cB + hstep + kstep, voffB);
        PG8_WAIT_V(6); PG8_BAR;
    } else {
        PG8_STAGE(PG8_SB(0, 0), cB, voffB); PG8_STAGE(PG8_SA(0, 0), cA, voffA); PG8_STAGE(PG8_SB(0, 1), cB + hstep, voffB); PG8_STAGE(PG8_SA(0, 1), cA + hstep, voffA);
        if (wr == 1) PG8_BAR;
        PG8_WAIT_V(4); PG8_BAR;
        PG8_STAGE(PG8_SB(1, 0), cB + kstep, voffB); PG8_STAGE(PG8_SA(1, 0), cA + kstep, voffA); PG8_STAGE(PG8_SB(1, 1), cB + hstep + kstep, voffB);
        PG8_WAIT_V(6); PG8_BAR;
    }
    for (;;) {
        const bool has_next = S.next(ui + 1, nxt);
        const char* nA = has_next ? (const char*)g.A + (size_t)nxt.pm * tstep : cA; const char* nB = has_next ? (const char*)g.Bt + (size_t)nxt.pn * tstep : cB;
        if constexpr (SPLIT8 > 0) {
            for (int t = 0; t < SPLIT8; t += 2) PG8_KBODY(true);
#pragma unroll
            for (int a = 0; a < 2; ++a)
#pragma unroll
                for (int b = 0; b < 2; ++b)
#pragma unroll
                    for (int m = 0; m < 4; ++m)
#pragma unroll
                        for (int n = 0; n < 2; ++n) acc[a][b][m][n] *= split_scale;
            for (int t = SPLIT8; t < nt; t += 2) PG8_KBODY(false);
        } else {
            for (int t = 0; t < nt; t += 2) PG8_KBODY(F8);
        }
        if constexpr (F8 || SPLIT8 > 0) asm volatile("s_nop 15\n\ts_nop 15" ::: "memory");
        if constexpr (ALIGN_EPI) { if (wr == 0) PG8_BAR; }
        if constexpr (!Epi::AFTER_DRAIN) { E(acc, cur, wr, wc, fr, fq); S.done(cur); }
        if (!has_next) break;
#pragma unroll
        for (int a = 0; a < 2; ++a)
#pragma unroll
            for (int b = 0; b < 2; ++b)
#pragma unroll
                for (int m = 0; m < 4; ++m)
#pragma unroll
                    for (int n = 0; n < 2; ++n) acc[a][b][m][n] = (f32x4){0.f, 0.f, 0.f, 0.f};
        cur = nxt; cA = nA; cB = nB; ++ui;
        if constexpr (ALIGN_EPI) { if (wr == 1) PG8_BAR; }
    }
    PG8_WAIT_V(0);
    if constexpr (!ALIGN_EPI) { if (wr == 0) PG8_BAR; }
    PG8_BAR;
    if constexpr (Epi::AFTER_DRAIN) { E.fused(acc, cur, wr, wc, fr, fq, lds, wid, lane); S.done(cur); }
#undef PG8_SA
#undef PG8_SB
#undef PG8_STAGE
#undef PG8_LDA
#undef PG8_LDB
#undef PG8_MMA
#undef PG8_KBODY
#undef PG8_CAT8
#undef PG8_WAIT_V
#undef PG8_WAIT_L
#undef PG8_BAR
#undef PG8_SCHED
}
}
namespace att {
using bf16 = unsigned short;
constexpr int D = 128, NW = 8, QBLK = 32, KVBLK = 64;
constexpr float SCALE = 0.088388347648318440f;
constexpr float THR = 8.f;
using f32x4 = __attribute__((ext_vector_type(4))) float;
using bf16x8 = __attribute__((ext_vector_type(8))) short;
using s16x4  = __attribute__((ext_vector_type(4))) short;
using f32x16 = __attribute__((ext_vector_type(16))) float;
using f32x8  = __attribute__((ext_vector_type(8))) float;
using u32x4  = __attribute__((ext_vector_type(4))) unsigned;
#define KSWZ(row, colB) ((row) * 256 + ((colB) ^ (((row) & 15) << 4)))
#define SBAR() __builtin_amdgcn_sched_barrier(0)
__device__ __forceinline__ int crow(int r, int hi) { return (r & 3) + 8 * (r >> 2) + 4 * hi; }
__device__ __forceinline__ unsigned cvtpk(float lo, float hi) {
  unsigned r; asm volatile("v_cvt_pk_bf16_f32 %0, %1, %2" : "=v"(r) : "v"(lo), "v"(hi)); return r;
}
__device__ __forceinline__ void partialSM(f32x16& p0, f32x16& p1, float& m_reg, float& mn, float& alpha) {
  constexpr float C = SCALE * 1.4426950408889634f;
  float pmax = p0[0]; _Pragma("unroll") for (int r = 1; r < 16; ++r) pmax = fmaxf(pmax, p0[r]); _Pragma("unroll") for (int r = 0; r < 16; ++r) pmax = fmaxf(pmax, p1[r]);
  { auto rr = __builtin_amdgcn_permlane32_swap(__float_as_uint(pmax), __float_as_uint(pmax), false, false);
    pmax = fmaxf(__uint_as_float(rr[0]), __uint_as_float(rr[1])); }
  if (__builtin_expect(__all(pmax - m_reg <= THR / SCALE), 1)) { mn = m_reg; alpha = 1.f; }
  else { mn = fmaxf(m_reg, pmax); alpha = __builtin_amdgcn_exp2f((m_reg - mn) * C); m_reg = mn; }
  float mnC = -mn * C;
  _Pragma("unroll") for (int r = 0; r < 16; ++r) p0[r] = fmaf(p0[r], C, mnC); _Pragma("unroll") for (int r = 0; r < 16; ++r) p1[r] = fmaf(p1[r], C, mnC);
  _Pragma("unroll") for (int r = 0; r < 16; ++r) p0[r] = __builtin_amdgcn_exp2f(p0[r]);
}
__device__ __forceinline__ void finishSM(f32x16& p0, f32x16& p1, float alpha, float& l_reg, bf16x8& pa0, bf16x8& pa1, bf16x8& pa2, bf16x8& pa3) {
  _Pragma("unroll") for (int r = 0; r < 16; ++r) p1[r] = __builtin_amdgcn_exp2f(p1[r]);
  float ps = 0; _Pragma("unroll") for (int r = 0; r < 16; ++r) ps += p0[r]; _Pragma("unroll") for (int r = 0; r < 16; ++r) ps += p1[r];
  { auto rr = __builtin_amdgcn_permlane32_swap(__float_as_uint(ps), __float_as_uint(ps), false, false);
    ps = __uint_as_float(rr[0]) + __uint_as_float(rr[1]); }
  l_reg = l_reg * alpha + ps;
#define PK4(P, BASE, OUT) do { unsigned a0 = cvtpk(P[BASE + 0], P[BASE + 1]), a1 = cvtpk(P[BASE + 2], P[BASE + 3]);   \
    unsigned b0 = cvtpk(P[BASE + 4], P[BASE + 5]), b1 = cvtpk(P[BASE + 6], P[BASE + 7]);                              \
    auto r0 = __builtin_amdgcn_permlane32_swap(a0, b0, false, false); auto r1 = __builtin_amdgcn_permlane32_swap(a1, b1, false, false); \
    u32x4 w = {r0[0], r1[0], r0[1], r1[1]}; OUT = *reinterpret_cast<bf16x8*>(&w); } while (0)
  PK4(p0, 0, pa0); PK4(p0, 8, pa1); PK4(p1, 0, pa2); PK4(p1, 8, pa3);
#undef PK4
}
__device__ __forceinline__ void qkt(f32x16& p0, f32x16& p1, const bf16* Ks, const bf16x8* qr, int r32, int hi) {
  p0 = f32x16{}; p1 = f32x16{};
  _Pragma("unroll") for (int d0 = 0; d0 < 8; ++d0) { int cb = (d0 * 16 + hi * 8) * 2;
    bf16x8 b0 = *reinterpret_cast<const bf16x8*>((const char*)Ks + KSWZ(r32, cb));
    bf16x8 b1 = *reinterpret_cast<const bf16x8*>((const char*)Ks + KSWZ(32 + r32, cb));
    p0 = __builtin_amdgcn_mfma_f32_32x32x16_bf16(b0, qr[d0], p0, 0, 0, 0);
    p1 = __builtin_amdgcn_mfma_f32_32x32x16_bf16(b1, qr[d0], p1, 0, 0, 0); }
}
__device__ __forceinline__ int v_st(int k, int c) { const int kk = (k & ~0xC) | ((k & 4) << 1) | ((k & 8) >> 1); return ((kk >> 3) * 4 + (c >> 5)) * 512 + ((kk & 7) * 32 + (c & 31)) * 2; }
__device__ __forceinline__ int v_rd_base(int lane) { return ((lane & 3) << 3) | (((lane >> 2) & 3) << 6) | (((lane >> 4) & 1) << 5) | (((lane >> 5) & 1) << 8); }
constexpr int v_rd_off(int d0, int ks, int half) { return d0 * 512 + ks * 4096 + half * 2048; }
template <int OFF> __device__ __forceinline__ s16x4 tr_read(int vb) {
  s16x4 r; asm volatile("ds_read_b64_tr_b16 %0, %1 offset:%2" : "=&v"(r) : "v"(vb), "i"(OFF) : "memory"); return r;
}
template <int D0> __device__ __forceinline__ void pv_one(f32x16& od, int vb, bf16x8 pa0, bf16x8 pa1, bf16x8 pa2, bf16x8 pa3) {
  const s16x4 l0 = tr_read<v_rd_off(D0, 0, 0)>(vb), h0 = tr_read<v_rd_off(D0, 0, 1)>(vb), l1 = tr_read<v_rd_off(D0, 1, 0)>(vb), h1 = tr_read<v_rd_off(D0, 1, 1)>(vb);
  const s16x4 l2 = tr_read<v_rd_off(D0, 2, 0)>(vb), h2 = tr_read<v_rd_off(D0, 2, 1)>(vb), l3 = tr_read<v_rd_off(D0, 3, 0)>(vb), h3 = tr_read<v_rd_off(D0, 3, 1)>(vb);
  asm volatile("s_waitcnt lgkmcnt(0)" ::: "memory"); SBAR();
#define PK(L, H) (bf16x8){L[0], L[1], L[2], L[3], H[0], H[1], H[2], H[3]}
  od = __builtin_amdgcn_mfma_f32_32x32x16_bf16(pa0, PK(l0, h0), od, 0, 0, 0);
  od = __builtin_amdgcn_mfma_f32_32x32x16_bf16(pa1, PK(l1, h1), od, 0, 0, 0);
  od = __builtin_amdgcn_mfma_f32_32x32x16_bf16(pa2, PK(l2, h2), od, 0, 0, 0);
  od = __builtin_amdgcn_mfma_f32_32x32x16_bf16(pa3, PK(l3, h3), od, 0, 0, 0);
#undef PK
}
__device__ __forceinline__ void pv_d0(f32x16* o, int vb, bf16x8 pa0, bf16x8 pa1, bf16x8 pa2, bf16x8 pa3) {
  pv_one<0>(o[0], vb, pa0, pa1, pa2, pa3); pv_one<1>(o[1], vb, pa0, pa1, pa2, pa3); pv_one<2>(o[2], vb, pa0, pa1, pa2, pa3); pv_one<3>(o[3], vb, pa0, pa1, pa2, pa3);
}
#define LAS3 __attribute__((address_space(3)))
typedef short v4i16_t __attribute__((ext_vector_type(4)));
__device__ __forceinline__ s16x4 vtr(const LAS3 char* p) { return __builtin_bit_cast(s16x4, __builtin_amdgcn_ds_read_tr16_b64_v4i16((LAS3 v4i16_t*)p)); }
__device__ __forceinline__ void partialSM_bf(f32x16& p0, f32x16& p1, float& m_reg, float& mn, float& alpha) {
  constexpr float C = SCALE * 1.4426950408889634f;
  float pmax = p0[0];
  _Pragma("unroll") for (int r = 1; r < 16; ++r) pmax = fmaxf(pmax, p0[r]);
  _Pragma("unroll") for (int r = 0; r < 16; ++r) pmax = fmaxf(pmax, p1[r]);
  { auto rr = __builtin_amdgcn_permlane32_swap(__float_as_uint(pmax), __float_as_uint(pmax), false, false);
    pmax = fmaxf(__uint_as_float(rr[0]), __uint_as_float(rr[1])); }
  const bool keep = __all(pmax - m_reg <= THR / SCALE);
  mn = keep ? m_reg : fmaxf(m_reg, pmax); alpha = __builtin_amdgcn_exp2f((m_reg - mn) * C); m_reg = mn;
  const float mnC = -mn * C;
  _Pragma("unroll") for (int r = 0; r < 16; ++r) p0[r] = fmaf(p0[r], C, mnC);
  _Pragma("unroll") for (int r = 0; r < 16; ++r) p1[r] = fmaf(p1[r], C, mnC);
  _Pragma("unroll") for (int r = 0; r < 16; ++r) p0[r] = __builtin_amdgcn_exp2f(p0[r]);
}
__device__ __forceinline__ void pv_all(f32x16* o, const LAS3 char* vp, bf16x8 pa0, bf16x8 pa1, bf16x8 pa2, bf16x8 pa3) {
#define PKV(L, H) (bf16x8){L[0], L[1], L[2], L[3], H[0], H[1], H[2], H[3]}
  _Pragma("unroll") for (int d0 = 0; d0 < 4; ++d0) {
    const s16x4 l0 = vtr(vp + v_rd_off(d0, 0, 0)), h0 = vtr(vp + v_rd_off(d0, 0, 1)), l1 = vtr(vp + v_rd_off(d0, 1, 0)), h1 = vtr(vp + v_rd_off(d0, 1, 1));
    const s16x4 l2 = vtr(vp + v_rd_off(d0, 2, 0)), h2 = vtr(vp + v_rd_off(d0, 2, 1)), l3 = vtr(vp + v_rd_off(d0, 3, 0)), h3 = vtr(vp + v_rd_off(d0, 3, 1));
    o[d0] = __builtin_amdgcn_mfma_f32_32x32x16_bf16(pa0, PKV(l0, h0), o[d0], 0, 0, 0);
    o[d0] = __builtin_amdgcn_mfma_f32_32x32x16_bf16(pa1, PKV(l1, h1), o[d0], 0, 0, 0);
    o[d0] = __builtin_amdgcn_mfma_f32_32x32x16_bf16(pa2, PKV(l2, h2), o[d0], 0, 0, 0);
    o[d0] = __builtin_amdgcn_mfma_f32_32x32x16_bf16(pa3, PKV(l3, h3), o[d0], 0, 0, 0); }
#undef PKV
}
#ifndef SGB_VALU_A
#define SGB_VALU_A 4
#endif
#ifndef SGB_VALU_B
#define SGB_VALU_B 4
#endif
#define PIN_A() asm volatile("" : "+v"(pa0), "+v"(pa1), "+v"(pa2), "+v"(pa3), "+v"(l_reg))
#define PIN_B(P0, P1, AL) asm volatile("" : "+v"(P0), "+v"(P1), "+v"(AL), "+v"(m_reg))
#define SGB_A() do { __builtin_amdgcn_sched_group_barrier(0x100, 2, 0); _Pragma("unroll") for (int i_ = 0; i_ < 16; ++i_) { __builtin_amdgcn_sched_group_barrier(0x008, 1, 0); \
    __builtin_amdgcn_sched_group_barrier(0x100, 1, 0); __builtin_amdgcn_sched_group_barrier(0x400, 1, 0); __builtin_amdgcn_sched_group_barrier(0x002, SGB_VALU_A, 0); } } while (0)
#define SGB_B() do { __builtin_amdgcn_sched_group_barrier(0x100, 2, 0); _Pragma("unroll") for (int i_ = 0; i_ < 16; ++i_) { __builtin_amdgcn_sched_group_barrier(0x008, 1, 0); \
    __builtin_amdgcn_sched_group_barrier(0x100, 2, 0); __builtin_amdgcn_sched_group_barrier(0x002, SGB_VALU_B, 0); __builtin_amdgcn_sched_group_barrier(0x400, 1, 0); } } while (0)
constexpr int DMODEL = 4096;
constexpr size_t SHM_V = 64 * 128 * 2, SHM_K = 64 * 128 * 2;
constexpr int ATT_WS_OFF = 2 * SHM_V + 2 * SHM_K, ATT_TAB_OFF = ATT_WS_OFF + 8 * 256, ATT_OST_OFF = ATT_TAB_OFF + 704 * 4 + 256  , ATT_LDS_BYTES = ATT_OST_OFF + 8 * 8192;
constexpr float LOG2E = 1.4426950408889634f;
constexpr float Y8_SCALE = 64.0f;
__device__ __forceinline__ float bf2f(bf16 v) { return __uint_as_float((unsigned)v << 16); }
__device__ __forceinline__ bf16 f2bf(float f) { return (bf16)(cvtpk(f, 0.f) & 0xffffu); }
__device__ __forceinline__ float silu_f(float g) { return g * __builtin_amdgcn_rcpf(1.0f + __builtin_amdgcn_exp2f(-g * LOG2E)); }
__device__ __forceinline__ void pack_p(const f32x16& p0, const f32x16& p1, bf16x8& pa0, bf16x8& pa1, bf16x8& pa2, bf16x8& pa3) {
#define PK4(P, BASE, OUT) do { unsigned a0 = cvtpk(P[BASE + 0], P[BASE + 1]), a1 = cvtpk(P[BASE + 2], P[BASE + 3]);   \
    unsigned b0 = cvtpk(P[BASE + 4], P[BASE + 5]), b1 = cvtpk(P[BASE + 6], P[BASE + 7]);                              \
    auto r0 = __builtin_amdgcn_permlane32_swap(a0, b0, false, false); auto r1 = __builtin_amdgcn_permlane32_swap(a1, b1, false, false); \
    u32x4 w = {r0[0], r1[0], r0[1], r1[1]}; OUT = *reinterpret_cast<bf16x8*>(&w); } while (0)
  PK4(p0, 0, pa0); PK4(p0, 8, pa1); PK4(p1, 0, pa2); PK4(p1, 8, pa3);
#undef PK4
}
#ifndef LU_GATE_EARLY
#define LU_GATE_EARLY 0
#endif
struct GateRegs { u32x4 g[2][4]; };
template <int ZP> __device__ __forceinline__ void load_gate(GateRegs& G, const bf16* Gb, int rowb, int lane) {
  const int rr = lane >> 3, c8 = (lane & 7) * 8;
#pragma unroll
  for (int h = 0; h < 2; ++h)
#pragma unroll
    for (int i = 0; i < 4; ++i) G.g[h][i] = *reinterpret_cast<const u32x4*>((const char*)Gb + (unsigned)(((rowb + 8 * i + rr) * ZP + h * 64 + c8) * 2));
}
template <int ZP, bool OUT8 = false, bool PRE = false>
__device__ __forceinline__ void store_gated(const f32x16* o, float l_reg, float* li_l, float* ost, const bf16* Gb, bf16* Yb, int wid, int lane, int r32, int hi, bool li_ready = false, int rowb = -1, const GateRegs* gpre = nullptr) {
  if (rowb < 0) rowb = wid * 32;
  if (!li_ready && hi == 0) li_l[r32] = l_reg;
  const int rr = lane >> 3, c8 = (lane & 7) * 8;
  u32x4 g[2][4];
#pragma unroll
  for (int h = 0; h < 2; ++h)
#pragma unroll
    for (int i = 0; i < 4; ++i) { if (PRE) g[h][i] = gpre->g[h][i]; else g[h][i] = *reinterpret_cast<const u32x4*>((const char*)Gb + (unsigned)(((rowb + 8 * i + rr) * ZP + h * 64 + c8) * 2)); }
#pragma unroll
  for (int h = 0; h < 2; ++h) {
#pragma unroll
    for (int d = 0; d < 2; ++d)
#pragma unroll
      for (int r = 0; r < 16; ++r) ost[crow(r, hi) * 64 + d * 32 + r32] = o[2 * h + d][r];
    asm volatile("s_waitcnt lgkmcnt(0)" ::: "memory");
#pragma unroll
    for (int i = 0; i < 4; ++i) { const int row = 8 * i + rr;
      const f32x4 a = *reinterpret_cast<const f32x4*>(ost + row * 64 + c8), b = *reinterpret_cast<const f32x4*>(ost + row * 64 + c8 + 4);
      const float rl = __builtin_amdgcn_rcpf(li_l[row]); const u32x4 gg = g[h][i];
      u32x4 w;
      w.x = cvtpk(a[0] * rl * silu_f(__uint_as_float(gg.x << 16)), a[1] * rl * silu_f(__uint_as_float(gg.x & 0xffff0000u)));
      w.y = cvtpk(a[2] * rl * silu_f(__uint_as_float(gg.y << 16)), a[3] * rl * silu_f(__uint_as_float(gg.y & 0xffff0000u)));
      w.z = cvtpk(b[0] * rl * silu_f(__uint_as_float(gg.z << 16)), b[1] * rl * silu_f(__uint_as_float(gg.z & 0xffff0000u)));
      w.w = cvtpk(b[2] * rl * silu_f(__uint_as_float(gg.w << 16)), b[3] * rl * silu_f(__uint_as_float(gg.w & 0xffff0000u)));
      if (OUT8) { const float ys = rl * Y8_SCALE;
        int e0 = __builtin_amdgcn_cvt_pk_fp8_f32(a[0] * ys * silu_f(__uint_as_float(gg.x << 16)), a[1] * ys * silu_f(__uint_as_float(gg.x & 0xffff0000u)), 0, false);
        e0 = __builtin_amdgcn_cvt_pk_fp8_f32(a[2] * ys * silu_f(__uint_as_float(gg.y << 16)), a[3] * ys * silu_f(__uint_as_float(gg.y & 0xffff0000u)), e0, true);
        int e1 = __builtin_amdgcn_cvt_pk_fp8_f32(b[0] * ys * silu_f(__uint_as_float(gg.z << 16)), b[1] * ys * silu_f(__uint_as_float(gg.z & 0xffff0000u)), 0, false);
        e1 = __builtin_amdgcn_cvt_pk_fp8_f32(b[2] * ys * silu_f(__uint_as_float(gg.w << 16)), b[3] * ys * silu_f(__uint_as_float(gg.w & 0xffff0000u)), e1, true);
        typedef int i32x2y __attribute__((ext_vector_type(2))); *reinterpret_cast<i32x2y*>((char*)Yb + (unsigned)((rowb + row) * (DMODEL * 2) + h * 64 + c8)) = (i32x2y){e0, e1};
      } else
      *reinterpret_cast<u32x4*>((char*)Yb + (unsigned)(((rowb + row) * DMODEL + h * 64 + c8) * 2)) = w; }
    asm volatile("s_waitcnt lgkmcnt(0)" ::: "memory");
  }
}

template <int ZP>
__device__ __forceinline__ void dense_unit(const bf16* Qb, const bf16* Kh, const bf16* Vh, const bf16* Gb, bf16* Yb, int seq, char* lds) {
  int tid_ = threadIdx.x; asm volatile("" : "+v"(tid_));
  const int tid = tid_, wid = __builtin_amdgcn_readfirstlane(tid >> 6), lane = tid & 63, r32 = lane & 31, hi = lane >> 5;
  bf16* V_lds = (bf16*)lds; bf16* K_lds = (bf16*)(lds + 2 * SHM_V);
  float* ws = (float*)(lds + ATT_WS_OFF) + wid * 64; float* li_l = ws; float* al_l = ws + 32;
  float m_reg = -1e30f, l_reg = 0; f32x16 o[4] = {}; bf16x8 qr[8];
  { const unsigned qoff = (unsigned)((wid * QBLK + r32) * ZP + hi * 8) * 2u;
#pragma unroll
    for (int d0 = 0; d0 < 8; ++d0) qr[d0] = *reinterpret_cast<const bf16x8*>((const char*)Qb + qoff + d0 * 32); }
  const int sr = tid >> 4, sc = (tid & 15) * 8, vst0 = v_st(sr, sc), vst1 = v_st(32 + sr, sc);
  const LAS3 char* vp0 = (const LAS3 char*)V_lds + v_rd_base(lane);
  struct { bf16x8 vs0, vs1, ks0, ks1; } sr_[2];
  const unsigned soff = (unsigned)(sr * ZP + sc) * 2u;
#define SLOAD(i, k0) do { const char* vp_ = (const char*)Vh + (size_t)(k0) * (ZP * 2); const char* kp_ = (const char*)Kh + (size_t)(k0) * (ZP * 2); \
    sr_[i].vs0 = *reinterpret_cast<const bf16x8*>(vp_ + soff); sr_[i].vs1 = *reinterpret_cast<const bf16x8*>(vp_ + 32 * ZP * 2 + soff); \
    sr_[i].ks0 = *reinterpret_cast<const bf16x8*>(kp_ + soff); sr_[i].ks1 = *reinterpret_cast<const bf16x8*>(kp_ + 32 * ZP * 2 + soff); } while (0)
#define SWRITE(b, i) do { *(bf16x8*)((char*)V_lds + (b) * SHM_V + vst0) = sr_[i].vs0;          \
    *(bf16x8*)((char*)V_lds + (b) * SHM_V + vst1) = sr_[i].vs1; int kc = sc * 2;               \
    *(bf16x8*)((char*)K_lds + (b) * SHM_K + KSWZ(sr, kc)) = sr_[i].ks0;                       \
    *(bf16x8*)((char*)K_lds + (b) * SHM_K + KSWZ(32 + sr, kc)) = sr_[i].ks1; } while (0)
#define SWAIT() asm volatile("s_waitcnt vmcnt(4)" ::: "memory")
#define RESC(a) do { if (__any((a) < 1.f)) { if (hi == 0) al_l[r32] = (a); asm volatile("s_waitcnt lgkmcnt(0)" ::: "memory"); \
    _Pragma("unroll") for (int d = 0; d < 4; ++d) _Pragma("unroll") for (int r = 0; r < 16; ++r) o[d][r] *= al_l[crow(r, hi)]; } } while (0)
  f32x16 pA0, pA1, pB0, pB1; float mnA, mnB, alA, alB; bf16x8 pa0, pa1, pa2, pa3; const int NT = seq / KVBLK;
  constexpr int SE = 0, SO = 1;
  SLOAD(SE, 0); asm volatile("s_waitcnt vmcnt(0)" ::: "memory"); SWRITE(0, SE); __syncthreads();
  qkt(pA0, pA1, K_lds, qr, r32, hi); partialSM(pA0, pA1, m_reg, mnA, alA);
  SLOAD(SO, KVBLK); if (2 < NT) SLOAD(SE, 2 * KVBLK);
  SWAIT(); SWRITE(1, SO); __syncthreads();
  for (int j = 1; j + 1 < NT; j += 2) {
    SBAR(); qkt(pB0, pB1, (bf16*)((char*)K_lds + SHM_K), qr, r32, hi);
    finishSM(pA0, pA1, alA, l_reg, pa0, pa1, pa2, pa3); PIN_A(); SGB_A(); SBAR();
    SLOAD(SO, (j + 2) * KVBLK); SBAR();
    pv_all(o, vp0, pa0, pa1, pa2, pa3); partialSM_bf(pB0, pB1, m_reg, mnB, alB); PIN_B(pB0, pB1, alB); SGB_B(); SBAR();
    __syncthreads(); SWAIT(); SWRITE(0, SE);
    RESC(alB); __syncthreads();
    SBAR(); qkt(pA0, pA1, K_lds, qr, r32, hi);
    finishSM(pB0, pB1, alB, l_reg, pa0, pa1, pa2, pa3); PIN_A(); SGB_A(); SBAR();
    if (j + 3 < NT) SLOAD(SE, (j + 3) * KVBLK); SBAR();
    pv_all(o, vp0 + SHM_V, pa0, pa1, pa2, pa3); partialSM_bf(pA0, pA1, m_reg, mnA, alA); PIN_B(pA0, pA1, alA); SGB_B(); SBAR();
    __syncthreads(); SWAIT(); SWRITE(1, SO);
    RESC(alA); __syncthreads();
  }
  SBAR(); qkt(pB0, pB1, (bf16*)((char*)K_lds + SHM_K), qr, r32, hi);
  finishSM(pA0, pA1, alA, l_reg, pa0, pa1, pa2, pa3); SBAR();
  pv_all(o, vp0, pa0, pa1, pa2, pa3); partialSM(pB0, pB1, m_reg, mnB, alB);
  __syncthreads(); RESC(alB);
  finishSM(pB0, pB1, alB, l_reg, pa0, pa1, pa2, pa3); SBAR();
  pv_all(o, vp0 + SHM_V, pa0, pa1, pa2, pa3);
  store_gated<ZP>(o, l_reg, li_l, (float*)(lds + ATT_OST_OFF) + wid * 2048, Gb, Yb, wid, lane, r32, hi);
#undef SLOAD
#undef SWRITE
#undef SWAIT
}

template <bool SHIFT> __device__ __forceinline__ void fsSM1(f32x16& p0, float& ps, float nm) {
  _Pragma("unroll") for (int r = 0; r < 16; ++r) p0[r] = __builtin_amdgcn_exp2f(SHIFT ? p0[r] + nm : p0[r]);
  float s = p0[0];
  _Pragma("unroll") for (int r = 1; r < 16; ++r) s += p0[r];
  ps = s;
}
template <bool SHIFT> __device__ __forceinline__ void fsSM2(f32x16& p0, f32x16& p1, float ps, float nm, float& l_reg, bf16x8& pa0, bf16x8& pa1, bf16x8& pa2, bf16x8& pa3) {
  _Pragma("unroll") for (int r = 0; r < 16; ++r) p1[r] = __builtin_amdgcn_exp2f(SHIFT ? p1[r] + nm : p1[r]);
  _Pragma("unroll") for (int r = 0; r < 16; ++r) ps += p1[r];
  { auto rr = __builtin_amdgcn_permlane32_swap(__float_as_uint(ps), __float_as_uint(ps), false, false);
    ps = __uint_as_float(rr[0]) + __uint_as_float(rr[1]); }
  l_reg += ps;
  pack_p(p0, p1, pa0, pa1, pa2, pa3);
}
#define SGB_FA() do { __builtin_amdgcn_sched_group_barrier(0x100, 2, 0); _Pragma("unroll") for (int i_ = 0; i_ < 16; ++i_) { __builtin_amdgcn_sched_group_barrier(0x008, 1, 0); \
    __builtin_amdgcn_sched_group_barrier(0x100, 1, 0); __builtin_amdgcn_sched_group_barrier(0x400, 1, 0); __builtin_amdgcn_sched_group_barrier(0x002, 4, 0); } } while (0)
#define SGB_FB() do { __builtin_amdgcn_sched_group_barrier(0x100, 2, 0); _Pragma("unroll") for (int i_ = 0; i_ < 16; ++i_) { __builtin_amdgcn_sched_group_barrier(0x008, 1, 0); \
    __builtin_amdgcn_sched_group_barrier(0x100, 2, 0); __builtin_amdgcn_sched_group_barrier(0x400, 1, 0); __builtin_amdgcn_sched_group_barrier(0x002, 1, 0); } } while (0)
template <int ZP, bool SHIFT>
__device__ __forceinline__ void dense_unit_fs(const bf16* Qb, const bf16* Kh, const bf16* Vh, const bf16* Gb, bf16* Yb, int seq, float nm, char* lds) {
  int tid_ = threadIdx.x; asm volatile("" : "+v"(tid_));
  const int tid = tid_, wid = __builtin_amdgcn_readfirstlane(tid >> 6), lane = tid & 63, r32 = lane & 31, hi = lane >> 5;
  bf16* V_lds = (bf16*)lds; bf16* K_lds = (bf16*)(lds + 2 * SHM_V);
  float* ws = (float*)(lds + ATT_WS_OFF) + wid * 64; float* li_l = ws;
  float l_reg = 0; f32x16 o[4] = {}; bf16x8 qr[8];
  { const unsigned qoff = (unsigned)((wid * QBLK + r32) * ZP + hi * 8) * 2u;
#pragma unroll
    for (int d0 = 0; d0 < 8; ++d0) qr[d0] = *reinterpret_cast<const bf16x8*>((const char*)Qb + qoff + d0 * 32); }
  const int sr = tid >> 4, sc = (tid & 15) * 8, vst0 = v_st(sr, sc), vst1 = v_st(32 + sr, sc);
  const int vb0 = (int)(uintptr_t)V_lds + v_rd_base(lane);
  struct { bf16x8 vs0, vs1, ks0, ks1; } sr_[2];
  const unsigned soff = (unsigned)(sr * ZP + sc) * 2u;
#define SLOAD(i, k0) do { const char* vp_ = (const char*)Vh + (size_t)(k0) * (ZP * 2); const char* kp_ = (const char*)Kh + (size_t)(k0) * (ZP * 2); \
    sr_[i].vs0 = *reinterpret_cast<const bf16x8*>(vp_ + soff); sr_[i].vs1 = *reinterpret_cast<const bf16x8*>(vp_ + 32 * ZP * 2 + soff); \
    sr_[i].ks0 = *reinterpret_cast<const bf16x8*>(kp_ + soff); sr_[i].ks1 = *reinterpret_cast<const bf16x8*>(kp_ + 32 * ZP * 2 + soff); } while (0)
#define SWRITE(b, i) do { *(bf16x8*)((char*)V_lds + (b) * SHM_V + vst0) = sr_[i].vs0;          \
    *(bf16x8*)((char*)V_lds + (b) * SHM_V + vst1) = sr_[i].vs1; int kc = sc * 2;               \
    *(bf16x8*)((char*)K_lds + (b) * SHM_K + KSWZ(sr, kc)) = sr_[i].ks0;                       \
    *(bf16x8*)((char*)K_lds + (b) * SHM_K + KSWZ(32 + sr, kc)) = sr_[i].ks1; } while (0)
#define SWAIT() asm volatile("s_waitcnt vmcnt(4)" ::: "memory")
#define PINF_A() asm volatile("" : "+v"(pa0), "+v"(pa1), "+v"(pa2), "+v"(pa3), "+v"(l_reg))
#define PINF_B(P0, PS) asm volatile("" : "+v"(P0), "+v"(PS))
  f32x16 pA0, pA1, pB0, pB1; float psA, psB; bf16x8 pa0, pa1, pa2, pa3; const int NT = seq / KVBLK;
  constexpr int SE = 0, SO = 1;
  SLOAD(SE, 0); asm volatile("s_waitcnt vmcnt(0)" ::: "memory"); SWRITE(0, SE); __syncthreads();
  qkt(pA0, pA1, K_lds, qr, r32, hi); fsSM1<SHIFT>(pA0, psA, nm);
  SLOAD(SO, KVBLK); if (2 < NT) SLOAD(SE, 2 * KVBLK);
  SWAIT(); SWRITE(1, SO); __syncthreads();
  for (int j = 1; j + 1 < NT; j += 2) {
    SBAR(); qkt(pB0, pB1, (bf16*)((char*)K_lds + SHM_K), qr, r32, hi);
    fsSM2<SHIFT>(pA0, pA1, psA, nm, l_reg, pa0, pa1, pa2, pa3); SBAR();
    SLOAD(SO, (j + 2) * KVBLK); SBAR();
    pv_d0(o, vb0, pa0, pa1, pa2, pa3); fsSM1<SHIFT>(pB0, psB, nm); SBAR();
    __syncthreads(); SWAIT(); SWRITE(0, SE);
    __syncthreads();
    SBAR(); qkt(pA0, pA1, K_lds, qr, r32, hi);
    fsSM2<SHIFT>(pB0, pB1, psB, nm, l_reg, pa0, pa1, pa2, pa3); SBAR();
    if (j + 3 < NT) SLOAD(SE, (j + 3) * KVBLK); SBAR();
    pv_d0(o, vb0 + (int)SHM_V, pa0, pa1, pa2, pa3); fsSM1<SHIFT>(pA0, psA, nm); SBAR();
    __syncthreads(); SWAIT(); SWRITE(1, SO);
    __syncthreads();
  }
  SBAR(); qkt(pB0, pB1, (bf16*)((char*)K_lds + SHM_K), qr, r32, hi);
  fsSM2<SHIFT>(pA0, pA1, psA, nm, l_reg, pa0, pa1, pa2, pa3); SBAR();
  pv_d0(o, vb0, pa0, pa1, pa2, pa3); fsSM1<SHIFT>(pB0, psB, nm);
  __syncthreads();
  fsSM2<SHIFT>(pB0, pB1, psB, nm, l_reg, pa0, pa1, pa2, pa3); SBAR();
  pv_d0(o, vb0 + (int)SHM_V, pa0, pa1, pa2, pa3);
  store_gated<ZP>(o, l_reg, li_l, (float*)(lds + ATT_OST_OFF) + wid * 2048, Gb, Yb, wid, lane, r32, hi);
#undef SLOAD
#undef SWRITE
#undef SWAIT
#undef PINF_A
#undef PINF_B
}

typedef int v8i __attribute__((ext_vector_type(8)));
#ifndef F8_SCALE_B
#define F8_SCALE_B 0x7f7f7f7f
#endif
template <bool M4 = false>
__device__ __forceinline__ void qkt_f8(f32x16& p0, f32x16& p1, const LAS3 char* Ks, const v8i* q8, int kb0) {
  _Pragma("unroll") for (int r = 0; r < 16; ++r) { p0[r] = M4 ? -4.0f : 0.0f; p1[r] = M4 ? -4.0f : 0.0f; }
  _Pragma("unroll") for (int ks = 0; ks < 2; ++ks) {
    const int o0 = kb0 ^ (ks << 6);
    const u32x4 a0 = *(const LAS3 u32x4*)(Ks + o0), a1 = *(const LAS3 u32x4*)(Ks + (o0 ^ 16));
    const u32x4 b0 = *(const LAS3 u32x4*)(Ks + 4096 + o0), b1 = *(const LAS3 u32x4*)(Ks + 4096 + (o0 ^ 16));
    const v8i A0 = {(int)a0.x, (int)a0.y, (int)a0.z, (int)a0.w, (int)a1.x, (int)a1.y, (int)a1.z, (int)a1.w};
    const v8i A1 = {(int)b0.x, (int)b0.y, (int)b0.z, (int)b0.w, (int)b1.x, (int)b1.y, (int)b1.z, (int)b1.w};
    p0 = __builtin_amdgcn_mfma_scale_f32_32x32x64_f8f6f4(A0, q8[ks], p0, 0, 0, 0, 0x7f7f7f7f, 0, F8_SCALE_B);
    p1 = __builtin_amdgcn_mfma_scale_f32_32x32x64_f8f6f4(A1, q8[ks], p1, 0, 0, 0, 0x7f7f7f7f, 0, F8_SCALE_B); }
}
template <int ZP, bool SHIFT, bool OUT8>
__device__ __forceinline__ void dense_unit_f8(const unsigned char* Q8b, const unsigned char* K8h, const bf16* Vh, const bf16* Gb, bf16* Yb, int seq, float nm, char* lds) {
  int tid_ = threadIdx.x; asm volatile("" : "+v"(tid_));
  const int tid = tid_, wid = __builtin_amdgcn_readfirstlane(tid >> 6), lane = tid & 63, r32 = lane & 31, hi = lane >> 5;
  bf16* V_lds = (bf16*)lds; const LAS3 char* K_l = (const LAS3 char*)lds + 2 * SHM_V;
  float* ws = (float*)(lds + ATT_WS_OFF) + wid * 64; float* li_l = ws;
  float l_reg = 0; f32x16 o[4] = {}; v8i q8[2];
  { const unsigned char* qp = Q8b + (size_t)(wid * QBLK + r32) * 2048 + 32 * hi;
#pragma unroll
    for (int ks = 0; ks < 2; ++ks) { const u32x4 x = *(const u32x4*)(qp + 64 * ks), y = *(const u32x4*)(qp + 64 * ks + 16);
      q8[ks] = (v8i){(int)x.x, (int)x.y, (int)x.z, (int)x.w, (int)y.x, (int)y.y, (int)y.z, (int)y.w}; } }
  const int sr = tid >> 4, sc = (tid & 15) * 8, vst0 = v_st(sr, sc), vst1 = v_st(32 + sr, sc);
  const int kr = tid >> 3, kc = tid & 7, kst = kr * 128 + ((kc ^ ((kr >> 1) & 7)) << 4);
  const int kb0 = r32 * 128 + (((2 * hi) ^ ((r32 >> 1) & 7)) << 4);
  const int vb0 = (int)(uintptr_t)V_lds + v_rd_base(lane);
  struct { bf16x8 vs0, vs1; u32x4 k8; } sr_[2];
  const unsigned soff = (unsigned)(sr * ZP + sc) * 2u, koff = (unsigned)(kr * 512 + kc * 16);
#define SLOAD(i, k0) do { const char* vp_ = (const char*)Vh + (size_t)(k0) * (ZP * 2); \
    sr_[i].vs0 = *reinterpret_cast<const bf16x8*>(vp_ + soff); sr_[i].vs1 = *reinterpret_cast<const bf16x8*>(vp_ + 32 * ZP * 2 + soff); \
    sr_[i].k8 = *reinterpret_cast<const u32x4*>(K8h + (size_t)(k0) * 512 + koff); } while (0)
#define SWRITE(b, i) do { *(bf16x8*)((char*)V_lds + (b) * SHM_V + vst0) = sr_[i].vs0; *(bf16x8*)((char*)V_lds + (b) * SHM_V + vst1) = sr_[i].vs1; \
    *(LAS3 u32x4*)((LAS3 char*)K_l + (b) * SHM_K + kst) = sr_[i].k8; } while (0)
#define SWAIT() asm volatile("s_waitcnt vmcnt(3)" ::: "memory")
  f32x16 pA0, pA1, pB0, pB1; float psA, psB; bf16x8 pa0, pa1, pa2, pa3; const int NT = seq / KVBLK;
  constexpr int SE = 0, SO = 1;
  SLOAD(SE, 0); asm volatile("s_waitcnt vmcnt(0)" ::: "memory"); SWRITE(0, SE); __syncthreads();
  qkt_f8(pA0, pA1, K_l, q8, kb0); fsSM1<SHIFT>(pA0, psA, nm);
  SLOAD(SO, KVBLK); if (2 < NT) SLOAD(SE, 2 * KVBLK);
  SWAIT(); SWRITE(1, SO); __syncthreads();
  for (int j = 1; j + 1 < NT; j += 2) {
    SBAR(); qkt_f8(pB0, pB1, K_l + SHM_K, q8, kb0);
    fsSM2<SHIFT>(pA0, pA1, psA, nm, l_reg, pa0, pa1, pa2, pa3); SBAR();
    SLOAD(SO, (j + 2) * KVBLK); SBAR();
    pv_d0(o, vb0, pa0, pa1, pa2, pa3); fsSM1<SHIFT>(pB0, psB, nm);
    __syncthreads(); SWAIT(); SWRITE(0, SE);
    __syncthreads();
    SBAR(); qkt_f8(pA0, pA1, K_l, q8, kb0);
    fsSM2<SHIFT>(pB0, pB1, psB, nm, l_reg, pa0, pa1, pa2, pa3); SBAR();
    if (j + 3 < NT) SLOAD(SE, (j + 3) * KVBLK); SBAR();
    pv_d0(o, vb0 + (int)SHM_V, pa0, pa1, pa2, pa3); fsSM1<SHIFT>(pA0, psA, nm);
    __syncthreads(); SWAIT(); SWRITE(1, SO);
    __syncthreads();
  }
  SBAR(); qkt_f8(pB0, pB1, K_l + SHM_K, q8, kb0);
  fsSM2<SHIFT>(pA0, pA1, psA, nm, l_reg, pa0, pa1, pa2, pa3); SBAR();
  pv_d0(o, vb0, pa0, pa1, pa2, pa3); fsSM1<SHIFT>(pB0, psB, nm);
  __syncthreads();
  fsSM2<SHIFT>(pB0, pB1, psB, nm, l_reg, pa0, pa1, pa2, pa3); SBAR();
  pv_d0(o, vb0 + (int)SHM_V, pa0, pa1, pa2, pa3);
  store_gated<ZP, OUT8>(o, l_reg, li_l, (float*)(lds + ATT_OST_OFF) + wid * 2048, Gb, Yb, wid, lane, r32, hi);
#undef SLOAD
#undef SWRITE
#undef SWAIT
}

template <bool CLAMP> __device__ __forceinline__ void f8SM1(f32x16& p0) {
  _Pragma("unroll") for (int r = 0; r < 16; ++r) { const float e = __builtin_amdgcn_exp2f(p0[r]); p0[r] = CLAMP ? fminf(e, 49152.0f) : e; }
}
template <bool CLAMP> __device__ __forceinline__ void f8SM2(const f32x16& p0, f32x16& p1, v8i& P8) {
  _Pragma("unroll") for (int r = 0; r < 16; ++r) { const float e = __builtin_amdgcn_exp2f(p1[r]); p1[r] = CLAMP ? fminf(e, 49152.0f) : e; }
  _Pragma("unroll") for (int i = 0; i < 4; ++i) {
    int a = __builtin_amdgcn_cvt_pk_bf8_f32(p0[4 * i], p0[4 * i + 1], 0, false); a = __builtin_amdgcn_cvt_pk_bf8_f32(p0[4 * i + 2], p0[4 * i + 3], a, true);
    int b = __builtin_amdgcn_cvt_pk_bf8_f32(p1[4 * i], p1[4 * i + 1], 0, false); b = __builtin_amdgcn_cvt_pk_bf8_f32(p1[4 * i + 2], p1[4 * i + 3], b, true);
    auto r = __builtin_amdgcn_permlane32_swap((unsigned)a, (unsigned)b, false, false);
    P8[2 * i] = (int)r[0]; P8[2 * i + 1] = (int)r[1]; }
}
__device__ __forceinline__ void pv_f8(f32x16* o, f32x16& osum, const LAS3 char* Vs, int vb8, const v8i& P8, const v8i& ones8, int one) {
  _Pragma("unroll") for (int db = 0; db < 4; ++db) {
    const u32x4 x = *(const LAS3 u32x4*)(Vs + db * 2048 + vb8), y = *(const LAS3 u32x4*)(Vs + db * 2048 + (vb8 ^ 16));
    const v8i V8 = {(int)x.x, (int)x.y, (int)x.z, (int)x.w, (int)y.x, (int)y.y, (int)y.z, (int)y.w};
    asm volatile("v_mfma_scale_f32_32x32x64_f8f6f4 %0, %1, %2, %0, %3, %3 op_sel_hi:[0,0,0] cbsz:1" : "+v"(o[db]) : "v"(P8), "v"(V8), "v"(one)); }
  asm volatile("v_mfma_scale_f32_32x32x64_f8f6f4 %0, %1, %2, %0, %3, %3 op_sel_hi:[0,0,0] cbsz:1" : "+v"(osum) : "v"(P8), "v"(ones8), "v"(one));
}
template <int ZP, bool OUT8, bool CLAMP>
__device__ __forceinline__ void dense_unit_f8pv(const unsigned char* Q8b, const unsigned char* K8h, const unsigned char* VT8h, int vt_pitch, const bf16* Gb, bf16* Yb, int seq, char* lds) {
  int tid_ = threadIdx.x; asm volatile("" : "+v"(tid_));
  const int tid = tid_, wid = __builtin_amdgcn_readfirstlane(tid >> 6), lane = tid & 63, r32 = lane & 31, hi = lane >> 5;
  const LAS3 char* V_l = (const LAS3 char*)lds;
  const LAS3 char* K_l = (const LAS3 char*)lds + 2 * 16384;
  float* ws = (float*)(lds + ATT_WS_OFF) + wid * 64; float* li_l = ws;
  f32x16 o[4] = {}, osum = {}; v8i q8[2];
  v8i ones8; { int o1 = 0x38383838; asm volatile("" : "+v"(o1)); _Pragma("unroll") for (int i = 0; i < 8; ++i) ones8[i] = o1; }
  { const unsigned char* qp = Q8b + (size_t)(wid * QBLK + r32) * 2048 + 32 * hi;
#pragma unroll
    for (int ks = 0; ks < 2; ++ks) { const u32x4 x = *(const u32x4*)(qp + 64 * ks), y = *(const u32x4*)(qp + 64 * ks + 16);
      q8[ks] = (v8i){(int)x.x, (int)x.y, (int)x.z, (int)x.w, (int)y.x, (int)y.y, (int)y.z, (int)y.w}; } }
  const int kr = tid >> 3, kc = tid & 7, kst = kr * 128 + ((kc ^ ((kr >> 1) & 7)) << 4);
  const int vd = tid >> 2, vc = tid & 3, vst = vd * 64 + ((vc ^ ((vd >> 2) & 3)) << 4);
  const int kb0 = r32 * 128 + (((2 * hi) ^ ((r32 >> 1) & 7)) << 4);
  const int vb8 = r32 * 64 + (((2 * hi) ^ ((r32 >> 2) & 3)) << 4);
  int one = 0x7f7f7f7f; asm volatile("" : "+v"(one));
  struct { u32x4 v8a, k8a, v8b, k8b; } sr_[2];
  const unsigned koff = (unsigned)(kr * 512 + kc * 16); const size_t voff = (size_t)vd * vt_pitch + vc * 16;
#define SLOAD(i, k0) do { sr_[i].v8a = *reinterpret_cast<const u32x4*>(VT8h + voff + (k0)); sr_[i].k8a = *reinterpret_cast<const u32x4*>(K8h + (size_t)(k0) * 512 + koff); \
    sr_[i].v8b = *reinterpret_cast<const u32x4*>(VT8h + voff + (k0) + 64); sr_[i].k8b = *reinterpret_cast<const u32x4*>(K8h + (size_t)((k0) + 64) * 512 + koff); } while (0)
#define SWRITE(b, i) do { *(LAS3 u32x4*)((LAS3 char*)V_l + (b) * 16384 + vst) = sr_[i].v8a; *(LAS3 u32x4*)((LAS3 char*)K_l + (b) * 16384 + kst) = sr_[i].k8a; \
    *(LAS3 u32x4*)((LAS3 char*)V_l + (b) * 16384 + 8192 + vst) = sr_[i].v8b; *(LAS3 u32x4*)((LAS3 char*)K_l + (b) * 16384 + 8192 + kst) = sr_[i].k8b; } while (0)
#define SWAIT() asm volatile("s_waitcnt vmcnt(4)" ::: "memory")
#define TBAR() do { asm volatile("s_waitcnt lgkmcnt(0)" ::: "memory"); __builtin_amdgcn_s_barrier(); asm volatile("" ::: "memory"); } while (0)
  f32x16 p0, p1; v8i P8; const int NT = seq / (2 * KVBLK);
  constexpr int SE = 0, SO = 1;
#define TCL(t) (((t) < NT ? (t) : NT - 1) * (2 * KVBLK))
#define SUBT(SL, H) do { qkt_f8<true>(p0, p1, K_l + (SL) * 16384 + (H) * 8192, q8, kb0); f8SM1<CLAMP>(p0); f8SM2<CLAMP>(p0, p1, P8); SBAR(); \
    pv_f8(o, osum, V_l + (SL) * 16384 + (H) * 8192, vb8, P8, ones8, one); } while (0)
#define STEP(SL, SETN, jn) do { SWAIT(); SWRITE(1 - (SL), SETN); SLOAD(SETN, TCL(jn)); SBAR(); SUBT(SL, 0); SBAR(); SUBT(SL, 1); TBAR(); } while (0)
  SLOAD(SE, 0); asm volatile("s_waitcnt vmcnt(0)" ::: "memory"); SWRITE(0, SE); SLOAD(SO, 2 * KVBLK); SLOAD(SE, 4 * KVBLK); TBAR();
  for (int j = 0; j < NT; j += 2) {
    STEP(0, SO, j + 3);
    STEP(1, SE, j + 4);
  }
#undef SUBT
#undef STEP
#undef TCL
#undef TBAR
  asm volatile("s_nop 15\n\ts_nop 15" ::: "memory");
  if (r32 == 0) { _Pragma("unroll") for (int r = 0; r < 16; ++r) li_l[crow(r, hi)] = osum[r]; }
  store_gated<ZP, OUT8>(o, 0.f, li_l, (float*)(lds + ATT_OST_OFF) + wid * 2048, Gb, Yb, wid, lane, r32, hi, true);
#undef SLOAD
#undef SWRITE
#undef SWAIT
}

template <int MODE, int ZP, bool WLOC = false, int KVP = ZP, int VAR = 0>
__device__ __forceinline__ void local_unit(const bf16* Qb, const bf16* Kh, const bf16* Vh, const bf16* Gb, bf16* Yb, char* lds,
                                           int jlo, int jhi, int wlo, int whi, int pa, float fa, float fb, const float* rpbh, int rot = 0) {
  int tid_ = threadIdx.x; asm volatile("" : "+v"(tid_));
  const int tid = tid_, wid = __builtin_amdgcn_readfirstlane(tid >> 6), lane = tid & 63, r32 = lane & 31, hi = lane >> 5;
  bf16* V_lds = (bf16*)lds; bf16* K_lds = (bf16*)(lds + 2 * SHM_V);
  float* ws = (float*)(lds + ATT_WS_OFF) + wid * 64; float* li_l = ws; float* al_l = ws + 32;
  float* tab = (float*)(lds + ATT_TAB_OFF);
  __syncthreads();
  if (MODE == 1) { for (int i = tid; i < 465; i += 512) tab[64 + i] = rpbh[i] * LOG2E; }
  float m_reg = -1e30f, l_reg = 0; f32x16 o[4] = {}; bf16x8 qr[8];
  { const unsigned qoff = (unsigned)(((WLOC ? 0 : wid * QBLK) + r32) * ZP + hi * 8) * 2u;
#pragma unroll
    for (int d0 = 0; d0 < 8; ++d0) qr[d0] = *reinterpret_cast<const bf16x8*>((const char*)Qb + qoff + d0 * 32); }
  GateRegs GR; if (LU_GATE_EARLY) load_gate<ZP>(GR, Gb, WLOC ? 0 : wid * 32, lane);
  const int sr = tid >> 4, sc = (tid & 15) * 8, vst0 = v_st(sr, sc), vst1 = v_st(32 + sr, sc);
  const int vb0 = (int)(uintptr_t)V_lds + v_rd_base(lane);
  bf16x8 vs0, vs1, ks0, ks1;
  const unsigned soff = (unsigned)(sr * KVP + sc) * 2u;
#define LLOAD(k0) do { const char* vp_ = (const char*)Vh + (size_t)(k0) * (KVP * 2); const char* kp_ = (const char*)Kh + (size_t)(k0) * (KVP * 2); \
    vs0 = *reinterpret_cast<const bf16x8*>(vp_ + soff); vs1 = *reinterpret_cast<const bf16x8*>(vp_ + 32 * KVP * 2 + soff); \
    ks0 = *reinterpret_cast<const bf16x8*>(kp_ + soff); ks1 = *reinterpret_cast<const bf16x8*>(kp_ + 32 * KVP * 2 + soff); } while (0)
#define LWRITE(b) do { *(bf16x8*)((char*)V_lds + (b) * SHM_V + vst0) = vs0; *(bf16x8*)((char*)V_lds + (b) * SHM_V + vst1) = vs1; int kc = sc * 2;               \
    *(bf16x8*)((char*)K_lds + (b) * SHM_K + KSWZ(sr, kc)) = ks0; *(bf16x8*)((char*)K_lds + (b) * SHM_K + KSWZ(32 + sr, kc)) = ks1; } while (0)
  constexpr float C = SCALE * LOG2E;
  const float NEG_INF = -__builtin_inff();
  int cq = 0, cs = 0, tq = 0;
  if (MODE == 1) { cq = 32 * (wid & 1) + r32; cs = cq - 8; cs = cs < 0 ? 0 : (cs > 48 ? 48 : cs); }
  else { tq = pa + (WLOC ? 0 : wid * QBLK) + r32; }
  int j = jlo + rot;
  LLOAD(j * KVBLK);
  for (int t = jhi - jlo; t > 0; --t) {
    const int b = t & 1;
    int jn = j + 1; jn = jn >= jhi ? jlo : jn;
    if (!(VAR & 8)) { asm volatile("s_waitcnt vmcnt(0)" ::: "memory"); LWRITE(b);
    if (t > 1) LLOAD(jn * KVBLK); }
    __syncthreads();
    if (j >= wlo && j < whi) {
      f32x16 p0, p1;
      if (VAR & 1) { _Pragma("unroll") for (int r = 0; r < 16; ++r) { p0[r] = (float)(j + r) * 0.01f; p1[r] = (float)(j - r) * 0.01f; } }
      else qkt(p0, p1, (bf16*)((char*)K_lds + b * SHM_K), qr, r32, hi);
      if (VAR & 2) { l_reg += p0[0]; } else {
      if (MODE == 1) {
        const float* trow = tab + 64 + (j - pa + 7) * 31 + 15 + 4 * hi - cq;
        const int cb = 4 * hi - cs;
        float bv0[16], bv1[16];
#pragma unroll
        for (int r = 0; r < 16; ++r) { const int kc0 = (r & 3) + 8 * (r >> 2); bv0[r] = trow[kc0]; bv1[r] = trow[kc0 + 32]; }
#pragma unroll
        for (int r = 0; r < 16; ++r) { const int kc0 = (r & 3) + 8 * (r >> 2);
          const float x0 = fmaf(p0[r], C, bv0[r]), x1 = fmaf(p1[r], C, bv1[r]);
          p0[r] = ((unsigned)(kc0 + cb) < 16u) ? x0 : NEG_INF;
          p1[r] = ((unsigned)(kc0 + 32 + cb) < 16u) ? x1 : NEG_INF; }
      } else {
        const float basef = (float)(j * KVBLK + 4 * hi - tq);
#pragma unroll
        for (int r = 0; r < 16; ++r) { const float kcf = (float)((r & 3) + 8 * (r >> 2));
          const float d0 = fabsf(basef + kcf), d1 = fabsf(basef + (kcf + 32.0f));
          const float x0 = fmaf(d0, -fa, p0[r]), x1 = fmaf(d1, -fa, p1[r]);
          p0[r] = (d0 <= 128.0f) ? x0 : NEG_INF;
          p1[r] = (d1 <= 128.0f) ? x1 : NEG_INF; }
      }
      float pmax = p0[0];
#pragma unroll
      for (int r = 1; r < 16; ++r) pmax = fmaxf(pmax, p0[r]);
#pragma unroll
      for (int r = 0; r < 16; ++r) pmax = fmaxf(pmax, p1[r]);
      { auto rr = __builtin_amdgcn_permlane32_swap(__float_as_uint(pmax), __float_as_uint(pmax), false, false);
        pmax = fmaxf(__uint_as_float(rr[0]), __uint_as_float(rr[1])); }
      float mn = m_reg, alpha = 1.0f;
      if (!__all(pmax - m_reg <= 8.0f * LOG2E)) { mn = fmaxf(m_reg, pmax); alpha = __builtin_amdgcn_exp2f(m_reg - mn); m_reg = mn; }
      float ps = 0.f;
#pragma unroll
      for (int r = 0; r < 16; ++r) { p0[r] = __builtin_amdgcn_exp2f(p0[r] - mn); p1[r] = __builtin_amdgcn_exp2f(p1[r] - mn); ps += p0[r] + p1[r]; }
      { auto rr = __builtin_amdgcn_permlane32_swap(__float_as_uint(ps), __float_as_uint(ps), false, false);
        ps = __uint_as_float(rr[0]) + __uint_as_float(rr[1]); }
      l_reg = l_reg * alpha + ps;
      RESC(alpha);
      }
      bf16x8 pa0, pa1, pa2, pa3;
      pack_p(p0, p1, pa0, pa1, pa2, pa3);
      if (VAR & 4) { o[0][0] += (float)pa0[0] + (float)pa1[1] + (float)pa2[2] + (float)pa3[3]; }
      else pv_d0(o, vb0 + b * (int)SHM_V, pa0, pa1, pa2, pa3);
    }
    j = jn;
  }
  if (MODE == 2) l_reg += __builtin_amdgcn_exp2f(fb - m_reg);
  store_gated<ZP, false, LU_GATE_EARLY != 0>(o, l_reg, li_l, (float*)(lds + ATT_OST_OFF) + wid * 2048, Gb, Yb, wid, lane, r32, hi, false, WLOC ? 0 : wid * 32, &GR);
#undef LLOAD
#undef LWRITE
#undef RESC
}
#define PP_BAR() do { asm volatile("s_waitcnt lgkmcnt(0)" ::: "memory"); __builtin_amdgcn_s_barrier(); asm volatile("" ::: "memory"); } while (0)

template <int ZP, int VAR = 0>
__device__ __forceinline__ void dense_unit_pp(const bf16* Qb, const bf16* Kh, const bf16* Vh, const bf16* Gb, bf16* Yb, int NT, char* lds_g) {
  int tid_ = threadIdx.x; asm volatile("" : "+v"(tid_));
  const int tid = tid_, wid = __builtin_amdgcn_readfirstlane(tid >> 6), lane = tid & 63, r32 = lane & 31, hi = lane >> 5, grp = wid >> 2;
  LAS3 char* Vl = (LAS3 char*)lds_g; LAS3 char* Kl = Vl + 2 * SHM_V;
  float* ws = (float*)(lds_g + ATT_WS_OFF) + wid * 64; float* li_l = ws; float* al_l = ws + 32;
  float m_reg = -1e30f, l_reg = 0; f32x16 o[4] = {}; bf16x8 qr[8];
  { const unsigned qoff = (unsigned)((wid * QBLK + r32) * ZP + hi * 8) * 2u;
#pragma unroll
    for (int d0 = 0; d0 < 8; ++d0) qr[d0] = *reinterpret_cast<const bf16x8*>((const char*)Qb + qoff + d0 * 32); }
  const int sr = tid >> 4, sc = (tid & 15) * 8, vst0 = v_st(sr, sc), vst1 = v_st(32 + sr, sc), kst0 = KSWZ(sr, sc * 2), kst1 = KSWZ(32 + sr, sc * 2);
  const unsigned soff = (unsigned)(sr * ZP + sc) * 2u;
  const int vrb = v_rd_base(lane), kfb = r32 * 256 + ((hi * 16) ^ ((r32 & 7) << 4));
  bf16x8 aK0, aK1, aV0, aV1;
#define PP_TC(t) ((t) < NT ? (t) : NT - 1)
#define PP_GLD(r0, r1, base, t) do { const char* p_ = (const char*)(base) + (size_t)PP_TC(t) * (64 * ZP * 2); \
    r0 = *reinterpret_cast<const bf16x8*>(p_ + soff); r1 = *reinterpret_cast<const bf16x8*>(p_ + 32 * ZP * 2 + soff); } while (0)
#define PP_WRK(slot, r0, r1) do { *(LAS3 bf16x8*)(Kl + (slot) * SHM_K + kst0) = r0; *(LAS3 bf16x8*)(Kl + (slot) * SHM_K + kst1) = r1; } while (0)
#define PP_WRV(slot, r0, r1) do { *(LAS3 bf16x8*)(Vl + (slot) * SHM_V + vst0) = r0; *(LAS3 bf16x8*)(Vl + (slot) * SHM_V + vst1) = r1; } while (0)
#define PP_KF(Kp, rowoff, d0) (*(const LAS3 bf16x8*)((Kp) + (rowoff) + (kfb_ ^ ((d0) * 32))))
#define PP_KLD(dst, Kp, d0a) do { dst[0] = PP_KF(Kp, 0, d0a); dst[1] = PP_KF(Kp, 8192, d0a); dst[2] = PP_KF(Kp, 0, (d0a) + 1); dst[3] = PP_KF(Kp, 8192, (d0a) + 1); } while (0)
#define PP_KMM(src, d0a) do { p0 = __builtin_amdgcn_mfma_f32_32x32x16_bf16(src[0], qr[d0a], p0, 0, 0, 0); p1 = __builtin_amdgcn_mfma_f32_32x32x16_bf16(src[1], qr[d0a], p1, 0, 0, 0); \
    p0 = __builtin_amdgcn_mfma_f32_32x32x16_bf16(src[2], qr[(d0a) + 1], p0, 0, 0, 0); p1 = __builtin_amdgcn_mfma_f32_32x32x16_bf16(src[3], qr[(d0a) + 1], p1, 0, 0, 0); } while (0)
#define PP_VLD(dst, Vp, oda, ks0) do { dst[0] = vtr((Vp) + v_rd_off(oda, ks0, 0)); dst[1] = vtr((Vp) + v_rd_off(oda, ks0, 1)); dst[2] = vtr((Vp) + v_rd_off((oda) + 1, ks0, 0)); dst[3] = vtr((Vp) + v_rd_off((oda) + 1, ks0, 1)); \
    dst[4] = vtr((Vp) + v_rd_off(oda, (ks0) + 1, 0)); dst[5] = vtr((Vp) + v_rd_off(oda, (ks0) + 1, 1)); dst[6] = vtr((Vp) + v_rd_off((oda) + 1, (ks0) + 1, 0)); dst[7] = vtr((Vp) + v_rd_off((oda) + 1, (ks0) + 1, 1)); } while (0)
#define PP_PK(L, H) (bf16x8){L[0], L[1], L[2], L[3], H[0], H[1], H[2], H[3]}
#define PP_VMM(src, oda, pfa, pfb) do { o[oda] = __builtin_amdgcn_mfma_f32_32x32x16_bf16(pfa, PP_PK(src[0], src[1]), o[oda], 0, 0, 0); o[(oda) + 1] = __builtin_amdgcn_mfma_f32_32x32x16_bf16(pfa, PP_PK(src[2], src[3]), o[(oda) + 1], 0, 0, 0); \
    o[oda] = __builtin_amdgcn_mfma_f32_32x32x16_bf16(pfb, PP_PK(src[4], src[5]), o[oda], 0, 0, 0); o[(oda) + 1] = __builtin_amdgcn_mfma_f32_32x32x16_bf16(pfb, PP_PK(src[6], src[7]), o[(oda) + 1], 0, 0, 0); } while (0)
  f32x16 p0, p1; bf16x8 pa0, pa1, pa2, pa3;
#define RESC(a) do { if (__any((a) < 1.f)) { if (hi == 0) al_l[r32] = (a); asm volatile("s_waitcnt lgkmcnt(0)" ::: "memory"); \
    _Pragma("unroll") for (int d = 0; d < 4; ++d) _Pragma("unroll") for (int r = 0; r < 16; ++r) o[d][r] *= al_l[crow(r, hi)]; } } while (0)
#define PP_MF(KS, VS, DOQK) do { const LAS3 char* Kp_ = Kl + (KS) * SHM_K; const LAS3 char* Vp_ = Vl + (VS) * SHM_V + vrb; \
    bf16x8 ka_[4], kb_[4]; s16x4 va_[8], vb_[8]; int kfb_ = kfb; asm volatile("" : "+v"(kfb_)); \
    if (DOQK) { p0 = f32x16{}; p1 = f32x16{}; \
      PP_KLD(ka_, Kp_, 0); PP_KLD(kb_, Kp_, 2); SBAR(); PP_KMM(ka_, 0); SBAR(); PP_KLD(ka_, Kp_, 4); SBAR(); PP_KMM(kb_, 2); SBAR(); PP_KLD(kb_, Kp_, 6); SBAR(); \
      PP_KMM(ka_, 4); SBAR(); PP_VLD(va_, Vp_, 0, 0); SBAR(); PP_KMM(kb_, 6); SBAR(); } \
    else { PP_VLD(va_, Vp_, 0, 0); SBAR(); } \
    PP_VLD(vb_, Vp_, 0, 2); SBAR(); PP_VMM(va_, 0, pa0, pa1); SBAR(); PP_VLD(va_, Vp_, 2, 0); SBAR(); PP_VMM(vb_, 0, pa2, pa3); SBAR(); \
    PP_VLD(vb_, Vp_, 2, 2); SBAR(); PP_VMM(va_, 2, pa0, pa1); SBAR(); PP_VMM(vb_, 2, pa2, pa3); SBAR(); } while (0)
#define PP_SM() do { float mn_, al_; partialSM(p0, p1, m_reg, mn_, al_); finishSM(p0, p1, al_, l_reg, pa0, pa1, pa2, pa3); RESC(al_); } while (0)

  PP_GLD(aK0, aK1, Kh, 0); PP_GLD(aV0, aV1, Vh, 0);
  PP_WRK(0, aK0, aK1); PP_WRV(0, aV0, aV1);
  PP_GLD(aK0, aK1, Kh, 1);
  PP_WRK(1, aK0, aK1);
  PP_GLD(aK0, aK1, Kh, 2); PP_GLD(aV0, aV1, Vh, 1);
  PP_BAR();
  { const LAS3 char* Kp_ = Kl; bf16x8 ka_[4]; int kfb_ = kfb; asm volatile("" : "+v"(kfb_)); p0 = f32x16{}; p1 = f32x16{};
    PP_KLD(ka_, Kp_, 0); SBAR(); PP_KMM(ka_, 0); SBAR(); PP_KLD(ka_, Kp_, 2); SBAR(); PP_KMM(ka_, 2); SBAR(); PP_KLD(ka_, Kp_, 4); SBAR(); PP_KMM(ka_, 4); SBAR(); PP_KLD(ka_, Kp_, 6); SBAR(); PP_KMM(ka_, 6); SBAR(); }
  PP_SM();
  PP_BAR();
#define PP_STAGE(x, KSL, VSL) do { PP_WRK(KSL, aK0, aK1); PP_WRV(VSL, aV0, aV1); PP_GLD(aK0, aK1, Kh, (x) + 3); PP_GLD(aV0, aV1, Vh, (x) + 2); } while (0)
  if (grp == 1) { PP_STAGE(0, 0, 1); PP_BAR(); }
  for (int jt = 0; jt < NT; jt += 2) {
    if (grp == 0) PP_STAGE(jt, 0, 1);
    if (VAR != 2) { PP_MF(1, 0, true); } PP_BAR();
    if (grp == 1) PP_STAGE(jt + 1, 1, 0);
    if (VAR != 1) { PP_SM(); } PP_BAR();
    if (grp == 0) PP_STAGE(jt + 1, 1, 0);
    if (VAR != 2) { PP_MF(0, 1, jt + 2 < NT); } PP_BAR();
    if (grp == 1) PP_STAGE(jt + 2, 0, 1);
    if (VAR != 1 && jt + 2 < NT) { PP_SM(); }
    PP_BAR();
  }
  if (grp == 0) PP_BAR();
#undef PP_STAGE
  store_gated<ZP>(o, l_reg, li_l, (float*)(lds_g + ATT_OST_OFF) + wid * 2048, Gb, Yb, wid, lane, r32, hi);
#undef PP_TC
#undef PP_GLD
#undef PP_WRK
#undef PP_WRV
#undef PP_KF
#undef PP_KLD
#undef PP_KMM
#undef PP_VLD
#undef PP_PK
#undef PP_VMM
#undef PP_MF
#undef PP_SM
#undef RESC
}
}
constexpr int NWAVES = 8;
constexpr int S = 8192, DM = 4096, HD = 128, DEPTH = 4;
constexpr int NIN_E = 13312, NIN_O = 10240;
constexpr int E_QA = 0, E_KA = 2048, E_VA = 2560, E_QB = 3072, E_KB = 5120, E_VB = 7168, E_G = 9216;
constexpr int O_Q = 0, O_K = 4096, O_V = 5120, O_G = 6144;
constexpr float NORM_EPS = 1e-6f;
constexpr size_t MiB = 1u << 20;
#ifndef GATEB_F8
#define GATEB_F8 0
#endif
constexpr size_t WS_CTL = 0, CTL_ZERO_BYTES = 1 * MiB;
constexpr size_t WS_ROPE = 1 * MiB;
constexpr size_t WS_PART = 2 * MiB;
constexpr size_t WS_WIN_E = 8 * MiB, WIN_E_BYTES = (size_t)NIN_E * DM * 2;
constexpr size_t WS_WIN_O = WS_WIN_E + 2 * WIN_E_BYTES, WIN_O_BYTES = (size_t)NIN_O * DM * 2;
constexpr size_t WS_WOUT_E = WS_WIN_O + 2 * WIN_O_BYTES, WOUT_BYTES = (size_t)DM * DM * 2;
constexpr size_t WS_WOUT_O = WS_WOUT_E + 2 * WOUT_BYTES;
constexpr size_t WS_XB = WS_WOUT_O + 2 * WOUT_BYTES;
constexpr size_t WS_Y = WS_XB + (size_t)S * DM * 2;
constexpr size_t WS_Z = WS_Y + (size_t)S * DM * 2;
constexpr size_t WS_Q8 = WS_Z + (size_t)S * NIN_E * 2;
constexpr size_t WS_K8 = WS_Q8 + (size_t)S * 2048;
constexpr size_t WS_XB8 = WS_K8 + (size_t)S * 512;
constexpr size_t WS_W8 = WS_XB8 + (size_t)S * DM, W8_ROWS = GATEB_F8 ? 7168 : 5120, W8_BYTES = W8_ROWS * (size_t)DM;
constexpr size_t WS_VT8 = WS_W8 + 2 * W8_BYTES;
constexpr size_t WS_KVB = WS_VT8 + (size_t)512 * S;
constexpr size_t WS_XH = WS_KVB + (size_t)80 * S * 128 * 2;
constexpr size_t WS_END = WS_XH + (size_t)S * DM * 2;
constexpr float W8_SCALE = 64.0f;
constexpr int CW_BAR = 4096;
constexpr int RING_OFF = 0, RING_BYTES = 131072;
constexpr int LDSCTL_OFF = 143360, MISC_OFF = LDSCTL_OFF + 320;
constexpr int NRP_OFF = 131072;
constexpr int RSTD_OFF = 139264;
constexpr int LDS_BYTES = 147456;
static_assert(MISC_OFF + 128 <= LDS_BYTES && att::ATT_LDS_BYTES <= LDSCTL_OFF && RING_BYTES <= NRP_OFF && NRP_OFF + 8192 <= RSTD_OFF && RSTD_OFF + 1024 <= LDSCTL_OFF, "LDS map");

#define GAS __attribute__((address_space(1)))
#define LAS __attribute__((address_space(3)))
typedef unsigned short bf16;
typedef unsigned v4u __attribute__((ext_vector_type(4)));
typedef float f32x4 __attribute__((ext_vector_type(4)));
typedef GAS unsigned gu32;
#define LDS_WAIT() asm volatile("s_waitcnt lgkmcnt(0)" ::: "memory")
#define VM_WAIT() asm volatile("s_waitcnt vmcnt(0)" ::: "memory")
__device__ __forceinline__ unsigned pk2(float lo, float hi) { unsigned r; asm volatile("v_cvt_pk_bf16_f32 %0, %1, %2" : "=v"(r) : "v"(lo), "v"(hi)); return r; }
typedef _Float16 fh2 __attribute__((ext_vector_type(2)));
__device__ __forceinline__ unsigned pk2h(float lo, float hi) { const fh2 h = {(_Float16)lo, (_Float16)hi}; return __builtin_bit_cast(unsigned, h); }
#ifndef IN_F16
#define IN_F16 0
#endif
#define XB_TMO      128
#define XB_XCNT(j)  (256  + 64 * (j))
#define XB_XSUB(j)  (1280 + 64 * (j))
#define XB_XGEN(j)  (2304 + 64 * (j))
#define XB_TOP      3328
#define XB_TOPGEN   3392
#define XCD_BAR_WORDS 3456
#define XB_SPIN_CAP (1u << 18)

__device__ __forceinline__ unsigned xb_ld(unsigned* p)              { return __hip_atomic_load(p, __ATOMIC_RELAXED, __HIP_MEMORY_SCOPE_AGENT); }
__device__ __forceinline__ unsigned xb_add(unsigned* p, unsigned v) { return __hip_atomic_fetch_add(p, v, __ATOMIC_RELAXED, __HIP_MEMORY_SCOPE_AGENT); }
__device__ __forceinline__ unsigned xb_xcc_id() { return (unsigned)__builtin_amdgcn_s_getreg((3 << 11) | 20) & 0xFu; }
#define XB_SPIN(cond, bar) do { unsigned _sp = 0; while (cond) { __builtin_amdgcn_s_sleep(1); \
    if ((++_sp & 255u) == 0u) { if (xb_ld(&(bar)[XB_TMO])) break; if (_sp > XB_SPIN_CAP) { atomicAdd(&(bar)[XB_TMO], 1u); break; } } } } while (0)

struct XcdBarrier {
    unsigned* bar; unsigned x;
    volatile LAS unsigned* st;
};

__device__ __forceinline__ XcdBarrier xcd_barrier_post(unsigned* bar, volatile LAS unsigned* st) {
    XcdBarrier b; b.bar = bar; b.x = xb_xcc_id(); b.st = st;
    if (threadIdx.x == 0) (void)xb_add(&bar[XB_XCNT(b.x)], 1u);
    return b;
}
__device__ __forceinline__ void xcd_barrier_complete(unsigned* bar, unsigned x, unsigned& nloc, unsigned& nx) {
    const unsigned G = gridDim.x * gridDim.y * gridDim.z;
    unsigned sum, cnt, mine, sp = 0u;
    for (;;) {
        sum = 0u; cnt = 0u; mine = 0u;
#pragma unroll
        for (unsigned j = 0; j < 16; ++j) { const unsigned c = xb_ld(&bar[XB_XCNT(j)]); sum += c; cnt += (c > 0u) ? 1u : 0u; mine = (j == x) ? c : mine; }
        if (sum == G) break;
        __builtin_amdgcn_s_sleep(1);
        if ((++sp & 255u) == 0u) { if (xb_ld(&bar[XB_TMO])) break; if (sp > XB_SPIN_CAP) { atomicAdd(&bar[XB_TMO], 1u); break; } }
    }
    nloc = mine > 0u ? mine : 1u; nx = cnt > 0u ? cnt : 1u;
}

__device__ __forceinline__ void xcd_barrier(const XcdBarrier& b) {
    asm volatile("s_waitcnt vmcnt(0)" ::: "memory");
    __syncthreads();
    if (threadIdx.x == 0) {
        unsigned* bar = b.bar;
        __builtin_amdgcn_s_waitcnt(0);
        unsigned nloc = b.st[0], nx = b.st[1];
        if (nloc == 0u) { xcd_barrier_complete(bar, b.x, nloc, nx); b.st[0] = nloc; b.st[1] = nx; }
        const unsigned old = xb_add(&bar[XB_XSUB(b.x)], 1u);
        const unsigned gen = old / nloc;
        if (old + 1u == (gen + 1u) * nloc) {
            __builtin_amdgcn_fence(__ATOMIC_RELEASE, "agent");
            asm volatile("s_waitcnt vmcnt(0)" ::: "memory");
            const unsigned og = xb_add(&bar[XB_TOP], 1u);
            const unsigned tg = og / nx;
            if (og + 1u == (tg + 1u) * nx) xb_add(&bar[XB_TOPGEN], 1u);
            else XB_SPIN(xb_ld(&bar[XB_TOPGEN]) == tg, bar);
            __builtin_amdgcn_fence(__ATOMIC_ACQUIRE, "agent");
            xb_add(&bar[XB_XGEN(b.x)], 1u);
            asm volatile("s_waitcnt vmcnt(0)" ::: "memory");
        } else {
            XB_SPIN(xb_ld(&bar[XB_XGEN(b.x)]) == gen, bar);
            __builtin_amdgcn_fence(__ATOMIC_ACQUIRE, "agent");
            asm volatile("s_waitcnt vmcnt(0)" ::: "memory");
        }
    }
    __syncthreads();
}
#ifndef ITEM_KFAST
#define ITEM_KFAST 0
#endif
struct Frame {
    LAS unsigned char* lds;
    volatile LAS unsigned* MISC;
    gu32* ctl;
    int wave;
    int vcu, G;
};
__device__ __forceinline__ float wave_sum(float v) {
#pragma unroll
    for (int o = 1; o < 64; o <<= 1) v += __shfl_xor(v, o);
    return v;
}
__device__ __forceinline__ void transpose_item(const float* W, int N, const float* kscale, bf16* WT, LAS float* scr, int item, int lane, int nperm = 0, unsigned char* W8 = nullptr, int n8 = 0, int ksplit = 0, bool f16 = false) {
    const int kb = ITEM_KFAST ? (item & 63) : item / (N >> 6), nb = ITEM_KFAST ? (item >> 6) : item - kb * (N >> 6), k0 = kb << 6, n0 = nb << 6;
    const int lr = lane >> 4, lc = (lane & 15) << 2;
    f32x4 v[16];
#pragma unroll
    for (int i = 0; i < 16; ++i) v[i] = *(const f32x4*)(W + (size_t)(k0 + 4 * i + lr) * N + n0 + lc);
#pragma unroll
    for (int i = 0; i < 16; ++i) { const int k = 4 * i + lr; const float s = kscale ? kscale[k0 + k] : 1.0f;
        *(LAS f32x4*)(scr + k * 64 + (lc ^ (((k >> 3) & 3) << 3))) = v[i] * s; }
    LDS_WAIT(); asm volatile("" ::: "memory");
    const int c = lane & 7, nn = lane >> 3, f = (c & 3) << 3;
#pragma unroll
    for (int j = 0; j < 8; ++j) { const int n = nn + 8 * j; const LAS float* s = scr + (8 * c) * 64 + (n ^ f);
        v4u o; if (f16) { o.x = pk2h(s[0 * 64], s[1 * 64]); o.y = pk2h(s[2 * 64], s[3 * 64]); o.z = pk2h(s[4 * 64], s[5 * 64]); o.w = pk2h(s[6 * 64], s[7 * 64]); }
        else { o.x = pk2(s[0 * 64], s[1 * 64]); o.y = pk2(s[2 * 64], s[3 * 64]); o.z = pk2(s[4 * 64], s[5 * 64]); o.w = pk2(s[6 * 64], s[7 * 64]); }
        const int cn = n0 + n, dn = cn < nperm ? (cn & ~63) + 8 * ((cn & 31) >> 2) + 4 * ((cn >> 5) & 1) + (cn & 3) : cn;
        const bool to8 = n8 > 0 && (n0 < 3072 || (n0 >= 9216 && n0 < (GATEB_F8 ? 13312 : 11264)));
        if (to8) { const int dn8 = n0 < 3072 ? dn : 3072 + (cn - 9216); int e0 = __builtin_amdgcn_cvt_pk_fp8_f32(s[0 * 64] * W8_SCALE, s[1 * 64] * W8_SCALE, 0, false); e0 = __builtin_amdgcn_cvt_pk_fp8_f32(s[2 * 64] * W8_SCALE, s[3 * 64] * W8_SCALE, e0, true);
            int e1 = __builtin_amdgcn_cvt_pk_fp8_f32(s[4 * 64] * W8_SCALE, s[5 * 64] * W8_SCALE, 0, false); e1 = __builtin_amdgcn_cvt_pk_fp8_f32(s[6 * 64] * W8_SCALE, s[7 * 64] * W8_SCALE, e1, true);
            typedef int i32x2t __attribute__((ext_vector_type(2))); *(GAS i32x2t*)(W8 + (size_t)dn8 * DM + k0 + 8 * c) = (i32x2t){e0, e1}; }
        else if (k0 < ksplit) { int e0 = __builtin_amdgcn_cvt_pk_fp8_f32(s[0 * 64] * W8_SCALE, s[1 * 64] * W8_SCALE, 0, false); e0 = __builtin_amdgcn_cvt_pk_fp8_f32(s[2 * 64] * W8_SCALE, s[3 * 64] * W8_SCALE, e0, true);
            int e1 = __builtin_amdgcn_cvt_pk_fp8_f32(s[4 * 64] * W8_SCALE, s[5 * 64] * W8_SCALE, 0, false); e1 = __builtin_amdgcn_cvt_pk_fp8_f32(s[6 * 64] * W8_SCALE, s[7 * 64] * W8_SCALE, e1, true);
            typedef int i32x2u __attribute__((ext_vector_type(2))); *(GAS i32x2u*)((GAS unsigned char*)(WT + (size_t)dn * DM) + k0 + 8 * c) = (i32x2u){e0, e1}; }
        else *(GAS v4u*)(WT + (size_t)dn * DM + k0 + 8 * c) = o; }
    LDS_WAIT(); asm volatile("" ::: "memory");
}

__device__ __forceinline__ unsigned group_sync(gu32* cnt, unsigned need, unsigned* tmo, volatile LAS unsigned* bc) {
    asm volatile("s_waitcnt vmcnt(0)" ::: "memory");
    __syncthreads();
    if (threadIdx.x == 0) {
        __builtin_amdgcn_fence(__ATOMIC_RELEASE, "agent");
        asm volatile("s_waitcnt vmcnt(0)" ::: "memory");
        const unsigned ticket = __hip_atomic_fetch_add(cnt, 1u, __ATOMIC_RELAXED, __HIP_MEMORY_SCOPE_AGENT);
        unsigned sp = 0u;
        while (__hip_atomic_load(cnt, __ATOMIC_RELAXED, __HIP_MEMORY_SCOPE_AGENT) < need) { __builtin_amdgcn_s_sleep(1);
            if ((++sp & 255u) == 0u) { if (xb_ld(tmo)) break; if (sp > XB_SPIN_CAP) { atomicAdd(tmo, 1u); break; } } }
        __builtin_amdgcn_fence(__ATOMIC_ACQUIRE, "agent");
        asm volatile("s_waitcnt vmcnt(0)" ::: "memory");
        bc[0] = ticket;
    }
    __syncthreads();
    return bc[0];
}
constexpr int CW_GRP = 16384;

struct PanelOrder {
    int pm, k, f8;
    __device__ __forceinline__ bool next(int i, pg8::Unit& u) const {
        u.pm = pm;
#if GATEB_F8
        if (f8) { if (i < 3) { u.pn = k + 8 * i; return true; } if (i == 3 && k < 4) { u.pn = 24 + k; return true; } return false; }
        if (i < 3) { u.pn = 12 + k + 8 * i; return true; } return false;
#else
        if (f8) { if (i < 2) { u.pn = k + 8 * i; return true; } if (i == 2 && k < 4) { u.pn = 16 + k; return true; } return false; }
        if (i < 4) { const int j = k + 8 * i; u.pn = j < 24 ? 12 + j : 20 + j; return true; } return false;
#endif
    }
    __device__ __forceinline__ void a_ready(const pg8::Unit&) const {}
    __device__ __forceinline__ void done(const pg8::Unit&) const {}
};

struct Args { const float* in[11]; float* out; unsigned char* ws; int ph_lo, ph_hi; };
constexpr int PH_FINAL = 1 + 4 * DEPTH, PH_END = PH_FINAL + 1;
#ifndef DENSE_PP
#define DENSE_PP 1
#endif
#ifndef CONV_SH_LO
#define CONV_SH_LO 1
#endif
#ifndef CONV_SH_HI
#define CONV_SH_HI 2
#endif
#ifndef PV_F8
#define PV_F8 1
#endif
#ifndef OUT_F8
#define OUT_F8 1
#endif
#ifndef INP_F8
#define INP_F8 1
#endif
#ifndef DENSE_F8
#define DENSE_F8 1
#endif
#ifndef DENSE_FS
#define DENSE_FS 1
#endif
#ifndef F8_QS
#define F8_QS 1.0f
#endif
#if DENSE_F8
#define DENSE_QSCALE (att::SCALE * att::LOG2E * F8_QS)
#define DENSE_CALL(QO, KO, VP, GP, YP) do { const unsigned char* q8_ = ws + WS_Q8 + (size_t)(qb * 256) * 2048 + h * HD; const unsigned char* k8_ = ws + WS_K8 + kvh * HD; \
    bf16* yp_ = OUT_F8 ? (bf16*)((char*)Y + (size_t)(qb * 256) * (DM * 2) + h * HD) : (YP); \
    if (PV_F8) { if (dense_nm >= -19.5f) att::dense_unit_f8pv<NIN_E, OUT_F8 != 0, false>(q8_, k8_, ws + WS_VT8 + (size_t)kvh * HD * S, S, GP, yp_, S, al); \
                 else att::dense_unit_f8pv<NIN_E, OUT_F8 != 0, true>(q8_, k8_, ws + WS_VT8 + (size_t)kvh * HD * S, S, GP, yp_, S, al); }     \
    else if (dense_nm >= -40.0f) att::dense_unit_f8<NIN_E, false, OUT_F8 != 0>(q8_, k8_, VP, GP, yp_, S, dense_nm, al); else att::dense_unit_f8<NIN_E, true, OUT_F8 != 0>(q8_, k8_, VP, GP, yp_, S, dense_nm, al); } while (0)
#elif DENSE_FS
#define DENSE_QSCALE (att::SCALE * att::LOG2E)
#define DENSE_CALL(...) do { if (dense_nm >= -40.0f) att::dense_unit_fs<NIN_E, false>(__VA_ARGS__, S, dense_nm, al); else att::dense_unit_fs<NIN_E, true>(__VA_ARGS__, S, dense_nm, al); } while (0)
#elif DENSE_PP
#define DENSE_QSCALE 1.0f
#define DENSE_CALL(...) att::dense_unit_pp<NIN_E>(__VA_ARGS__, S / 64, al)
#else
#define DENSE_QSCALE 1.0f
#define DENSE_CALL(...) att::dense_unit<NIN_E>(__VA_ARGS__, S, al)
#endif
#ifndef ZP_O
#define ZP_O NIN_O
#endif
#ifndef WIN_GQA
#define WIN_GQA 1
#endif
#ifndef GROUP_SYNC
#define GROUP_SYNC 0
#endif
#ifndef TAIL_OUT_O
#define TAIL_OUT_O 0
#endif
#ifndef TAIL_INO_ITEMS
#define TAIL_INO_ITEMS 10240
#endif
#ifndef GEMM_ALIGN_OUT
#define GEMM_ALIGN_OUT true
#endif
#ifndef GEMM_SP2
#define GEMM_SP2 true
#endif
#ifndef GEMM_ALIGN
#define GEMM_ALIGN true
#endif
#ifndef REP_PRO
#define REP_PRO 1
#endif
#ifndef REP_IN
#define REP_IN 1
#endif
#ifndef REP_OUT0
#define REP_OUT0 1
#endif
#ifndef REP_DENSE
#define REP_DENSE 1
#endif
#ifndef HM_ALL
#define HM_ALL 1
#endif
#ifndef RES_F16
#define RES_F16 15
#endif
constexpr bool res_combo(bool ob, bool nf, int parity) { for (int L = parity; L < DEPTH; L += 2) { const bool o = L > 0 && ((RES_F16 >> (L - 1)) & 1), n = !((RES_F16 >> L) & 1); if (o == ob && n == nf) return true; } return false; }
#ifndef NA_HALF_REPS
#define NA_HALF_REPS 0
#endif
#ifndef NA_HALF_DIV
#define NA_HALF_DIV 2
#endif
#ifndef NA_ROT
#define NA_ROT 1
#endif
#ifndef WIN_ROT
#define WIN_ROT 1
#endif
#ifndef REP_NA
#define REP_NA 1
#endif
#ifndef REP_LOCAL
#define REP_LOCAL 1
#endif

__global__ void __launch_bounds__(NWAVES * 64, 2) mk_fwd(Args args) {
    extern __shared__ __attribute__((aligned(16))) unsigned char lds[];
    Frame F;
    F.lds = (LAS unsigned char*)lds;
    F.MISC = (volatile LAS unsigned*)(F.lds + MISC_OFF);
    F.wave = __builtin_amdgcn_readfirstlane((int)threadIdx.x >> 6);
    F.G = gridDim.x; { const int bx = blockIdx.x; F.vcu = (F.G % 8 == 0) ? (bx % 8) * (F.G / 8) + bx / 8 : bx; }
    unsigned char* ws = args.ws;
    F.ctl = (gu32*)(ws + WS_CTL);
    for (int u = ((int)threadIdx.x); u < (LDS_BYTES - LDSCTL_OFF) / 4; u += NWAVES * 64) ((LAS unsigned*)(F.lds + LDSCTL_OFF))[u] = 0u;
    __syncthreads();
    const int lo = args.ph_lo, hi = args.ph_hi;
    const bool use_bar = (hi - lo) > 1;
    XcdBarrier bar; bar.bar = (unsigned*)(F.ctl + CW_BAR); bar.x = 0; bar.st = nullptr;
    if (use_bar) bar = xcd_barrier_post((unsigned*)(F.ctl + CW_BAR), F.MISC + 8);
#define IN(k) (lo <= (k) && (k) < hi)
#if defined(DIAG_IDLE)
    unsigned long long idle_acc = 0;
#define SEAM(k) do { if (IN(k) && IN((k) + 1)) { const unsigned long long t0_ = __builtin_amdgcn_s_memrealtime(); xcd_barrier(bar); \
        if ((DIAG_IDLE >> (k)) & 1) idle_acc += __builtin_amdgcn_s_memrealtime() - t0_; } } while (0)
#else
#define SEAM(k) do { if (IN(k) && IN((k) + 1)) xcd_barrier(bar); } while (0)
#endif

#if defined(DIAG_PHT)
    unsigned long long pht = 0;
    if (DIAG_PHT & 1) pht -= __builtin_amdgcn_s_memrealtime();
#undef SEAM
#define SEAM(k) do { if (IN(k) && IN((k) + 1)) xcd_barrier(bar); if ((DIAG_PHT >> (k)) & 1) pht += __builtin_amdgcn_s_memrealtime(); } while (0)
#define CLK_BEGIN(k) do { if ((k) > 0 && ((DIAG_PHT >> (k)) & 1)) pht -= __builtin_amdgcn_s_memrealtime(); } while (0)
#define CLK_END(k) do {} while (0)
#elif defined(DIAG_CLK)
    unsigned long long clk_m = 0, clk_r = 0;
#define CLK_BEGIN(k) do { if ((k) == DIAG_CLK) { clk_m -= __builtin_amdgcn_s_memtime(); clk_r -= __builtin_amdgcn_s_memrealtime(); } } while (0)
#define CLK_END(k) do { if ((k) == DIAG_CLK) { clk_m += __builtin_amdgcn_s_memtime(); clk_r += __builtin_amdgcn_s_memrealtime(); } } while (0)
#else
#define CLK_BEGIN(k) do {} while (0)
#define CLK_END(k) do {} while (0)
#endif
    const float* x_in = args.in[0];
    float* X = args.out;
    float* PART = (float*)(ws + WS_PART);
    bf16* XB = (bf16*)(ws + WS_XB); bf16* Y = (bf16*)(ws + WS_Y); bf16* Z = (bf16*)(ws + WS_Z); bf16* KVB = (bf16*)(ws + WS_KVB);
    unsigned short* XH = IN_F16 ? (unsigned short*)XB : (unsigned short*)(ws + WS_XH);
    static_assert(!IN_F16 || RES_F16 == 15, "IN_F16 needs the fp16 residual stream in every layer");
    float* ROPE = (float*)(ws + WS_ROPE);
    const int gw = F.vcu * NWAVES + F.wave, NGW = F.G * NWAVES;

    if (IN(0)) {
      _Pragma("nounroll") for (int rep = 0; rep < REP_PRO; ++rep) {
        LAS float* scr = (LAS float*)(F.lds + RING_OFF + F.wave * 16384);
        constexpr int I_INE = 64 * (NIN_E / 64), I_OUT = 64 * (DM / 64);
        constexpr int NITEMS = 2 * I_INE + 4 * I_OUT + 2 * (64 * (NIN_O / 64) - TAIL_INO_ITEMS);
        for (int it = gw; it < NITEMS; it += NGW) {
            int r = it;
            if (r < I_INE) { transpose_item(args.in[2], NIN_E, args.in[1], (bf16*)(ws + WS_WIN_E), scr, r, ((int)threadIdx.x & 63), E_VA, ws + WS_W8, INP_F8 ? (int)W8_ROWS : 0, 0, IN_F16 != 0); continue; }
            r -= I_INE;
            if (r < I_OUT) { transpose_item(args.in[3], DM, nullptr, (bf16*)(ws + WS_WOUT_E), scr, r, ((int)threadIdx.x & 63), 0, nullptr, 0, OUT_F8 ? 2048 : 0); continue; }
            r -= I_OUT;
            if (r < I_OUT) { if (!TAIL_OUT_O) transpose_item(args.in[8], DM, nullptr, (bf16*)(ws + WS_WOUT_O), scr, r, ((int)threadIdx.x & 63)); continue; }
            r -= I_OUT;
            if (r < I_INE) { transpose_item(args.in[2] + (size_t)DM * NIN_E, NIN_E, args.in[1] + 2 * DM, (bf16*)(ws + WS_WIN_E + WIN_E_BYTES), scr, r, ((int)threadIdx.x & 63), E_VA, ws + WS_W8 + W8_BYTES, INP_F8 ? (int)W8_ROWS : 0, 0, IN_F16 != 0); continue; }
            r -= I_INE;
            if (r < I_OUT) { transpose_item(args.in[3] + (size_t)DM * DM, DM, nullptr, (bf16*)(ws + WS_WOUT_E + WOUT_BYTES), scr, r, ((int)threadIdx.x & 63), 0, nullptr, 0, OUT_F8 ? 2048 : 0); continue; }
            r -= I_OUT;
            if (r < I_OUT) { if (!TAIL_OUT_O) transpose_item(args.in[8] + (size_t)DM * DM, DM, nullptr, (bf16*)(ws + WS_WOUT_O + WOUT_BYTES), scr, r, ((int)threadIdx.x & 63)); continue; }
            r -= I_OUT;
            { constexpr int REST = 64 * (NIN_O / 64) - TAIL_INO_ITEMS; const int eo = r / (REST > 0 ? REST : 1); r -= eo * REST;
              transpose_item(args.in[7] + (size_t)eo * DM * NIN_O, NIN_O, args.in[1] + (2 * eo + 1) * DM, (bf16*)(ws + WS_WIN_O + eo * WIN_O_BYTES), scr, TAIL_INO_ITEMS + r, ((int)threadIdx.x & 63), 0, nullptr, 0, 0, IN_F16 != 0); }
        }
        for (int m = gw; m < S; m += NGW) {
            const GAS f32x4* xr = (const GAS f32x4*)(x_in + (size_t)m * DM) + ((int)threadIdx.x & 63);
            GAS unsigned long long* o8 = (GAS unsigned long long*)(XB + (size_t)m * DM) + ((int)threadIdx.x & 63);
            float ss = 0.f;
#pragma unroll
            for (int j = 0; j < 16; ++j) { const f32x4 v = xr[64 * j]; ss += (v.x * v.x + v.y * v.y) + (v.z * v.z + v.w * v.w);
                o8[64 * j] = IN_F16 ? ((unsigned long long)pk2h(v.x, v.y) | ((unsigned long long)pk2h(v.z, v.w) << 32)) : ((unsigned long long)pk2(v.x, v.y) | ((unsigned long long)pk2(v.z, v.w) << 32));
                if (INP_F8) { int e0 = __builtin_amdgcn_cvt_pk_fp8_f32(v.x, v.y, 0, false); e0 = __builtin_amdgcn_cvt_pk_fp8_f32(v.z, v.w, e0, true); ((GAS int*)(ws + WS_XB8 + (size_t)m * DM))[64 * j + ((int)threadIdx.x & 63)] = e0; } }
            ss = wave_sum(ss);
            PART[(size_t)m * 64 + ((int)threadIdx.x & 63)] = ((int)threadIdx.x & 63) == 0 ? ss : 0.f;
        }
        for (int i = blockIdx.x * 512 + ((int)threadIdx.x); i < 128 * 32; i += F.G * 512) {
            const int p = i >> 5, k = i & 31;
            double inv = 1.0; for (int q = 0; q < k; ++q) inv *= 0.7498942093324558;
            const double ang = (double)p * inv, n = __builtin_rint(ang * 0.6366197723675814);
            double r = __builtin_fma(-n, 1.5707963267948966, ang); r = __builtin_fma(-n, 6.123233995736766e-17, r);
            const double r2 = r * r;
            double sp = 2.8114572543455206e-15; sp = sp * r2 - 7.647163731819816e-13; sp = sp * r2 + 1.6059043836821613e-10; sp = sp * r2 - 2.505210838544172e-08; sp = sp * r2 + 2.7557319223985893e-06;
            sp = sp * r2 - 0.0001984126984126984; sp = sp * r2 + 0.008333333333333333; sp = sp * r2 - 0.16666666666666666; sp = sp * r2 + 1.0; sp *= r;
            double cp = 1.5619206968586225e-16; cp = cp * r2 - 4.779477332387385e-14; cp = cp * r2 + 1.1470745597729725e-11; cp = cp * r2 - 2.08767569878681e-09; cp = cp * r2 + 2.755731922398589e-07;
            cp = cp * r2 - 2.48015873015873e-05; cp = cp * r2 + 0.001388888888888889; cp = cp * r2 - 0.041666666666666664; cp = cp * r2 + 0.5; cp = 1.0 - cp * r2;
            const int q4 = (int)n & 3;
            const double cv = q4 == 0 ? cp : (q4 == 1 ? -sp : (q4 == 2 ? -cp : sp)), sv = q4 == 0 ? sp : (q4 == 1 ? cp : (q4 == 2 ? -sp : -cp));
            ROPE[2 * i] = (float)cv; ROPE[2 * i + 1] = (float)sv;
        }
      }
    }
    SEAM(0);

    int grp_ticket = 0, my_pm = 0;
    for (int L = 0; L < DEPTH; ++L) {
        const int e = L >> 1; const bool even = (L & 1) == 0;
        const int NIN = even ? NIN_E : NIN_O;
        const int pb = 1 + 4 * L;
        CLK_BEGIN(pb);
        if (IN(pb)) {
            const bf16* Wt = (const bf16*)(ws + (even ? WS_WIN_E + e * WIN_E_BYTES : WS_WIN_O + e * WIN_O_BYTES));
            pg8::Gemm g{XB, Wt, S, NIN, DM}; pg8::StaticOrder So; So.init(S, NIN, F.G, (int)blockIdx.x);
            LAS float* rstd = (LAS float*)(F.lds + RSTD_OFF);
            { pg8::Unit u0; So.next(0, u0);
                int t_ = ((int)threadIdx.x); asm volatile("" : "+v"(t_));
                const f32x4* pp = (const f32x4*)(PART + (size_t)(u0.pm * 256 + (t_ >> 1)) * 64 + (t_ & 1) * 32);
                f32x4 a = pp[0] + pp[1], b = pp[2] + pp[3], c = pp[4] + pp[5], d = pp[6] + pp[7]; a = (a + b) + (c + d);
                float s = (a[0] + a[1]) + (a[2] + a[3]); s += __shfl_xor(s, 1);
                if (!(t_ & 1)) rstd[t_ >> 1] = 1.0f / sqrtf(s * (1.0f / DM) + NORM_EPS);
                __syncthreads(); }
            pg8::EpiIn E{Z, even ? NIN_E : ZP_O, rstd, att::SCALE * att::LOG2E, even ? 0 : O_K / 256, KVB, HM_ALL ? (even ? E_QB / 256 : 0) : (even ? E_KB / 256 : O_K / 256), HM_ALL ? (even ? NIN_E / 256 : NIN_O / 256) : (even ? E_G / 256 : O_G / 256)};
#ifndef NO_GEMM_IN
            if (even) {
                PanelOrder Po; { pg8::Unit u0; So.next(0, u0); Po.pm = u0.pm; Po.k = ((int)blockIdx.x & 1) * 4 + ((int)blockIdx.x >> 6); }
                { pg8::EpiInA E8{Z, NIN_E, rstd, 1.0f / W8_SCALE, args.in[4] + e * HD, args.in[5] + e * HD, ROPE, (LAS float*)(F.lds + NRP_OFF), att::SCALE * att::LOG2E, ws + WS_Q8, ws + WS_K8, PV_F8 ? ws + WS_VT8 : nullptr, S};
                  pg8::Gemm g8{(const bf16*)(ws + WS_XB8), (const bf16*)(ws + WS_W8 + e * W8_BYTES), S, (int)W8_ROWS, DM / 2};
                  Po.f8 = 1; pg8::gemm_phase<pg8::EpiInA, PanelOrder, GEMM_ALIGN, GEMM_SP2, true>(F.lds + RING_OFF, g8, Po, E8); }
                Po.f8 = 0; pg8::gemm_phase<pg8::EpiIn, PanelOrder, GEMM_ALIGN, GEMM_SP2, false, 0, IN_F16 != 0>(F.lds + RING_OFF, g, Po, E);
                LAS float* scr = (LAS float*)(F.lds + RING_OFF + F.wave * 16384);
                constexpr int I_INO = 64 * (NIN_O / 64), SH_LO = CONV_SH_LO, SH_HI = CONV_SH_HI, PER_PANEL = I_INO / (S / 256);
                int ln = ((int)threadIdx.x & 63); asm volatile("" : "+v"(ln));
                constexpr int PER_LO = PER_PANEL * SH_LO / (4 * (SH_LO + SH_HI)), PER_HI = (PER_PANEL - 4 * PER_LO) / 4;
                const int i0 = Po.pm * PER_PANEL + (Po.k < 4 ? Po.k * PER_LO : 4 * PER_LO + (Po.k - 4) * PER_HI), i1 = i0 + (Po.k < 4 ? PER_LO : PER_HI);
                for (int it = i0 + F.wave; it < i1; it += NWAVES)
                    transpose_item(args.in[7] + (size_t)e * DM * NIN_O, NIN_O, args.in[1] + (2 * e + 1) * DM, (bf16*)(ws + WS_WIN_O + e * WIN_O_BYTES), scr, it, ln, 0, nullptr, 0, 0, IN_F16 != 0);
            } else {
            _Pragma("nounroll") for (int rep = 0; rep < REP_IN; ++rep)
            pg8::gemm_phase<pg8::EpiIn, pg8::StaticOrder, GEMM_ALIGN, GEMM_SP2, false, 0, IN_F16 != 0>(F.lds + RING_OFF, g, So, E);
            }
#endif
        }
        CLK_END(pb);
        SEAM(pb);
        CLK_BEGIN(pb + 2);
        if (IN(pb + 2)) {
            const int xcd = (int)blockIdx.x & 7, slot = (int)blockIdx.x >> 3;
            char* al = (char*)lds + RING_OFF;
            if (even) {
                float dense_nm;
                { const float* qw = args.in[4] + e * HD; const float* kw = args.in[5] + e * HD; int ln_ = (int)threadIdx.x & 63; asm volatile("" : "+v"(ln_));
                  float mq = fmaxf(fabsf(qw[ln_]), fabsf(qw[64 + ln_])), mk = fmaxf(fabsf(kw[ln_]), fabsf(kw[64 + ln_]));
#pragma unroll
                  for (int o_ = 1; o_ < 64; o_ <<= 1) { mq = fmaxf(mq, __shfl_xor(mq, o_)); mk = fmaxf(mk, __shfl_xor(mk, o_)); }
                  dense_nm = __builtin_amdgcn_readfirstlane(-(att::LOG2E * 11.313708498984761f * 1.01f) * mq * mk); }
                _Pragma("nounroll") for (int rep = 0; rep < REP_DENSE; ++rep)
                for (int u = (int)blockIdx.x; u < 512; u += F.G) {
                    const int h = (u / 256) * 8 + (u & 7), qb = (u & 255) >> 3, kvh = h >> 2;
                    const bf16* Zq = Z + (size_t)(qb * 256) * NIN_E;
#ifndef NO_DENSE
                    DENSE_CALL(Zq + E_QA + h * HD, Z + E_KA + kvh * HD, Z + E_VA + kvh * HD, Zq + E_G + h * HD, Y + (size_t)(qb * 256) * DM + h * HD);
#endif
                }
#if defined(PROBE_DENSE_VAR)
                if (L == 0) for (int u = (int)blockIdx.x; u < 512; u += F.G) {
                    const int h = (u / 256) * 8 + (u & 7), qb = (u & 255) >> 3, kvh = h >> 2;
                    const bf16* Zq = Z + (size_t)(qb * 256) * NIN_E;
                    att::dense_unit_pp<NIN_E, PROBE_DENSE_VAR>(Zq + E_QA + h * HD, Z + E_KA + kvh * HD, Z + E_VA + kvh * HD, Zq + E_G + h * HD, (bf16*)(ws + 900 * MiB) + (size_t)(qb * 256) * DM + h * HD, S / 64, al);
                }
#endif
                _Pragma("nounroll") for (int rep = 0; rep < REP_LOCAL * REP_NA; ++rep)
                for (int u = (int)blockIdx.x; u < 512; u += F.G) {
                    const int h = (u / 256) * 8 + (u & 7), blk = (u & 255) >> 3;
                    const int r0 = 4 * blk, rw = r0 + (F.wave >> 1);
                    int jlo = r0 - 4; jlo = jlo < 0 ? 0 : (jlo > 120 ? 120 : jlo);
                    int jh = r0 + 3 - 4; jh = jh < 0 ? 0 : (jh > 120 ? 120 : jh); jh += 8;
                    int wlo = rw - 4; wlo = wlo < 0 ? 0 : (wlo > 120 ? 120 : wlo);
                    const bf16* Zq = Z + (size_t)(blk * 256) * NIN_E;
#ifndef NO_NA
                    att::local_unit<1, HM_ALL ? HD : NIN_E, false, 128>(HM_ALL ? KVB + ((size_t)h * S + blk * 256) * HD : Zq + E_QB + h * HD, KVB + (size_t)((HM_ALL ? 16 : 0) + h) * S * HD, KVB + (size_t)((HM_ALL ? 32 : 16) + h) * S * HD, HM_ALL ? KVB + ((size_t)(64 + h) * S + blk * 256) * HD : Zq + E_G + 2048 + h * HD, Y + (size_t)(blk * 256) * DM + 2048 + h * HD, al,
                                              jlo, (rep < NA_HALF_REPS) ? jlo + (jh - jlo) / NA_HALF_DIV : jh, wlo, wlo + 8, rw, 0.f, 0.f, args.in[6] + ((size_t)e * 16 + h) * 465, (NA_ROT && jh - jlo == 12 && rep >= NA_HALF_REPS) ? (12 - jlo % 12) % 12 : 0);
#endif
                }
                (void)xcd; (void)slot;
            } else {
                _Pragma("nounroll") for (int rep = 0; rep < REP_LOCAL; ++rep)
#if WIN_GQA
#if defined(PROBE_WIN_VAR)
                for (int u = (int)blockIdx.x; u < 1024; u += F.G) {
                    const int kvh = u & 7, qblk = (u & 255) >> 3 | (u >> 8) << 5, q0 = qblk * 64, h = kvh * 4 + (F.wave >> 1), q0w = q0 + 32 * (F.wave & 1);
                    int klo = q0 - 128; klo = klo < 0 ? 0 : klo; int khi = q0 + 64 + 128; khi = khi > S ? S : khi;
                    int wl = q0w - 128; wl = wl < 0 ? 0 : wl; int wh = q0w + 31 + 128; wh = wh > S - 1 ? S - 1 : wh;
                    const float slope = exp2f(-8.0f * (float)(h + 1) / 32.0f);
                    const bf16* Zq = Z + (size_t)q0w * ZP_O;
                    att::local_unit<2, HD, true, 128, PROBE_WIN_VAR>(KVB + ((size_t)h * S + q0w) * HD, KVB + (size_t)(32 + kvh) * S * HD, KVB + (size_t)(40 + kvh) * S * HD, KVB + ((size_t)(48 + h) * S + q0w) * HD, (bf16*)(ws + 1100 * MiB) + (size_t)q0w * DM + h * HD, al,
                                              klo >> 6, khi >> 6, wl >> 6, (wh >> 6) + 1, q0w, slope * att::LOG2E, args.in[9][e * 32 + h] * att::LOG2E, nullptr, (WIN_ROT && (khi - klo) >> 6 == 5) ? (5 - (klo >> 6) % 5) % 5 : 0);
                }
#endif
                for (int u = (int)blockIdx.x; u < 1024; u += F.G) {
                    const int kvh = u & 7, qblk = (u & 255) >> 3 | (u >> 8) << 5, q0 = qblk * 64, h = kvh * 4 + (F.wave >> 1), q0w = q0 + 32 * (F.wave & 1);
                    int klo = q0 - 128; klo = klo < 0 ? 0 : klo; int khi = q0 + 64 + 128; khi = khi > S ? S : khi;
                    int wl = q0w - 128; wl = wl < 0 ? 0 : wl; int wh = q0w + 31 + 128; wh = wh > S - 1 ? S - 1 : wh;
                    const float slope = exp2f(-8.0f * (float)(h + 1) / 32.0f);
                    const bf16* Zq = Z + (size_t)q0w * ZP_O;
#ifndef NO_WIN
                    att::local_unit<2, HM_ALL ? HD : ZP_O, true, 128>(HM_ALL ? KVB + ((size_t)h * S + q0w) * HD : Zq + O_Q + h * HD, KVB + (size_t)((HM_ALL ? 32 : 0) + kvh) * S * HD, KVB + (size_t)((HM_ALL ? 40 : 8) + kvh) * S * HD, HM_ALL ? KVB + ((size_t)(48 + h) * S + q0w) * HD : Zq + O_G + h * HD, Y + (size_t)q0w * DM + h * HD, al,
                                              klo >> 6, khi >> 6, wl >> 6, (wh >> 6) + 1, q0w, slope * att::LOG2E, args.in[9][e * 32 + h] * att::LOG2E, nullptr, (WIN_ROT && (khi - klo) >> 6 == 5) ? (5 - (klo >> 6) % 5) % 5 : 0);
#endif
                }
#else
                for (int u = (int)blockIdx.x; u < 1024; u += F.G) {
                    const int h = (u / 256) * 8 + (u & 7), qb = (u & 255) >> 3, kvh = h >> 2, i0 = qb * 256, q0 = i0 + F.wave * 32;
                    int klo = i0 - 128; klo = klo < 0 ? 0 : klo; int khi = i0 + 256 + 128; khi = khi > S ? S : khi;
                    int wl = q0 - 128; wl = wl < 0 ? 0 : wl; int wh = q0 + 31 + 128; wh = wh > S - 1 ? S - 1 : wh;
                    const float slope = exp2f(-8.0f * (float)(h + 1) / 32.0f);
                    const bf16* Zq = Z + (size_t)i0 * ZP_O;
#ifndef NO_WIN
                    att::local_unit<2, ZP_O>(Zq + O_Q + h * HD, Z + O_K + kvh * HD, Z + O_V + kvh * HD, Zq + O_G + h * HD, Y + (size_t)i0 * DM + h * HD, al,
                                              klo >> 6, khi >> 6, wl >> 6, (wh >> 6) + 1, i0, slope * att::LOG2E, args.in[9][e * 32 + h] * att::LOG2E, nullptr);
#endif
                }
#endif
            }
        }
        CLK_END(pb + 2);
        SEAM(pb + 2);
        CLK_BEGIN(pb + 3);
        if (IN(pb + 3)) {
            const bf16* Wt = (const bf16*)(ws + (even ? WS_WOUT_E : WS_WOUT_O) + e * WOUT_BYTES);
            pg8::Gemm g{Y, Wt, S, DM, DM}; pg8::StaticOrder So; So.init(S, DM, F.G, (int)blockIdx.x);
            const bool oldb = L > 0 && ((RES_F16 >> (L - 1)) & 1), newf = !((RES_F16 >> L) & 1);
            bf16* xbo = (L == DEPTH - 1 || IN_F16) ? nullptr : XB; float* parto = L == DEPTH - 1 ? nullptr : PART;
            unsigned char* xb8o = (INP_F8 && L == 1) ? ws + WS_XB8 : nullptr;
#ifndef NO_GEMM_OUT
#define OUT_CASE(OB, NF) if (oldb == OB && newf == NF) { \
              if constexpr (res_combo(OB, NF, 0)) { if (even) { pg8::EpiOutT<OB, NF> E{L == 0 ? x_in : X, X, xbo, parto, xb8o, XH}; \
                if (OUT_F8) pg8::gemm_phase<pg8::EpiOutT<OB, NF>, pg8::StaticOrder, GEMM_ALIGN_OUT, GEMM_SP2, false, 16>(F.lds + RING_OFF, g, So, E, 1.0f / (att::Y8_SCALE * W8_SCALE)); \
                else pg8::gemm_phase<pg8::EpiOutT<OB, NF>, pg8::StaticOrder, GEMM_ALIGN_OUT, GEMM_SP2>(F.lds + RING_OFF, g, So, E); } } \
              if constexpr (res_combo(OB, NF, 1)) { if (!even) { pg8::EpiOutT<OB, NF> E{L == 0 ? x_in : X, X, xbo, parto, xb8o, XH}; \
                pg8::gemm_phase<pg8::EpiOutT<OB, NF>, pg8::StaticOrder, GEMM_ALIGN_OUT, GEMM_SP2>(F.lds + RING_OFF, g, So, E); } } }
            OUT_CASE(false, true) OUT_CASE(false, false) OUT_CASE(true, true) OUT_CASE(true, false)
#undef OUT_CASE
#endif
        }
#if defined(PROBE_OUT_LIGHT)
        if (IN(pb + 3) && L == 0) { const bf16* Wt = (const bf16*)(ws + WS_WOUT_E);
            pg8::Gemm g{Y, Wt, S, DM, DM}; pg8::StaticOrder So; So.init(S, DM, F.G, (int)blockIdx.x);
            pg8::EpiLight E{(bf16*)(ws + 900 * MiB)};
            pg8::gemm_phase<pg8::EpiLight, pg8::StaticOrder, GEMM_ALIGN, GEMM_SP2>(F.lds + RING_OFF, g, So, E); }
#endif
        CLK_END(pb + 3);
#if !GROUP_SYNC
        SEAM(pb + 3);
#else
        if (IN(pb + 3) && IN(pb + 4)) {
            pg8::StaticOrder So; So.init(S, DM, F.G, (int)blockIdx.x); pg8::Unit u0; So.next(0, u0); my_pm = u0.pm;
            grp_ticket = (int)group_sync(F.ctl + CW_GRP + (L * 32 + u0.pm) * 64, (unsigned)(F.G / (S / 256)), (unsigned*)(F.ctl + CW_BAR) + XB_TMO, F.MISC + 12);
        }
#endif
    }
    if (IN(PH_FINAL)) {
        const float* fw = args.in[10]; const int per = 256 / (F.G / (S / 256)), ln = (int)threadIdx.x & 63;
#if GROUP_SYNC
        for (int i = F.wave; i < per; i += NWAVES) { const int m = my_pm * 256 + grp_ticket * per + i;
#else
        (void)per; (void)my_pm; (void)grp_ticket;
        for (int m = gw; m < S; m += NGW) {
#endif
            GAS f32x4* xr = (GAS f32x4*)(X + (size_t)m * DM) + ln;
            f32x4 v[16]; float ss = 0.f;
            if ((RES_F16 >> (DEPTH - 1)) & 1) {
                const GAS v4u* xb = (const GAS v4u*)(XH + (size_t)m * DM) + ln;
#pragma unroll
                for (int j = 0; j < 8; ++j) { const v4u t = xb[64 * j];
                    v[2 * j] = f32x4{pg8::h_lo(t.x), pg8::h_hi(t.x), pg8::h_lo(t.y), pg8::h_hi(t.y)};
                    v[2 * j + 1] = f32x4{pg8::h_lo(t.z), pg8::h_hi(t.z), pg8::h_lo(t.w), pg8::h_hi(t.w)}; }
#pragma unroll
                for (int j = 0; j < 16; ++j) ss += (v[j].x * v[j].x + v[j].y * v[j].y) + (v[j].z * v[j].z + v[j].w * v[j].w);
                const float rs = 1.0f / sqrtf(wave_sum(ss) * (1.0f / DM) + NORM_EPS);
                GAS f32x4* xo = (GAS f32x4*)(X + (size_t)m * DM) + 2 * ln;
#pragma unroll
                for (int j = 0; j < 16; ++j) { const f32x4 w = ((const f32x4*)fw)[128 * (j >> 1) + 2 * ln + (j & 1)]; xo[128 * (j >> 1) + (j & 1)] = v[j] * rs * w; }
                continue;
            }
#pragma unroll
            for (int j = 0; j < 16; ++j) { v[j] = xr[64 * j]; ss += (v[j].x * v[j].x + v[j].y * v[j].y) + (v[j].z * v[j].z + v[j].w * v[j].w); }
            const float rs = 1.0f / sqrtf(wave_sum(ss) * (1.0f / DM) + NORM_EPS);
#pragma unroll
            for (int j = 0; j < 16; ++j) { const f32x4 w = ((const f32x4*)fw)[64 * j + ln]; xr[64 * j] = v[j] * rs * w; }
        }
    }
#if defined(DIAG_PHT)
    if (blockIdx.x == 0 && ((int)threadIdx.x) == 0) { const unsigned long long dt = pht * DIAG_PHT_K, t0_ = __builtin_amdgcn_s_memrealtime();
        while (__builtin_amdgcn_s_memrealtime() - t0_ < dt) __builtin_amdgcn_s_sleep(32); }
#elif defined(DIAG_CLK)
    if (blockIdx.x == 0 && ((int)threadIdx.x) == 0) { const unsigned long long mhz = (clk_m * 100ull) / (clk_r ? clk_r : 1ull);
        const unsigned long long dt = mhz * 50ull, t0_ = __builtin_amdgcn_s_memrealtime();
        while (__builtin_amdgcn_s_memrealtime() - t0_ < dt) __builtin_amdgcn_s_sleep(32); }
#endif
#if defined(DIAG_IDLE)
    if (((int)threadIdx.x) == 0) { atomicAdd((unsigned long long*)(F.ctl + 2048), idle_acc); atomicAdd((unsigned long long*)(F.ctl + 2048 + 64 + 64 * (bar.x & 7u)), idle_acc); }
    xcd_barrier(bar);
    if (blockIdx.x == 0 && ((int)threadIdx.x) == 0) { const unsigned long long tot = __hip_atomic_load((unsigned long long*)(F.ctl + 2048), __ATOMIC_RELAXED, __HIP_MEMORY_SCOPE_AGENT);
#if defined(DIAG_XCD_SPREAD)
        unsigned long long mx = 0, mnv = ~0ull; for (int j = 0; j < 8; ++j) { const unsigned long long v = __hip_atomic_load((unsigned long long*)(F.ctl + 2048 + 64 + 64 * j), __ATOMIC_RELAXED, __HIP_MEMORY_SCOPE_AGENT); mx = v > mx ? v : mx; mnv = v < mnv ? v : mnv; }
#if defined(DIAG_XCD_ARGMIN)
        int amin = 0; for (int j = 0; j < 8; ++j) { const unsigned long long v = __hip_atomic_load((unsigned long long*)(F.ctl + 2048 + 64 + 64 * j), __ATOMIC_RELAXED, __HIP_MEMORY_SCOPE_AGENT); if (v == mnv) amin = j; }
        const unsigned long long dt = (unsigned long long)(amin + 1) * 10000ull, t0_ = __builtin_amdgcn_s_memrealtime();
#else
        const unsigned long long dt = ((mx - mnv) / (unsigned long long)(F.G / 8)) * DIAG_K, t0_ = __builtin_amdgcn_s_memrealtime();
#endif
#else
        const unsigned long long dt = (tot / (unsigned long long)F.G) * DIAG_K, t0_ = __builtin_amdgcn_s_memrealtime();
#endif
        while (__builtin_amdgcn_s_memrealtime() - t0_ < dt) __builtin_amdgcn_s_sleep(32); }
#endif
#undef IN
#undef SEAM
}

#ifndef MK_SPLIT
#define MK_SPLIT 0
#endif
extern "C" void kernel_launch(void* const* d_in, const int* in_sizes, int n_in, void* d_out, int out_size, void* d_ws, size_t ws_size, hipStream_t stream) {
    static int grid = 0;
    if (grid == 0) {
        if (n_in != 11 || in_sizes[0] != S * DM || out_size != S * DM || ws_size < WS_END) {
            fprintf(stderr, "kernel_launch: shape mismatch: n_in %d in0 %d out %d ws %zu (need %zu)\n", n_in, n_in > 0 ? in_sizes[0] : -1, out_size, ws_size, (size_t)WS_END); grid = -1; return; }
        int dev = 0, cus = 0, per_cu = 0;
        if (hipGetDevice(&dev) != hipSuccess || hipDeviceGetAttribute(&cus, hipDeviceAttributeMultiprocessorCount, dev) != hipSuccess) { grid = -1; return; }
        if (hipFuncSetAttribute((const void*)mk_fwd, hipFuncAttributeMaxDynamicSharedMemorySize, LDS_BYTES) != hipSuccess) { fprintf(stderr, "kernel_launch: hipFuncSetAttribute failed\n"); grid = -1; return; }
        if (hipOccupancyMaxActiveBlocksPerMultiprocessor(&per_cu, (const void*)mk_fwd, NWAVES * 64, LDS_BYTES) != hipSuccess || per_cu < 1)
            fprintf(stderr, "kernel_launch: note: occupancy query reports %d workgroups per CU\n", per_cu);
        (void)hipGetLastError();
        grid = cus;
        if (grid % (S / 256) != 0 || 256 % (grid / (S / 256)) != 0) { fprintf(stderr, "kernel_launch: grid %d does not split into equal panel groups; nothing launched\n", grid); grid = -1; return; }
        { int cntp[S / 256] = {0};
            for (int c = 0; c < grid; ++c) { pg8::StaticOrder A_, B_, C_; A_.init(S, NIN_E, grid, c); B_.init(S, NIN_O, grid, c); C_.init(S, DM, grid, c); pg8::Unit a, b, d; A_.next(0, a); B_.next(0, b); C_.next(0, d);
                if (a.pm != d.pm || b.pm != d.pm) { fprintf(stderr, "kernel_launch: workgroup %d owns different row panels in different GEMMs; nothing launched\n", c); grid = -1; return; } ++cntp[d.pm]; }
            for (int p = 0; p < S / 256; ++p) if (cntp[p] != grid / (S / 256)) { fprintf(stderr, "kernel_launch: panel %d has %d owners; nothing launched\n", p, cntp[p]); grid = -1; return; } }
        { const int Ns[3] = {NIN_E, NIN_O, DM};
            for (int k = 0; k < 3; ++k) for (int c = 0; c < grid; ++c) { pg8::StaticOrder So; So.init(S, Ns[k], grid, c); pg8::Unit u0, u; if (!So.next(0, u0)) continue;
                for (int i = 1; So.next(i, u); ++i) if (u.pm != u0.pm) { fprintf(stderr, "kernel_launch: unit order gives workgroup %d two row panels (N %d); nothing launched\n", c, Ns[k]); grid = -1; return; } } }
    }
    if (grid < 0) return;
    if (hipMemsetAsync((char*)d_ws + WS_CTL, 0, CTL_ZERO_BYTES, stream) != hipSuccess) { fprintf(stderr, "kernel_launch: memset failed\n"); return; }
    Args a{};
    for (int i = 0; i < 11; ++i) a.in[i] = (const float*)d_in[i];
    a.out = (float*)d_out; a.ws = (unsigned char*)d_ws;
#if MK_SPLIT
    for (int p = 0; p < PH_END; ++p) { a.ph_lo = p; a.ph_hi = p + 1; hipLaunchKernelGGL(mk_fwd, dim3(grid), dim3(NWAVES * 64), LDS_BYTES, stream, a); }
#else
    a.ph_lo = 0; a.ph_hi = PH_END;
    hipLaunchKernelGGL(mk_fwd, dim3(grid), dim3(NWAVES * 64), LDS_BYTES, stream, a);
#endif
    const hipError_t le = hipPeekAtLastError();
    if (le != hipSuccess) fprintf(stderr, "kernel_launch: launch failed: %s\n", hipGetErrorName(le));
}
```

```cpp
#include <hip/hip_runtime.h>
#include <cstdio>
#include <cstdint>
namespace pg8 {
#define PG8_LAS __attribute__((address_space(3)))
typedef unsigned short bf16_t;
typedef short bf16x8 __attribute__((ext_vector_type(8)));
typedef float f32x4 __attribute__((ext_vector_type(4)));
typedef unsigned u32x4 __attribute__((ext_vector_type(4)));
constexpr int BM = 256, BK = 64, HALF = 128, HTB = HALF * BK * 2  , STAGE_BYTES = 8 * HTB, NXCD = 8, WGM = 8;

__host__ __device__ __forceinline__ int lds_byte(int r, int c) { const int st = (r >> 4) * 2 + (c >> 5), rr = r & 15, cc = c & 31, ob = rr * 64 + cc * 2; return st * 1024 + (ob ^ (((ob >> 9) & 1) << 5)); }
__host__ __device__ __forceinline__ void stage_rc(int b, int& R, int& C) { const int st = b / 1024, sb = b % 1024, swz = sb ^ (((sb >> 9) & 1) << 5); R = (st >> 1) * 16 + swz / 64; C = (st & 1) * 32 + (swz % 64) / 2; }
__host__ __device__ __forceinline__ int perm32(int rho) { const int n = rho >> 4, i = rho & 15; return 8 * (i >> 2) + 4 * n + (i & 3); }

struct Unit { int pm, pn; };
struct Gemm { const bf16_t* A; const bf16_t* Bt; int M, N, K; };

struct StaticOrder {
    int nM, nN, nwg, G, c;
    __host__ __device__ void init(int M, int N, int G_, int c_) { nM = M / BM; nN = N / BM; nwg = nM * nN; G = G_; c = c_; }
    __host__ __device__ bool next(int i, Unit& u) const {
        const long L = (long)i * G + c; if (L >= nwg) return false;
        int wgid = (int)L; { const int q = nwg / NXCD, r = nwg % NXCD, xcd = wgid % NXCD, off = wgid / NXCD; wgid = (xcd < r ? xcd * (q + 1) : r * (q + 1) + (xcd - r) * q) + off; }
        const int nig = WGM * nN, gid = wgid / nig, fm = gid * WGM, gsz = (nM - fm) < WGM ? (nM - fm) : WGM;
        u.pm = fm + ((wgid % nig) % gsz); u.pn = (wgid % nig) / gsz; return true;
    }
    __device__ __forceinline__ void a_ready(const Unit&) const {}
    __device__ __forceinline__ void done(const Unit&) const {}
};

__device__ __forceinline__ unsigned cvt_pk_bf16(float lo, float hi) { unsigned r; asm volatile("v_cvt_pk_bf16_f32 %0, %1, %2" : "=v"(r) : "v"(lo), "v"(hi)); return r; }
typedef float f32x2 __attribute__((ext_vector_type(2)));
#ifndef NT_Z
#define NT_Z 0
#endif
#ifndef NT_X
#define NT_X 0
#endif
#if NT_Z
#define ST_Z(p, v) __builtin_nontemporal_store((v), (p))
#else
#define ST_Z(p, v) (*(p) = (v))
#endif
#if NT_X
#define ST_X(p, v) __builtin_nontemporal_store((v), (p))
#else
#define ST_X(p, v) (*(p) = (v))
#endif
struct EpiIn {
    static constexpr bool PERM = true, AFTER_DRAIN = false;
    bf16_t* Z; int ldz; const PG8_LAS float* rstd; float qscale; int sc_tiles;
    bf16_t* kv; int kv_t0, kv_t1;
    __device__ __forceinline__ void operator()(const f32x4 (&acc)[2][2][4][2], const Unit& u, int wr, int wc, int fr, int fq) const {
        const float cs = u.pn < sc_tiles ? qscale : 1.0f;
        const bool tokv = u.pn >= kv_t0 && u.pn < kv_t1;
        char* base = tokv ? (char*)(kv + (size_t)(u.pn - kv_t0) * 2 * 8192 * 128) : (char*)(Z + u.pn * BM);
        const unsigned pitch = tokv ? 256u : (unsigned)ldz * 2u, bjs = tokv ? 8192u * 256u : (unsigned)HALF * 2u;
        const unsigned lane_off = (unsigned)(u.pm * BM + wr * 64 + fr) * pitch + (unsigned)(wc * 32 + 8 * fq) * 2u;
#pragma unroll
        for (int ai = 0; ai < 2; ++ai)
#pragma unroll
            for (int m = 0; m < 4; ++m) {
                const float rs = rstd[ai * HALF + wr * 64 + m * 16 + fr] * cs;
                char* rowp = base + (lane_off + (unsigned)(ai * HALF + m * 16) * pitch);
#pragma unroll
                for (int bj = 0; bj < 2; ++bj) { const f32x4 v0 = acc[ai][bj][m][0] * rs, v1 = acc[ai][bj][m][1] * rs;
                    u32x4 w; w.x = cvt_pk_bf16(v0[0], v0[1]); w.y = cvt_pk_bf16(v0[2], v0[3]); w.z = cvt_pk_bf16(v1[0], v1[1]); w.w = cvt_pk_bf16(v1[2], v1[3]);
                    ST_Z((u32x4*)(rowp + bj * bjs), w); }
            }
    }
};
struct EpiInA {
    static constexpr bool PERM = true, AFTER_DRAIN = false;
    bf16_t* Z; int ldz; const PG8_LAS float* rstd; float zmul;
    const float* qn; const float* kn; const float* rope; PG8_LAS float* P; float qscale; unsigned char* q8; unsigned char* k8; unsigned char* vt8; int vt_pitch;
    __device__ __forceinline__ void operator()(const f32x4 (&acc)[2][2][4][2], const Unit& u, int wr, int wc, int fr_, int fq_) const {
        int fr = fr_, fq = fq_; asm volatile("" : "+v"(fr), "+v"(fq));
        const int row0 = u.pm * BM + wr * 64 + fr, col0 = (u.pn < 12 ? u.pn * BM : 9216 + (u.pn - 12) * BM) + wc * 32 + 8 * fq;
        const PG8_LAS float* rsp = rstd + wr * 64 + fr;
#define RS_(ai, m) (rsp[(ai) * HALF + (m) * 16] * zmul)
        if (vt8 && (u.pn == 10 || u.pn == 11)) {
            const int c0 = (u.pn - 10) * BM + wc * 32 + 8 * fq;
#pragma unroll
            for (int ai = 0; ai < 2; ++ai)
#pragma unroll
                for (int m = 0; m < 4; ++m) { const float r_ = RS_(ai, m); const int row = row0 + ai * HALF + m * 16;
#pragma unroll
                    for (int bj = 0; bj < 2; ++bj) { const f32x4 v0 = acc[ai][bj][m][0] * r_, v1 = acc[ai][bj][m][1] * r_;
                        int e0 = __builtin_amdgcn_cvt_pk_fp8_f32(v0[0], v0[1], 0, false); e0 = __builtin_amdgcn_cvt_pk_fp8_f32(v0[2], v0[3], e0, true);
                        int e1 = __builtin_amdgcn_cvt_pk_fp8_f32(v1[0], v1[1], 0, false); e1 = __builtin_amdgcn_cvt_pk_fp8_f32(v1[2], v1[3], e1, true);
                        unsigned char* dp = vt8 + (size_t)(c0 + bj * HALF) * vt_pitch + row;
                        dp[0] = (unsigned char)e0; dp[vt_pitch] = (unsigned char)(e0 >> 8); dp[2 * (size_t)vt_pitch] = (unsigned char)(e0 >> 16); dp[3 * (size_t)vt_pitch] = (unsigned char)((unsigned)e0 >> 24);
                        dp[4 * (size_t)vt_pitch] = (unsigned char)e1; dp[5 * (size_t)vt_pitch] = (unsigned char)(e1 >> 8); dp[6 * (size_t)vt_pitch] = (unsigned char)(e1 >> 16); dp[7 * (size_t)vt_pitch] = (unsigned char)((unsigned)e1 >> 24); } }
        } else if (u.pn >= 10) {
#pragma unroll
            for (int ai = 0; ai < 2; ++ai)
#pragma unroll
                for (int m = 0; m < 4; ++m) {
                    bf16_t* rowp = Z + (size_t)(row0 + ai * HALF + m * 16) * ldz + col0;
                    const float r_ = RS_(ai, m);
#pragma unroll
                    for (int bj = 0; bj < 2; ++bj) { const f32x4 v0 = acc[ai][bj][m][0] * r_, v1 = acc[ai][bj][m][1] * r_;
                        u32x4 w; w.x = cvt_pk_bf16(v0[0], v0[1]); w.y = cvt_pk_bf16(v0[2], v0[3]); w.z = cvt_pk_bf16(v1[0], v1[1]); w.w = cvt_pk_bf16(v1[2], v1[3]);
                        ST_Z((u32x4*)(rowp + bj * HALF), w); }
                }
        } else {
#pragma unroll
            for (int ai = 0; ai < 2; ++ai)
#pragma unroll
                for (int m = 0; m < 4; ++m) { const float r_ = RS_(ai, m);
#pragma unroll
                    for (int bj = 0; bj < 2; ++bj) { const f32x4 a = acc[ai][bj][m][0] * r_, b = acc[ai][bj][m][1] * r_;
                        float ss = ((a[0] * a[0] + a[1] * a[1]) + (a[2] * a[2] + a[3] * a[3])) + ((b[0] * b[0] + b[1] * b[1]) + (b[2] * b[2] + b[3] * b[3]));
                        ss += __shfl_xor(ss, 16); ss += __shfl_xor(ss, 32);
                        if (fq == 0) P[(ai * HALF + wr * 64 + m * 16 + fr) * 8 + bj * 4 + wc] = ss; } }
            asm volatile("s_waitcnt lgkmcnt(0)" ::: "memory"); __builtin_amdgcn_s_barrier(); asm volatile("" ::: "memory");
            const int hf = wc >> 1, i0 = (16 * wc + 4 * fq) & 31;
            const float* wn = (u.pn < 8 ? qn : kn) + 64 * hf + i0;
            const float qsc = u.pn < 8 ? qscale : 1.0f;
            const f32x4 w1 = *(const f32x4*)wn * qsc, w2 = *(const f32x4*)(wn + 32) * qsc;
            unsigned char* dst0 = u.pn < 8 ? q8 + col0 : k8 + (col0 - 2048);
            const int dpitch = u.pn < 8 ? 2048 : 512;
#pragma unroll
            for (int ai = 0; ai < 2; ++ai)
#pragma unroll
                for (int m = 0; m < 4; ++m) {
                    const int row = row0 + ai * HALF + m * 16, pos = hf ? (row & 63) : (row >> 6); const float r_ = RS_(ai, m);
                    const f32x4 cs0 = *(const f32x4*)(rope + (size_t)(pos * 32 + i0) * 2), cs1 = *(const f32x4*)(rope + (size_t)(pos * 32 + i0) * 2 + 4);
#pragma unroll
                    for (int bj = 0; bj < 2; ++bj) {
                        const f32x4 pp = *(const PG8_LAS f32x4*)(P + (ai * HALF + wr * 64 + m * 16 + fr) * 8 + bj * 4);
                        const float hr = r_ / sqrtf(((pp[0] + pp[1]) + (pp[2] + pp[3])) * (1.0f / 128.0f) + 1e-6f);
                        const f32x4 x1 = acc[ai][bj][m][0] * hr * w1, x2 = acc[ai][bj][m][1] * hr * w2;
                        const float a0 = x1[0] * cs0[0] - x2[0] * cs0[1], b0 = x2[0] * cs0[0] + x1[0] * cs0[1];
                        const float a1 = x1[1] * cs0[2] - x2[1] * cs0[3], b1 = x2[1] * cs0[2] + x1[1] * cs0[3];
                        const float a2 = x1[2] * cs1[0] - x2[2] * cs1[1], b2 = x2[2] * cs1[0] + x1[2] * cs1[1];
                        const float a3 = x1[3] * cs1[2] - x2[3] * cs1[3], b3 = x2[3] * cs1[2] + x1[3] * cs1[3];
                        int w0 = __builtin_amdgcn_cvt_pk_fp8_f32(a0, a1, 0, false); w0 = __builtin_amdgcn_cvt_pk_fp8_f32(a2, a3, w0, true);
                        int w1_ = __builtin_amdgcn_cvt_pk_fp8_f32(b0, b1, 0, false); w1_ = __builtin_amdgcn_cvt_pk_fp8_f32(b2, b3, w1_, true);
                        typedef int i32x2v __attribute__((ext_vector_type(2))); *(i32x2v*)(dst0 + (size_t)row * dpitch + bj * HALF) = (i32x2v){w0, w1_}; }
                }
        }
#undef RS_
    }
};
typedef _Float16 h16x2 __attribute__((ext_vector_type(2)));
__device__ __forceinline__ unsigned pk_h2(float a, float b) { const h16x2 h = {(_Float16)a, (_Float16)b}; return __builtin_bit_cast(unsigned, h); }
__device__ __forceinline__ float h_lo(unsigned u) { return (float)__builtin_bit_cast(h16x2, u)[0]; }
__device__ __forceinline__ float h_hi(unsigned u) { return (float)__builtin_bit_cast(h16x2, u)[1]; }
template <bool OLDB, bool NEWF>
struct EpiOutT {
    static constexpr bool PERM = true, AFTER_DRAIN = false;
    const float* Xold; float* Xnew; bf16_t* XB  ; float* part  ; unsigned char* xb8; unsigned short* XH;
    __device__ __forceinline__ void operator()(const f32x4 (&acc)[2][2][4][2], const Unit& u, int wr, int wc, int fr, int fq) const {
        const int row0 = u.pm * BM + wr * 64 + fr, col0 = u.pn * BM + wc * 32 + 8 * fq;
        f32x4 xs[2][2][2][2];
#define EO_LD(slot, g) do { _Pragma("unroll") for (int mi = 0; mi < 2; ++mi) _Pragma("unroll") for (int bj = 0; bj < 2; ++bj) { \
            const size_t off = (size_t)(row0 + ((g) >> 1) * HALF + (((g) & 1) * 2 + mi) * 16) * 4096 + col0 + bj * HALF; \
            if (OLDB) { const u32x4 t_ = *(const u32x4*)(XH + off); \
                xs[slot][mi][bj][0] = f32x4{h_lo(t_.x), h_hi(t_.x), h_lo(t_.y), h_hi(t_.y)}; \
                xs[slot][mi][bj][1] = f32x4{h_lo(t_.z), h_hi(t_.z), h_lo(t_.w), h_hi(t_.w)}; } \
            else { xs[slot][mi][bj][0] = *(const f32x4*)(Xold + off); xs[slot][mi][bj][1] = *(const f32x4*)(Xold + off + 4); } } } while (0)
#define EO_PR(slot, g) do { _Pragma("unroll") for (int mi = 0; mi < 2; ++mi) { const int ai = (g) >> 1, m = ((g) & 1) * 2 + mi; const int row = row0 + ai * HALF + m * 16; float ss = 0.f; \
            _Pragma("unroll") for (int bj = 0; bj < 2; ++bj) { const size_t off = (size_t)row * 4096 + col0 + bj * HALF; \
                const f32x4 x0 = xs[slot][mi][bj][0] + acc[ai][bj][m][0], x1 = xs[slot][mi][bj][1] + acc[ai][bj][m][1]; \
                if (NEWF) { ST_X((f32x4*)(Xnew + off), x0); ST_X((f32x4*)(Xnew + off + 4), x1); } \
                else { u32x4 hh; hh.x = pk_h2(x0[0], x0[1]); hh.y = pk_h2(x0[2], x0[3]); hh.z = pk_h2(x1[0], x1[1]); hh.w = pk_h2(x1[2], x1[3]); *(u32x4*)(XH + off) = hh; } \
                u32x4 w; w.x = cvt_pk_bf16(x0[0], x0[1]); w.y = cvt_pk_bf16(x0[2], x0[3]); w.z = cvt_pk_bf16(x1[0], x1[1]); w.w = cvt_pk_bf16(x1[2], x1[3]); \
                if (XB) *(u32x4*)(XB + off) = w; \
                if (xb8) { int e0 = __builtin_amdgcn_cvt_pk_fp8_f32(x0[0], x0[1], 0, false); e0 = __builtin_amdgcn_cvt_pk_fp8_f32(x0[2], x0[3], e0, true); int e1 = __builtin_amdgcn_cvt_pk_fp8_f32(x1[0], x1[1], 0, false); e1 = __builtin_amdgcn_cvt_pk_fp8_f32(x1[2], x1[3], e1, true); \
                    typedef int i32x2e __attribute__((ext_vector_type(2))); *(i32x2e*)(xb8 + off) = (i32x2e){e0, e1}; } \
                ss += ((x0[0] * x0[0] + x0[1] * x0[1]) + (x0[2] * x0[2] + x0[3] * x0[3])) + ((x1[0] * x1[0] + x1[1] * x1[1]) + (x1[2] * x1[2] + x1[3] * x1[3])); } \
            ss += __shfl_xor(ss, 16); ss += __shfl_xor(ss, 32); \
            if (part && fq == 0) part[(size_t)row * 64 + u.pn * 4 + wc] = ss; } } while (0)
        EO_LD(0, 0); EO_LD(1, 1); asm volatile("" ::: "memory");
        EO_PR(0, 0); asm volatile("" ::: "memory"); EO_LD(0, 2); asm volatile("" ::: "memory");
        EO_PR(1, 1); asm volatile("" ::: "memory"); EO_LD(1, 3); asm volatile("" ::: "memory");
        EO_PR(0, 2); EO_PR(1, 3);
#undef EO_LD
#undef EO_PR
    }
};
typedef EpiOutT<false, true> EpiOut;

struct EpiLight {
    static constexpr bool PERM = true, AFTER_DRAIN = false;
    bf16_t* O;
    __device__ __forceinline__ void operator()(const f32x4 (&acc)[2][2][4][2], const Unit& u, int wr, int wc, int fr, int fq) const {
        const int row0 = u.pm * BM + wr * 64 + fr, col0 = u.pn * BM + wc * 32 + 8 * fq;
#pragma unroll
        for (int ai = 0; ai < 2; ++ai)
#pragma unroll
            for (int m = 0; m < 4; ++m) { bf16_t* rowp = O + (size_t)(row0 + ai * HALF + m * 16) * 4096 + col0;
#pragma unroll
                for (int bj = 0; bj < 2; ++bj) { const f32x4 v0 = acc[ai][bj][m][0], v1 = acc[ai][bj][m][1];
                    u32x4 w; w.x = cvt_pk_bf16(v0[0], v0[1]); w.y = cvt_pk_bf16(v0[2], v0[3]); w.z = cvt_pk_bf16(v1[0], v1[1]); w.w = cvt_pk_bf16(v1[2], v1[3]);
                    *(u32x4*)(rowp + bj * HALF) = w; } }
    }
};
template <class Epi, class Sched, bool ALIGN_EPI = false, bool SP2 = false, bool F8 = false, int SPLIT8 = 0, bool F16 = false>
__device__ __forceinline__ void gemm_phase(PG8_LAS unsigned char* lds, const Gemm g, const Sched& S, const Epi& E, float split_scale = 1.0f) {
    int tid_ = threadIdx.x; asm volatile("" : "+v"(tid_));
    const int tid = tid_, wid = __builtin_amdgcn_readfirstlane(tid >> 6), lane = tid & 63, wr = wid >> 2, wc = wid & 3, fr = lane & 15, fq = lane >> 4;
    typedef int i32x4_ __attribute__((ext_vector_type(4)));
    typedef _Float16 f16x8_ __attribute__((ext_vector_type(8)));
    const int f8one = 0x7f7f7f7f;
    const int K = g.K, nt = K / BK - SPLIT8;
    unsigned voffA[2], voffB[2];
#pragma unroll
    for (int i = 0; i < 2; ++i) { int R, C; stage_rc(tid * 16 + i * 8192, R, C); const int Rb = Epi::PERM ? ((R & ~31) + perm32(R & 31)) : R;
        voffA[i] = (unsigned)(R * K + C) * 2u; voffB[i] = (unsigned)(Rb * K + C) * 2u; }
    const size_t kstep = (size_t)(BK * 2);
    const size_t hstep = (size_t)HALF * K * 2;
    const size_t tstep = 2 * hstep;
    const unsigned ldsw = (unsigned)wid * 1024u;
    const int aoff = lds_byte(wr * 64 + fr, fq * 8), boff = lds_byte(wc * 32 + fr, fq * 8);
#define PG8_SA(b, h) (((b) * 2 + (h)) * HTB)
#define PG8_SB(b, h) ((4 + (b) * 2 + (h)) * HTB)
#define PG8_STAGE(bufoff, gbase, voff) do { _Pragma("unroll") for (int _i = 0; _i < 2; ++_i) \
        __builtin_amdgcn_global_load_lds((const unsigned*)((const char*)(gbase) + (voff)[_i]), (PG8_LAS unsigned*)(lds + (bufoff) + ldsw + _i * 8192), 16, 0, 0); } while (0)
#define PG8_LDA(dst, b, h) do { _Pragma("unroll") for (int m = 0; m < 4; ++m) _Pragma("unroll") for (int k = 0; k < 2; ++k) dst[m][k] = *(const PG8_LAS bf16x8*)(lds + PG8_SA(b, h) + aoff + m * 2048 + k * 1024); } while (0)
#define PG8_LDB(dst, b, h) do { _Pragma("unroll") for (int n = 0; n < 2; ++n) _Pragma("unroll") for (int k = 0; k < 2; ++k) dst[n][k] = *(const PG8_LAS bf16x8*)(lds + PG8_SB(b, h) + boff + n * 2048 + k * 1024); } while (0)
#define PG8_CAT8(x, y) __builtin_shufflevector(__builtin_bit_cast(i32x4_, x), __builtin_bit_cast(i32x4_, y), 0, 1, 2, 3, 4, 5, 6, 7)
#define PG8_MMA(ai, bj, At, Bt) do { __builtin_amdgcn_s_setprio(1); _Pragma("unroll") for (int m = 0; m < 4; ++m) _Pragma("unroll") for (int n = 0; n < 2; ++n) { \
        if constexpr (f8t) { asm volatile("v_mfma_scale_f32_16x16x128_f8f6f4 %0, %1, %2, %0, %3, %3 op_sel_hi:[0,0,0]" : "+v"(acc[ai][bj][m][n]) : "v"(PG8_CAT8(Bt[n][0], Bt[n][1])), "v"(PG8_CAT8(At[m][0], At[m][1])), "v"(f8one)); } \
        else if constexpr (SPLIT8 > 0) { _Pragma("unroll") for (int k = 0; k < 2; ++k) asm volatile("v_mfma_f32_16x16x32_bf16 %0, %1, %2, %0" : "+v"(acc[ai][bj][m][n]) : "v"(Bt[n][k]), "v"(At[m][k])); } \
        else if constexpr (F16) { _Pragma("unroll") for (int k = 0; k < 2; ++k) acc[ai][bj][m][n] = __builtin_amdgcn_mfma_f32_16x16x32_f16(__builtin_bit_cast(f16x8_, Bt[n][k]), __builtin_bit_cast(f16x8_, At[m][k]), acc[ai][bj][m][n], 0, 0, 0); } \
        else { _Pragma("unroll") for (int k = 0; k < 2; ++k) acc[ai][bj][m][n] = __builtin_amdgcn_mfma_f32_16x16x32_bf16(Bt[n][k], At[m][k], acc[ai][bj][m][n], 0, 0, 0); } } \
        __builtin_amdgcn_s_setprio(0); } while (0)
#define PG8_WAIT_V(n) asm volatile("s_waitcnt vmcnt(" #n ")" ::: "memory")
#define PG8_WAIT_L(n) asm volatile("s_waitcnt lgkmcnt(" #n ")" ::: "memory")
#define PG8_BAR __builtin_amdgcn_s_barrier()
#define PG8_SCHED __builtin_amdgcn_sched_barrier(0)
#define PG8_KBODY(F8T) do { constexpr bool f8t = (F8T); (void)f8t; \
            const bool last = (t == nt - 2); \
            const size_t k1 = (size_t)((t + 1 < SPLIT8 || SPLIT8 == 0) ? t + 1 : t + 1 + SPLIT8) * kstep, k2 = (size_t)((t + 2 < SPLIT8 || SPLIT8 == 0) ? t + 2 : t + 2 + SPLIT8) * kstep; \
            const char* a1 = cA + k1; \
            const char* a2 = last ? nA : cA + k2; const char* b2 = last ? nB : cB + k2; \
            const char* a3 = a2 + kstep; const char* b3 = b2 + kstep; \
            if (last && has_next) S.a_ready(nxt); \
            if constexpr (SP2) { \
            PG8_LDB(B0, 0, 0); PG8_LDB(B1, 0, 1); PG8_SCHED; PG8_LDA(At, 0, 0); PG8_STAGE(PG8_SA(1, 1), a1 + hstep, voffA); \
            PG8_WAIT_V(8); PG8_WAIT_L(0); PG8_BAR; PG8_MMA(0, 0, At, B0); PG8_MMA(0, 1, At, B1); PG8_BAR; PG8_SCHED; \
            PG8_LDA(At, 0, 1); PG8_STAGE(PG8_SB(0, 0), b2, voffB); PG8_STAGE(PG8_SB(0, 1), b2 + hstep, voffB); PG8_STAGE(PG8_SA(0, 0), a2, voffA); \
            PG8_WAIT_V(8); PG8_WAIT_L(0); PG8_BAR; PG8_MMA(1, 0, At, B0); PG8_MMA(1, 1, At, B1); PG8_BAR; PG8_SCHED; \
            PG8_LDB(B0, 1, 0); PG8_LDB(B1, 1, 1); PG8_SCHED; PG8_LDA(At, 1, 0); PG8_STAGE(PG8_SA(0, 1), a2 + hstep, voffA); \
            PG8_WAIT_V(8); PG8_WAIT_L(0); PG8_BAR; PG8_MMA(0, 0, At, B0); PG8_MMA(0, 1, At, B1); PG8_BAR; PG8_SCHED; \
            PG8_LDA(At, 1, 1); PG8_STAGE(PG8_SB(1, 0), b3, voffB); PG8_STAGE(PG8_SB(1, 1), b3 + hstep, voffB); PG8_STAGE(PG8_SA(1, 0), a3, voffA); \
            PG8_WAIT_V(8); PG8_WAIT_L(0); PG8_BAR; PG8_MMA(1, 0, At, B0); PG8_MMA(1, 1, At, B1); PG8_BAR; PG8_SCHED; \
            } else { \
            PG8_LDB(B0, 0, 0); PG8_SCHED; PG8_LDA(At, 0, 0); PG8_STAGE(PG8_SA(1, 1), a1 + hstep, voffA); \
            PG8_WAIT_L(8); PG8_BAR; PG8_WAIT_L(0); PG8_MMA(0, 0, At, B0); PG8_BAR; PG8_SCHED; \
            PG8_LDB(B1, 0, 1); PG8_STAGE(PG8_SB(0, 0), b2, voffB); \
            PG8_BAR; PG8_WAIT_L(0); PG8_MMA(0, 1, At, B1); PG8_BAR; \
            PG8_LDA(At, 0, 1); PG8_STAGE(PG8_SA(0, 0), a2, voffA); \
            PG8_BAR; PG8_WAIT_L(0); PG8_MMA(1, 0, At, B0); PG8_BAR; PG8_SCHED; \
            PG8_STAGE(PG8_SB(0, 1), b2 + hstep, voffB); \
            PG8_WAIT_V(6); PG8_BAR; PG8_MMA(1, 1, At, B1); PG8_BAR; \
            PG8_LDB(B0, 1, 0); PG8_SCHED; PG8_LDA(At, 1, 0); PG8_STAGE(PG8_SA(0, 1), a2 + hstep, voffA); \
            PG8_WAIT_L(8); PG8_BAR; PG8_WAIT_L(0); PG8_MMA(0, 0, At, B0); PG8_BAR; PG8_SCHED; \
            PG8_LDB(B1, 1, 1); PG8_STAGE(PG8_SB(1, 0), b3, voffB); \
            PG8_BAR; PG8_WAIT_L(0); PG8_MMA(0, 1, At, B1); PG8_BAR; \
            PG8_LDA(At, 1, 1); PG8_STAGE(PG8_SA(1, 0), a3, voffA); \
            PG8_BAR; PG8_WAIT_L(0); PG8_MMA(1, 0, At, B0); PG8_BAR; PG8_SCHED; \
            PG8_STAGE(PG8_SB(1, 1), b3 + hstep, voffB); \
            PG8_WAIT_V(6); PG8_BAR; PG8_MMA(1, 1, At, B1); PG8_BAR; \
            } \
        } while (0)
    Unit cur, nxt; int ui = 0;
    if (!S.next(0, cur)) return;
    f32x4 acc[2][2][4][2];
#pragma unroll
    for (int a = 0; a < 2; ++a)
#pragma unroll
        for (int b = 0; b < 2; ++b)
#pragma unroll
            for (int m = 0; m < 4; ++m)
#pragma unroll
                for (int n = 0; n < 2; ++n) acc[a][b][m][n] = (f32x4){0.f, 0.f, 0.f, 0.f};
    bf16x8 At[4][2], B0[2][2], B1[2][2];
    const char* cA = (const char*)g.A + (size_t)cur.pm * tstep; const char* cB = (const char*)g.Bt + (size_t)cur.pn * tstep;
    S.a_ready(cur);
    if constexpr (SP2) {
        PG8_STAGE(PG8_SB(0, 0), cB, voffB); PG8_STAGE(PG8_SB(0, 1), cB + hstep, voffB); PG8_STAGE(PG8_SA(0, 0), cA, voffA); PG8_STAGE(PG8_SA(0, 1), cA + hstep, voffA);
        if (wr == 1) PG8_BAR;
        PG8_WAIT_V(2); PG8_BAR;
        PG8_STAGE(PG8_SB(1, 0), cB + kstep, voffB); PG8_STAGE(PG8_SA(1, 0), cA + kstep, voffA); PG8_STAGE(PG8_SB(1, 1), cB + hstep + kstep, voffB);
        PG8_WAIT_V(6); PG8_BAR;
    } else {
        PG8_STAGE(PG8_SB(0, 0), cB, voffB); PG8_STAGE(PG8_SA(0, 0), cA, voffA); PG8_STAGE(PG8_SB(0, 1), cB + hstep, voffB); PG8_STAGE(PG8_SA(0, 1), cA + hstep, voffA);
        if (wr == 1) PG8_BAR;
        PG8_WAIT_V(4); PG8_BAR;
        PG8_STAGE(PG8_SB(1, 0), cB + kstep, voffB); PG8_STAGE(PG8_SA(1, 0), cA + kstep, voffA); PG8_STAGE(PG8_SB(1, 1), cB + hstep + kstep, voffB);
        PG8_WAIT_V(6); PG8_BAR;
    }
    for (;;) {
        const bool has_next = S.next(ui + 1, nxt);
        const char* nA = has_next ? (const char*)g.A + (size_t)nxt.pm * tstep : cA; const char* nB = has_next ? (const char*)g.Bt + (size_t)nxt.pn * tstep : cB;
        if constexpr (SPLIT8 > 0) {
            for (int t = 0; t < SPLIT8; t += 2) PG8_KBODY(true);
#pragma unroll
            for (int a = 0; a < 2; ++a)
#pragma unroll
                for (int b = 0; b < 2; ++b)
#pragma unroll
                    for (int m = 0; m < 4; ++m)
#pragma unroll
                        for (int n = 0; n < 2; ++n) acc[a][b][m][n] *= split_scale;
            for (int t = SPLIT8; t < nt; t += 2) PG8_KBODY(false);
        } else {
            for (int t = 0; t < nt; t += 2) PG8_KBODY(F8);
        }
        if constexpr (F8 || SPLIT8 > 0) asm volatile("s_nop 15\n\ts_nop 15" ::: "memory");
        if constexpr (ALIGN_EPI) { if (wr == 0) PG8_BAR; }
        if constexpr (!Epi::AFTER_DRAIN) { E(acc, cur, wr, wc, fr, fq); S.done(cur); }
        if (!has_next) break;
#pragma unroll
        for (int a = 0; a < 2; ++a)
#pragma unroll
            for (int b = 0; b < 2; ++b)
#pragma unroll
                for (int m = 0; m < 4; ++m)
#pragma unroll
                    for (int n = 0; n < 2; ++n) acc[a][b][m][n] = (f32x4){0.f, 0.f, 0.f, 0.f};
        cur = nxt; cA = nA; cB = nB; ++ui;
        if constexpr (ALIGN_EPI) { if (wr == 1) PG8_BAR; }
    }
    PG8_WAIT_V(0);
    if constexpr (!ALIGN_EPI) { if (wr == 0) PG8_BAR; }
    PG8_BAR;
    if constexpr (Epi::AFTER_DRAIN) { E.fused(acc, cur, wr, wc, fr, fq, lds, wid, lane); S.done(cur); }
#undef PG8_SA
#undef PG8_SB
#undef PG8_STAGE
#undef PG8_LDA
#undef PG8_LDB
#undef PG8_MMA
#undef PG8_KBODY
#undef PG8_CAT8
#undef PG8_WAIT_V
#undef PG8_WAIT_L
#undef PG8_BAR
#undef PG8_SCHED
}
}
namespace att {
using bf16 = unsigned short;
constexpr int D = 128, NW = 8, QBLK = 32, KVBLK = 64;
constexpr float SCALE = 0.088388347648318440f;
constexpr float THR = 8.f;
using f32x4 = __attribute__((ext_vector_type(4))) float;
using bf16x8 = __attribute__((ext_vector_type(8))) short;
using s16x4  = __attribute__((ext_vector_type(4))) short;
using f32x16 = __attribute__((ext_vector_type(16))) float;
using f32x8  = __attribute__((ext_vector_type(8))) float;
using u32x4  = __attribute__((ext_vector_type(4))) unsigned;
#define KSWZ(row, colB) ((row) * 256 + ((colB) ^ (((row) & 15) << 4)))
#define SBAR() __builtin_amdgcn_sched_barrier(0)
__device__ __forceinline__ int crow(int r, int hi) { return (r & 3) + 8 * (r >> 2) + 4 * hi; }
__device__ __forceinline__ unsigned cvtpk(float lo, float hi) {
  unsigned r; asm volatile("v_cvt_pk_bf16_f32 %0, %1, %2" : "=v"(r) : "v"(lo), "v"(hi)); return r;
}
__device__ __forceinline__ void partialSM(f32x16& p0, f32x16& p1, float& m_reg, float& mn, float& alpha) {
  constexpr float C = SCALE * 1.4426950408889634f;
  float pmax = p0[0]; _Pragma("unroll") for (int r = 1; r < 16; ++r) pmax = fmaxf(pmax, p0[r]); _Pragma("unroll") for (int r = 0; r < 16; ++r) pmax = fmaxf(pmax, p1[r]);
  { auto rr = __builtin_amdgcn_permlane32_swap(__float_as_uint(pmax), __float_as_uint(pmax), false, false);
    pmax = fmaxf(__uint_as_float(rr[0]), __uint_as_float(rr[1])); }
  if (__builtin_expect(__all(pmax - m_reg <= THR / SCALE), 1)) { mn = m_reg; alpha = 1.f; }
  else { mn = fmaxf(m_reg, pmax); alpha = __builtin_amdgcn_exp2f((m_reg - mn) * C); m_reg = mn; }
  float mnC = -mn * C;
  _Pragma("unroll") for (int r = 0; r < 16; ++r) p0[r] = fmaf(p0[r], C, mnC); _Pragma("unroll") for (int r = 0; r < 16; ++r) p1[r] = fmaf(p1[r], C, mnC);
  _Pragma("unroll") for (int r = 0; r < 16; ++r) p0[r] = __builtin_amdgcn_exp2f(p0[r]);
}
__device__ __forceinline__ void finishSM(f32x16& p0, f32x16& p1, float alpha, float& l_reg, bf16x8& pa0, bf16x8& pa1, bf16x8& pa2, bf16x8& pa3) {
  _Pragma("unroll") for (int r = 0; r < 16; ++r) p1[r] = __builtin_amdgcn_exp2f(p1[r]);
  float ps = 0; _Pragma("unroll") for (int r = 0; r < 16; ++r) ps += p0[r]; _Pragma("unroll") for (int r = 0; r < 16; ++r) ps += p1[r];
  { auto rr = __builtin_amdgcn_permlane32_swap(__float_as_uint(ps), __float_as_uint(ps), false, false);
    ps = __uint_as_float(rr[0]) + __uint_as_float(rr[1]); }
  l_reg = l_reg * alpha + ps;
#define PK4(P, BASE, OUT) do { unsigned a0 = cvtpk(P[BASE + 0], P[BASE + 1]), a1 = cvtpk(P[BASE + 2], P[BASE + 3]);   \
    unsigned b0 = cvtpk(P[BASE + 4], P[BASE + 5]), b1 = cvtpk(P[BASE + 6], P[BASE + 7]);                              \
    auto r0 = __builtin_amdgcn_permlane32_swap(a0, b0, false, false); auto r1 = __builtin_amdgcn_permlane32_swap(a1, b1, false, false); \
    u32x4 w = {r0[0], r1[0], r0[1], r1[1]}; OUT = *reinterpret_cast<bf16x8*>(&w); } while (0)
  PK4(p0, 0, pa0); PK4(p0, 8, pa1); PK4(p1, 0, pa2); PK4(p1, 8, pa3);
#undef PK4
}
__device__ __forceinline__ void qkt(f32x16& p0, f32x16& p1, const bf16* Ks, const bf16x8* qr, int r32, int hi) {
  p0 = f32x16{}; p1 = f32x16{};
  _Pragma("unroll") for (int d0 = 0; d0 < 8; ++d0) { int cb = (d0 * 16 + hi * 8) * 2;
    bf16x8 b0 = *reinterpret_cast<const bf16x8*>((const char*)Ks + KSWZ(r32, cb));
    bf16x8 b1 = *reinterpret_cast<const bf16x8*>((const char*)Ks + KSWZ(32 + r32, cb));
    p0 = __builtin_amdgcn_mfma_f32_32x32x16_bf16(b0, qr[d0], p0, 0, 0, 0);
    p1 = __builtin_amdgcn_mfma_f32_32x32x16_bf16(b1, qr[d0], p1, 0, 0, 0); }
}
__device__ __forceinline__ int v_st(int k, int c) { const int kk = (k & ~0xC) | ((k & 4) << 1) | ((k & 8) >> 1); return ((kk >> 3) * 4 + (c >> 5)) * 512 + ((kk & 7) * 32 + (c & 31)) * 2; }
__device__ __forceinline__ int v_rd_base(int lane) { return ((lane & 3) << 3) | (((lane >> 2) & 3) << 6) | (((lane >> 4) & 1) << 5) | (((lane >> 5) & 1) << 8); }
constexpr int v_rd_off(int d0, int ks, int half) { return d0 * 512 + ks * 4096 + half * 2048; }
template <int OFF> __device__ __forceinline__ s16x4 tr_read(int vb) {
  s16x4 r; asm volatile("ds_read_b64_tr_b16 %0, %1 offset:%2" : "=&v"(r) : "v"(vb), "i"(OFF) : "memory"); return r;
}
template <int D0> __device__ __forceinline__ void pv_one(f32x16& od, int vb, bf16x8 pa0, bf16x8 pa1, bf16x8 pa2, bf16x8 pa3) {
  const s16x4 l0 = tr_read<v_rd_off(D0, 0, 0)>(vb), h0 = tr_read<v_rd_off(D0, 0, 1)>(vb), l1 = tr_read<v_rd_off(D0, 1, 0)>(vb), h1 = tr_read<v_rd_off(D0, 1, 1)>(vb);
  const s16x4 l2 = tr_read<v_rd_off(D0, 2, 0)>(vb), h2 = tr_read<v_rd_off(D0, 2, 1)>(vb), l3 = tr_read<v_rd_off(D0, 3, 0)>(vb), h3 = tr_read<v_rd_off(D0, 3, 1)>(vb);
  asm volatile("s_waitcnt lgkmcnt(0)" ::: "memory"); SBAR();
#define PK(L, H) (bf16x8){L[0], L[1], L[2], L[3], H[0], H[1], H[2], H[3]}
  od = __builtin_amdgcn_mfma_f32_32x32x16_bf16(pa0, PK(l0, h0), od, 0, 0, 0);
  od = __builtin_amdgcn_mfma_f32_32x32x16_bf16(pa1, PK(l1, h1), od, 0, 0, 0);
  od = __builtin_amdgcn_mfma_f32_32x32x16_bf16(pa2, PK(l2, h2), od, 0, 0, 0);
  od = __builtin_amdgcn_mfma_f32_32x32x16_bf16(pa3, PK(l3, h3), od, 0, 0, 0);
#undef PK
}
__device__ __forceinline__ void pv_d0(f32x16* o, int vb, bf16x8 pa0, bf16x8 pa1, bf16x8 pa2, bf16x8 pa3) {
  pv_one<0>(o[0], vb, pa0, pa1, pa2, pa3); pv_one<1>(o[1], vb, pa0, pa1, pa2, pa3); pv_one<2>(o[2], vb, pa0, pa1, pa2, pa3); pv_one<3>(o[3], vb, pa0, pa1, pa2, pa3);
}
#define LAS3 __attribute__((address_space(3)))
typedef short v4i16_t __attribute__((ext_vector_type(4)));
__device__ __forceinline__ s16x4 vtr(const LAS3 char* p) { return __builtin_bit_cast(s16x4, __builtin_amdgcn_ds_read_tr16_b64_v4i16((LAS3 v4i16_t*)p)); }
__device__ __forceinline__ void partialSM_bf(f32x16& p0, f32x16& p1, float& m_reg, float& mn, float& alpha) {
  constexpr float C = SCALE * 1.4426950408889634f;
  float pmax = p0[0];
  _Pragma("unroll") for (int r = 1; r < 16; ++r) pmax = fmaxf(pmax, p0[r]);
  _Pragma("unroll") for (int r = 0; r < 16; ++r) pmax = fmaxf(pmax, p1[r]);
  { auto rr = __builtin_amdgcn_permlane32_swap(__float_as_uint(pmax), __float_as_uint(pmax), false, false);
    pmax = fmaxf(__uint_as_float(rr[0]), __uint_as_float(rr[1])); }
  const bool keep = __all(pmax - m_reg <= THR / SCALE);
  mn = keep ? m_reg : fmaxf(m_reg, pmax); alpha = __builtin_amdgcn_exp2f((m_reg - mn) * C); m_reg = mn;
  const float mnC = -mn * C;
  _Pragma("unroll") for (int r = 0; r < 16; ++r) p0[r] = fmaf(p0[r], C, mnC);
  _Pragma("unroll") for (int r = 0; r < 16; ++r) p1[r] = fmaf(p1[r], C, mnC);
  _Pragma("unroll") for (int r = 0; r < 16; ++r) p0[r] = __builtin_amdgcn_exp2f(p0[r]);
}
__device__ __forceinline__ void pv_all(f32x16* o, const LAS3 char* vp, bf16x8 pa0, bf16x8 pa1, bf16x8 pa2, bf16x8 pa3) {
#define PKV(L, H) (bf16x8){L[0], L[1], L[2], L[3], H[0], H[1], H[2], H[3]}
  _Pragma("unroll") for (int d0 = 0; d0 < 4; ++d0) {
    const s16x4 l0 = vtr(vp + v_rd_off(d0, 0, 0)), h0 = vtr(vp + v_rd_off(d0, 0, 1)), l1 = vtr(vp + v_rd_off(d0, 1, 0)), h1 = vtr(vp + v_rd_off(d0, 1, 1));
    const s16x4 l2 = vtr(vp + v_rd_off(d0, 2, 0)), h2 = vtr(vp + v_rd_off(d0, 2, 1)), l3 = vtr(vp + v_rd_off(d0, 3, 0)), h3 = vtr(vp + v_rd_off(d0, 3, 1));
    o[d0] = __builtin_amdgcn_mfma_f32_32x32x16_bf16(pa0, PKV(l0, h0), o[d0], 0, 0, 0);
    o[d0] = __builtin_amdgcn_mfma_f32_32x32x16_bf16(pa1, PKV(l1, h1), o[d0], 0, 0, 0);
    o[d0] = __builtin_amdgcn_mfma_f32_32x32x16_bf16(pa2, PKV(l2, h2), o[d0], 0, 0, 0);
    o[d0] = __builtin_amdgcn_mfma_f32_32x32x16_bf16(pa3, PKV(l3, h3), o[d0], 0, 0, 0); }
#undef PKV
}
#ifndef SGB_VALU_A
#define SGB_VALU_A 4
#endif
#ifndef SGB_VALU_B
#define SGB_VALU_B 4
#endif
#define PIN_A() asm volatile("" : "+v"(pa0), "+v"(pa1), "+v"(pa2), "+v"(pa3), "+v"(l_reg))
#define PIN_B(P0, P1, AL) asm volatile("" : "+v"(P0), "+v"(P1), "+v"(AL), "+v"(m_reg))
#define SGB_A() do { __builtin_amdgcn_sched_group_barrier(0x100, 2, 0); _Pragma("unroll") for (int i_ = 0; i_ < 16; ++i_) { __builtin_amdgcn_sched_group_barrier(0x008, 1, 0); \
    __builtin_amdgcn_sched_group_barrier(0x100, 1, 0); __builtin_amdgcn_sched_group_barrier(0x400, 1, 0); __builtin_amdgcn_sched_group_barrier(0x002, SGB_VALU_A, 0); } } while (0)
#define SGB_B() do { __builtin_amdgcn_sched_group_barrier(0x100, 2, 0); _Pragma("unroll") for (int i_ = 0; i_ < 16; ++i_) { __builtin_amdgcn_sched_group_barrier(0x008, 1, 0); \
    __builtin_amdgcn_sched_group_barrier(0x100, 2, 0); __builtin_amdgcn_sched_group_barrier(0x002, SGB_VALU_B, 0); __builtin_amdgcn_sched_group_barrier(0x400, 1, 0); } } while (0)
constexpr int DMODEL = 4096;
constexpr size_t SHM_V = 64 * 128 * 2, SHM_K = 64 * 128 * 2;
constexpr int ATT_WS_OFF = 2 * SHM_V + 2 * SHM_K, ATT_TAB_OFF = ATT_WS_OFF + 8 * 256, ATT_OST_OFF = ATT_TAB_OFF + 704 * 4 + 256  , ATT_LDS_BYTES = ATT_OST_OFF + 8 * 8192;
constexpr float LOG2E = 1.4426950408889634f;
constexpr float Y8_SCALE = 64.0f;
__device__ __forceinline__ float bf2f(bf16 v) { return __uint_as_float((unsigned)v << 16); }
__device__ __forceinline__ bf16 f2bf(float f) { return (bf16)(cvtpk(f, 0.f) & 0xffffu); }
__device__ __forceinline__ float silu_f(float g) { return g * __builtin_amdgcn_rcpf(1.0f + __builtin_amdgcn_exp2f(-g * LOG2E)); }
__device__ __forceinline__ void pack_p(const f32x16& p0, const f32x16& p1, bf16x8& pa0, bf16x8& pa1, bf16x8& pa2, bf16x8& pa3) {
#define PK4(P, BASE, OUT) do { unsigned a0 = cvtpk(P[BASE + 0], P[BASE + 1]), a1 = cvtpk(P[BASE + 2], P[BASE + 3]);   \
    unsigned b0 = cvtpk(P[BASE + 4], P[BASE + 5]), b1 = cvtpk(P[BASE + 6], P[BASE + 7]);                              \
    auto r0 = __builtin_amdgcn_permlane32_swap(a0, b0, false, false); auto r1 = __builtin_amdgcn_permlane32_swap(a1, b1, false, false); \
    u32x4 w = {r0[0], r1[0], r0[1], r1[1]}; OUT = *reinterpret_cast<bf16x8*>(&w); } while (0)
  PK4(p0, 0, pa0); PK4(p0, 8, pa1); PK4(p1, 0, pa2); PK4(p1, 8, pa3);
#undef PK4
}
#ifndef LU_GATE_EARLY
#define LU_GATE_EARLY 0
#endif
struct GateRegs { u32x4 g[2][4]; };
template <int ZP> __device__ __forceinline__ void load_gate(GateRegs& G, const bf16* Gb, int rowb, int lane) {
  const int rr = lane >> 3, c8 = (lane & 7) * 8;
#pragma unroll
  for (int h = 0; h < 2; ++h)
#pragma unroll
    for (int i = 0; i < 4; ++i) G.g[h][i] = *reinterpret_cast<const u32x4*>((const char*)Gb + (unsigned)(((rowb + 8 * i + rr) * ZP + h * 64 + c8) * 2));
}
template <int ZP, bool OUT8 = false, bool PRE = false>
__device__ __forceinline__ void store_gated(const f32x16* o, float l_reg, float* li_l, float* ost, const bf16* Gb, bf16* Yb, int wid, int lane, int r32, int hi, bool li_ready = false, int rowb = -1, const GateRegs* gpre = nullptr) {
  if (rowb < 0) rowb = wid * 32;
  if (!li_ready && hi == 0) li_l[r32] = l_reg;
  const int rr = lane >> 3, c8 = (lane & 7) * 8;
  u32x4 g[2][4];
#pragma unroll
  for (int h = 0; h < 2; ++h)
#pragma unroll
    for (int i = 0; i < 4; ++i) { if (PRE) g[h][i] = gpre->g[h][i]; else g[h][i] = *reinterpret_cast<const u32x4*>((const char*)Gb + (unsigned)(((rowb + 8 * i + rr) * ZP + h * 64 + c8) * 2)); }
#pragma unroll
  for (int h = 0; h < 2; ++h) {
#pragma unroll
    for (int d = 0; d < 2; ++d)
#pragma unroll
      for (int r = 0; r < 16; ++r) ost[crow(r, hi) * 64 + d * 32 + r32] = o[2 * h + d][r];
    asm volatile("s_waitcnt lgkmcnt(0)" ::: "memory");
#pragma unroll
    for (int i = 0; i < 4; ++i) { const int row = 8 * i + rr;
      const f32x4 a = *reinterpret_cast<const f32x4*>(ost + row * 64 + c8), b = *reinterpret_cast<const f32x4*>(ost + row * 64 + c8 + 4);
      const float rl = __builtin_amdgcn_rcpf(li_l[row]); const u32x4 gg = g[h][i];
      u32x4 w;
      w.x = cvtpk(a[0] * rl * silu_f(__uint_as_float(gg.x << 16)), a[1] * rl * silu_f(__uint_as_float(gg.x & 0xffff0000u)));
      w.y = cvtpk(a[2] * rl * silu_f(__uint_as_float(gg.y << 16)), a[3] * rl * silu_f(__uint_as_float(gg.y & 0xffff0000u)));
      w.z = cvtpk(b[0] * rl * silu_f(__uint_as_float(gg.z << 16)), b[1] * rl * silu_f(__uint_as_float(gg.z & 0xffff0000u)));
      w.w = cvtpk(b[2] * rl * silu_f(__uint_as_float(gg.w << 16)), b[3] * rl * silu_f(__uint_as_float(gg.w & 0xffff0000u)));
      if (OUT8) { const float ys = rl * Y8_SCALE;
        int e0 = __builtin_amdgcn_cvt_pk_fp8_f32(a[0] * ys * silu_f(__uint_as_float(gg.x << 16)), a[1] * ys * silu_f(__uint_as_float(gg.x & 0xffff0000u)), 0, false);
        e0 = __builtin_amdgcn_cvt_pk_fp8_f32(a[2] * ys * silu_f(__uint_as_float(gg.y << 16)), a[3] * ys * silu_f(__uint_as_float(gg.y & 0xffff0000u)), e0, true);
        int e1 = __builtin_amdgcn_cvt_pk_fp8_f32(b[0] * ys * silu_f(__uint_as_float(gg.z << 16)), b[1] * ys * silu_f(__uint_as_float(gg.z & 0xffff0000u)), 0, false);
        e1 = __builtin_amdgcn_cvt_pk_fp8_f32(b[2] * ys * silu_f(__uint_as_float(gg.w << 16)), b[3] * ys * silu_f(__uint_as_float(gg.w & 0xffff0000u)), e1, true);
        typedef int i32x2y __attribute__((ext_vector_type(2))); *reinterpret_cast<i32x2y*>((char*)Yb + (unsigned)((rowb + row) * (DMODEL * 2) + h * 64 + c8)) = (i32x2y){e0, e1};
      } else
      *reinterpret_cast<u32x4*>((char*)Yb + (unsigned)(((rowb + row) * DMODEL + h * 64 + c8) * 2)) = w; }
    asm volatile("s_waitcnt lgkmcnt(0)" ::: "memory");
  }
}

template <int ZP>
__device__ __forceinline__ void dense_unit(const bf16* Qb, const bf16* Kh, const bf16* Vh, const bf16* Gb, bf16* Yb, int seq, char* lds) {
  int tid_ = threadIdx.x; asm volatile("" : "+v"(tid_));
  const int tid = tid_, wid = __builtin_amdgcn_readfirstlane(tid >> 6), lane = tid & 63, r32 = lane & 31, hi = lane >> 5;
  bf16* V_lds = (bf16*)lds; bf16* K_lds = (bf16*)(lds + 2 * SHM_V);
  float* ws = (float*)(lds + ATT_WS_OFF) + wid * 64; float* li_l = ws; float* al_l = ws + 32;
  float m_reg = -1e30f, l_reg = 0; f32x16 o[4] = {}; bf16x8 qr[8];
  { const unsigned qoff = (unsigned)((wid * QBLK + r32) * ZP + hi * 8) * 2u;
#pragma unroll
    for (int d0 = 0; d0 < 8; ++d0) qr[d0] = *reinterpret_cast<const bf16x8*>((const char*)Qb + qoff + d0 * 32); }
  const int sr = tid >> 4, sc = (tid & 15) * 8, vst0 = v_st(sr, sc), vst1 = v_st(32 + sr, sc);
  const LAS3 char* vp0 = (const LAS3 char*)V_lds + v_rd_base(lane);
  struct { bf16x8 vs0, vs1, ks0, ks1; } sr_[2];
  const unsigned soff = (unsigned)(sr * ZP + sc) * 2u;
#define SLOAD(i, k0) do { const char* vp_ = (const char*)Vh + (size_t)(k0) * (ZP * 2); const char* kp_ = (const char*)Kh + (size_t)(k0) * (ZP * 2); \
    sr_[i].vs0 = *reinterpret_cast<const bf16x8*>(vp_ + soff); sr_[i].vs1 = *reinterpret_cast<const bf16x8*>(vp_ + 32 * ZP * 2 + soff); \
    sr_[i].ks0 = *reinterpret_cast<const bf16x8*>(kp_ + soff); sr_[i].ks1 = *reinterpret_cast<const bf16x8*>(kp_ + 32 * ZP * 2 + soff); } while (0)
#define SWRITE(b, i) do { *(bf16x8*)((char*)V_lds + (b) * SHM_V + vst0) = sr_[i].vs0;          \
    *(bf16x8*)((char*)V_lds + (b) * SHM_V + vst1) = sr_[i].vs1; int kc = sc * 2;               \
    *(bf16x8*)((char*)K_lds + (b) * SHM_K + KSWZ(sr, kc)) = sr_[i].ks0;                       \
    *(bf16x8*)((char*)K_lds + (b) * SHM_K + KSWZ(32 + sr, kc)) = sr_[i].ks1; } while (0)
#define SWAIT() asm volatile("s_waitcnt vmcnt(4)" ::: "memory")
#define RESC(a) do { if (__any((a) < 1.f)) { if (hi == 0) al_l[r32] = (a); asm volatile("s_waitcnt lgkmcnt(0)" ::: "memory"); \
    _Pragma("unroll") for (int d = 0; d < 4; ++d) _Pragma("unroll") for (int r = 0; r < 16; ++r) o[d][r] *= al_l[crow(r, hi)]; } } while (0)
  f32x16 pA0, pA1, pB0, pB1; float mnA, mnB, alA, alB; bf16x8 pa0, pa1, pa2, pa3; const int NT = seq / KVBLK;
  constexpr int SE = 0, SO = 1;
  SLOAD(SE, 0); asm volatile("s_waitcnt vmcnt(0)" ::: "memory"); SWRITE(0, SE); __syncthreads();
  qkt(pA0, pA1, K_lds, qr, r32, hi); partialSM(pA0, pA1, m_reg, mnA, alA);
  SLOAD(SO, KVBLK); if (2 < NT) SLOAD(SE, 2 * KVBLK);
  SWAIT(); SWRITE(1, SO); __syncthreads();
  for (int j = 1; j + 1 < NT; j += 2) {
    SBAR(); qkt(pB0, pB1, (bf16*)((char*)K_lds + SHM_K), qr, r32, hi);
    finishSM(pA0, pA1, alA, l_reg, pa0, pa1, pa2, pa3); PIN_A(); SGB_A(); SBAR();
    SLOAD(SO, (j + 2) * KVBLK); SBAR();
    pv_all(o, vp0, pa0, pa1, pa2, pa3); partialSM_bf(pB0, pB1, m_reg, mnB, alB); PIN_B(pB0, pB1, alB); SGB_B(); SBAR();
    __syncthreads(); SWAIT(); SWRITE(0, SE);
    RESC(alB); __syncthreads();
    SBAR(); qkt(pA0, pA1, K_lds, qr, r32, hi);
    finishSM(pB0, pB1, alB, l_reg, pa0, pa1, pa2, pa3); PIN_A(); SGB_A(); SBAR();
    if (j + 3 < NT) SLOAD(SE, (j + 3) * KVBLK); SBAR();
    pv_all(o, vp0 + SHM_V, pa0, pa1, pa2, pa3); partialSM_bf(pA0, pA1, m_reg, mnA, alA); PIN_B(pA0, pA1, alA); SGB_B(); SBAR();
    __syncthreads(); SWAIT(); SWRITE(1, SO);
    RESC(alA); __syncthreads();
  }
  SBAR(); qkt(pB0, pB1, (bf16*)((char*)K_lds + SHM_K), qr, r32, hi);
  finishSM(pA0, pA1, alA, l_reg, pa0, pa1, pa2, pa3); SBAR();
  pv_all(o, vp0, pa0, pa1, pa2, pa3); partialSM(pB0, pB1, m_reg, mnB, alB);
  __syncthreads(); RESC(alB);
  finishSM(pB0, pB1, alB, l_reg, pa0, pa1, pa2, pa3); SBAR();
  pv_all(o, vp0 + SHM_V, pa0, pa1, pa2, pa3);
  store_gated<ZP>(o, l_reg, li_l, (float*)(lds + ATT_OST_OFF) + wid * 2048, Gb, Yb, wid, lane, r32, hi);
#undef SLOAD
#undef SWRITE
#undef SWAIT
}

template <bool SHIFT> __device__ __forceinline__ void fsSM1(f32x16& p0, float& ps, float nm) {
  _Pragma("unroll") for (int r = 0; r < 16; ++r) p0[r] = __builtin_amdgcn_exp2f(SHIFT ? p0[r] + nm : p0[r]);
  float s = p0[0];
  _Pragma("unroll") for (int r = 1; r < 16; ++r) s += p0[r];
  ps = s;
}
template <bool SHIFT> __device__ __forceinline__ void fsSM2(f32x16& p0, f32x16& p1, float ps, float nm, float& l_reg, bf16x8& pa0, bf16x8& pa1, bf16x8& pa2, bf16x8& pa3) {
  _Pragma("unroll") for (int r = 0; r < 16; ++r) p1[r] = __builtin_amdgcn_exp2f(SHIFT ? p1[r] + nm : p1[r]);
  _Pragma("unroll") for (int r = 0; r < 16; ++r) ps += p1[r];
  { auto rr = __builtin_amdgcn_permlane32_swap(__float_as_uint(ps), __float_as_uint(ps), false, false);
    ps = __uint_as_float(rr[0]) + __uint_as_float(rr[1]); }
  l_reg += ps;
  pack_p(p0, p1, pa0, pa1, pa2, pa3);
}
#define SGB_FA() do { __builtin_amdgcn_sched_group_barrier(0x100, 2, 0); _Pragma("unroll") for (int i_ = 0; i_ < 16; ++i_) { __builtin_amdgcn_sched_group_barrier(0x008, 1, 0); \
    __builtin_amdgcn_sched_group_barrier(0x100, 1, 0); __builtin_amdgcn_sched_group_barrier(0x400, 1, 0); __builtin_amdgcn_sched_group_barrier(0x002, 4, 0); } } while (0)
#define SGB_FB() do { __builtin_amdgcn_sched_group_barrier(0x100, 2, 0); _Pragma("unroll") for (int i_ = 0; i_ < 16; ++i_) { __builtin_amdgcn_sched_group_barrier(0x008, 1, 0); \
    __builtin_amdgcn_sched_group_barrier(0x100, 2, 0); __builtin_amdgcn_sched_group_barrier(0x400, 1, 0); __builtin_amdgcn_sched_group_barrier(0x002, 1, 0); } } while (0)
template <int ZP, bool SHIFT>
__device__ __forceinline__ void dense_unit_fs(const bf16* Qb, const bf16* Kh, const bf16* Vh, const bf16* Gb, bf16* Yb, int seq, float nm, char* lds) {
  int tid_ = threadIdx.x; asm volatile("" : "+v"(tid_));
  const int tid = tid_, wid = __builtin_amdgcn_readfirstlane(tid >> 6), lane = tid & 63, r32 = lane & 31, hi = lane >> 5;
  bf16* V_lds = (bf16*)lds; bf16* K_lds = (bf16*)(lds + 2 * SHM_V);
  float* ws = (float*)(lds + ATT_WS_OFF) + wid * 64; float* li_l = ws;
  float l_reg = 0; f32x16 o[4] = {}; bf16x8 qr[8];
  { const unsigned qoff = (unsigned)((wid * QBLK + r32) * ZP + hi * 8) * 2u;
#pragma unroll
    for (int d0 = 0; d0 < 8; ++d0) qr[d0] = *reinterpret_cast<const bf16x8*>((const char*)Qb + qoff + d0 * 32); }
  const int sr = tid >> 4, sc = (tid & 15) * 8, vst0 = v_st(sr, sc), vst1 = v_st(32 + sr, sc);
  const int vb0 = (int)(uintptr_t)V_lds + v_rd_base(lane);
  struct { bf16x8 vs0, vs1, ks0, ks1; } sr_[2];
  const unsigned soff = (unsigned)(sr * ZP + sc) * 2u;
#define SLOAD(i, k0) do { const char* vp_ = (const char*)Vh + (size_t)(k0) * (ZP * 2); const char* kp_ = (const char*)Kh + (size_t)(k0) * (ZP * 2); \
    sr_[i].vs0 = *reinterpret_cast<const bf16x8*>(vp_ + soff); sr_[i].vs1 = *reinterpret_cast<const bf16x8*>(vp_ + 32 * ZP * 2 + soff); \
    sr_[i].ks0 = *reinterpret_cast<const bf16x8*>(kp_ + soff); sr_[i].ks1 = *reinterpret_cast<const bf16x8*>(kp_ + 32 * ZP * 2 + soff); } while (0)
#define SWRITE(b, i) do { *(bf16x8*)((char*)V_lds + (b) * SHM_V + vst0) = sr_[i].vs0;          \
    *(bf16x8*)((char*)V_lds + (b) * SHM_V + vst1) = sr_[i].vs1; int kc = sc * 2;               \
    *(bf16x8*)((char*)K_lds + (b) * SHM_K + KSWZ(sr, kc)) = sr_[i].ks0;                       \
    *(bf16x8*)((char*)K_lds + (b) * SHM_K + KSWZ(32 + sr, kc)) = sr_[i].ks1; } while (0)
#define SWAIT() asm volatile("s_waitcnt vmcnt(4)" ::: "memory")
#define PINF_A() asm volatile("" : "+v"(pa0), "+v"(pa1), "+v"(pa2), "+v"(pa3), "+v"(l_reg))
#define PINF_B(P0, PS) asm volatile("" : "+v"(P0), "+v"(PS))
  f32x16 pA0, pA1, pB0, pB1; float psA, psB; bf16x8 pa0, pa1, pa2, pa3; const int NT = seq / KVBLK;
  constexpr int SE = 0, SO = 1;
  SLOAD(SE, 0); asm volatile("s_waitcnt vmcnt(0)" ::: "memory"); SWRITE(0, SE); __syncthreads();
  qkt(pA0, pA1, K_lds, qr, r32, hi); fsSM1<SHIFT>(pA0, psA, nm);
  SLOAD(SO, KVBLK); if (2 < NT) SLOAD(SE, 2 * KVBLK);
  SWAIT(); SWRITE(1, SO); __syncthreads();
  for (int j = 1; j + 1 < NT; j += 2) {
    SBAR(); qkt(pB0, pB1, (bf16*)((char*)K_lds + SHM_K), qr, r32, hi);
    fsSM2<SHIFT>(pA0, pA1, psA, nm, l_reg, pa0, pa1, pa2, pa3); SBAR();
    SLOAD(SO, (j + 2) * KVBLK); SBAR();
    pv_d0(o, vb0, pa0, pa1, pa2, pa3); fsSM1<SHIFT>(pB0, psB, nm); SBAR();
    __syncthreads(); SWAIT(); SWRITE(0, SE);
    __syncthreads();
    SBAR(); qkt(pA0, pA1, K_lds, qr, r32, hi);
    fsSM2<SHIFT>(pB0, pB1, psB, nm, l_reg, pa0, pa1, pa2, pa3); SBAR();
    if (j + 3 < NT) SLOAD(SE, (j + 3) * KVBLK); SBAR();
    pv_d0(o, vb0 + (int)SHM_V, pa0, pa1, pa2, pa3); fsSM1<SHIFT>(pA0, psA, nm); SBAR();
    __syncthreads(); SWAIT(); SWRITE(1, SO);
    __syncthreads();
  }
  SBAR(); qkt(pB0, pB1, (bf16*)((char*)K_lds + SHM_K), qr, r32, hi);
  fsSM2<SHIFT>(pA0, pA1, psA, nm, l_reg, pa0, pa1, pa2, pa3); SBAR();
  pv_d0(o, vb0, pa0, pa1, pa2, pa3); fsSM1<SHIFT>(pB0, psB, nm);
  __syncthreads();
  fsSM2<SHIFT>(pB0, pB1, psB, nm, l_reg, pa0, pa1, pa2, pa3); SBAR();
  pv_d0(o, vb0 + (int)SHM_V, pa0, pa1, pa2, pa3);
  store_gated<ZP>(o, l_reg, li_l, (float*)(lds + ATT_OST_OFF) + wid * 2048, Gb, Yb, wid, lane, r32, hi);
#undef SLOAD
#undef SWRITE
#undef SWAIT
#undef PINF_A
#undef PINF_B
}

typedef int v8i __attribute__((ext_vector_type(8)));
#ifndef F8_SCALE_B
#define F8_SCALE_B 0x7f7f7f7f
#endif
template <bool M4 = false>
__device__ __forceinline__ void qkt_f8(f32x16& p0, f32x16& p1, const LAS3 char* Ks, const v8i* q8, int kb0) {
  _Pragma("unroll") for (int r = 0; r < 16; ++r) { p0[r] = M4 ? -4.0f : 0.0f; p1[r] = M4 ? -4.0f : 0.0f; }
  _Pragma("unroll") for (int ks = 0; ks < 2; ++ks) {
    const int o0 = kb0 ^ (ks << 6);
    const u32x4 a0 = *(const LAS3 u32x4*)(Ks + o0), a1 = *(const LAS3 u32x4*)(Ks + (o0 ^ 16));
    const u32x4 b0 = *(const LAS3 u32x4*)(Ks + 4096 + o0), b1 = *(const LAS3 u32x4*)(Ks + 4096 + (o0 ^ 16));
    const v8i A0 = {(int)a0.x, (int)a0.y, (int)a0.z, (int)a0.w, (int)a1.x, (int)a1.y, (int)a1.z, (int)a1.w};
    const v8i A1 = {(int)b0.x, (int)b0.y, (int)b0.z, (int)b0.w, (int)b1.x, (int)b1.y, (int)b1.z, (int)b1.w};
    p0 = __builtin_amdgcn_mfma_scale_f32_32x32x64_f8f6f4(A0, q8[ks], p0, 0, 0, 0, 0x7f7f7f7f, 0, F8_SCALE_B);
    p1 = __builtin_amdgcn_mfma_scale_f32_32x32x64_f8f6f4(A1, q8[ks], p1, 0, 0, 0, 0x7f7f7f7f, 0, F8_SCALE_B); }
}
template <int ZP, bool SHIFT, bool OUT8>
__device__ __forceinline__ void dense_unit_f8(const unsigned char* Q8b, const unsigned char* K8h, const bf16* Vh, const bf16* Gb, bf16* Yb, int seq, float nm, char* lds) {
  int tid_ = threadIdx.x; asm volatile("" : "+v"(tid_));
  const int tid = tid_, wid = __builtin_amdgcn_readfirstlane(tid >> 6), lane = tid & 63, r32 = lane & 31, hi = lane >> 5;
  bf16* V_lds = (bf16*)lds; const LAS3 char* K_l = (const LAS3 char*)lds + 2 * SHM_V;
  float* ws = (float*)(lds + ATT_WS_OFF) + wid * 64; float* li_l = ws;
  float l_reg = 0; f32x16 o[4] = {}; v8i q8[2];
  { const unsigned char* qp = Q8b + (size_t)(wid * QBLK + r32) * 2048 + 32 * hi;
#pragma unroll
    for (int ks = 0; ks < 2; ++ks) { const u32x4 x = *(const u32x4*)(qp + 64 * ks), y = *(const u32x4*)(qp + 64 * ks + 16);
      q8[ks] = (v8i){(int)x.x, (int)x.y, (int)x.z, (int)x.w, (int)y.x, (int)y.y, (int)y.z, (int)y.w}; } }
  const int sr = tid >> 4, sc = (tid & 15) * 8, vst0 = v_st(sr, sc), vst1 = v_st(32 + sr, sc);
  const int kr = tid >> 3, kc = tid & 7, kst = kr * 128 + ((kc ^ ((kr >> 1) & 7)) << 4);
  const int kb0 = r32 * 128 + (((2 * hi) ^ ((r32 >> 1) & 7)) << 4);
  const int vb0 = (int)(uintptr_t)V_lds + v_rd_base(lane);
  struct { bf16x8 vs0, vs1; u32x4 k8; } sr_[2];
  const unsigned soff = (unsigned)(sr * ZP + sc) * 2u, koff = (unsigned)(kr * 512 + kc * 16);
#define SLOAD(i, k0) do { const char* vp_ = (const char*)Vh + (size_t)(k0) * (ZP * 2); \
    sr_[i].vs0 = *reinterpret_cast<const bf16x8*>(vp_ + soff); sr_[i].vs1 = *reinterpret_cast<const bf16x8*>(vp_ + 32 * ZP * 2 + soff); \
    sr_[i].k8 = *reinterpret_cast<const u32x4*>(K8h + (size_t)(k0) * 512 + koff); } while (0)
#define SWRITE(b, i) do { *(bf16x8*)((char*)V_lds + (b) * SHM_V + vst0) = sr_[i].vs0; *(bf16x8*)((char*)V_lds + (b) * SHM_V + vst1) = sr_[i].vs1; \
    *(LAS3 u32x4*)((LAS3 char*)K_l + (b) * SHM_K + kst) = sr_[i].k8; } while (0)
#define SWAIT() asm volatile("s_waitcnt vmcnt(3)" ::: "memory")
  f32x16 pA0, pA1, pB0, pB1; float psA, psB; bf16x8 pa0, pa1, pa2, pa3; const int NT = seq / KVBLK;
  constexpr int SE = 0, SO = 1;
  SLOAD(SE, 0); asm volatile("s_waitcnt vmcnt(0)" ::: "memory"); SWRITE(0, SE); __syncthreads();
  qkt_f8(pA0, pA1, K_l, q8, kb0); fsSM1<SHIFT>(pA0, psA, nm);
  SLOAD(SO, KVBLK); if (2 < NT) SLOAD(SE, 2 * KVBLK);
  SWAIT(); SWRITE(1, SO); __syncthreads();
  for (int j = 1; j + 1 < NT; j += 2) {
    SBAR(); qkt_f8(pB0, pB1, K_l + SHM_K, q8, kb0);
    fsSM2<SHIFT>(pA0, pA1, psA, nm, l_reg, pa0, pa1, pa2, pa3); SBAR();
    SLOAD(SO, (j + 2) * KVBLK); SBAR();
    pv_d0(o, vb0, pa0, pa1, pa2, pa3); fsSM1<SHIFT>(pB0, psB, nm);
    __syncthreads(); SWAIT(); SWRITE(0, SE);
    __syncthreads();
    SBAR(); qkt_f8(pA0, pA1, K_l, q8, kb0);
    fsSM2<SHIFT>(pB0, pB1, psB, nm, l_reg, pa0, pa1, pa2, pa3); SBAR();
    if (j + 3 < NT) SLOAD(SE, (j + 3) * KVBLK); SBAR();
    pv_d0(o, vb0 + (int)SHM_V, pa0, pa1, pa2, pa3); fsSM1<SHIFT>(pA0, psA, nm);
    __syncthreads(); SWAIT(); SWRITE(1, SO);
    __syncthreads();
  }
  SBAR(); qkt_f8(pB0, pB1, K_l + SHM_K, q8, kb0);
  fsSM2<SHIFT>(pA0, pA1, psA, nm, l_reg, pa0, pa1, pa2, pa3); SBAR();
  pv_d0(o, vb0, pa0, pa1, pa2, pa3); fsSM1<SHIFT>(pB0, psB, nm);
  __syncthreads();
  fsSM2<SHIFT>(pB0, pB1, psB, nm, l_reg, pa0, pa1, pa2, pa3); SBAR();
  pv_d0(o, vb0 + (int)SHM_V, pa0, pa1, pa2, pa3);
  store_gated<ZP, OUT8>(o, l_reg, li_l, (float*)(lds + ATT_OST_OFF) + wid * 2048, Gb, Yb, wid, lane, r32, hi);
#undef SLOAD
#undef SWRITE
#undef SWAIT
}

template <bool CLAMP> __device__ __forceinline__ void f8SM1(f32x16& p0) {
  _Pragma("unroll") for (int r = 0; r < 16; ++r) { const float e = __builtin_amdgcn_exp2f(p0[r]); p0[r] = CLAMP ? fminf(e, 49152.0f) : e; }
}
template <bool CLAMP> __device__ __forceinline__ void f8SM2(const f32x16& p0, f32x16& p1, v8i& P8) {
  _Pragma("unroll") for (int r = 0; r < 16; ++r) { const float e = __builtin_amdgcn_exp2f(p1[r]); p1[r] = CLAMP ? fminf(e, 49152.0f) : e; }
  _Pragma("unroll") for (int i = 0; i < 4; ++i) {
    int a = __builtin_amdgcn_cvt_pk_bf8_f32(p0[4 * i], p0[4 * i + 1], 0, false); a = __builtin_amdgcn_cvt_pk_bf8_f32(p0[4 * i + 2], p0[4 * i + 3], a, true);
    int b = __builtin_amdgcn_cvt_pk_bf8_f32(p1[4 * i], p1[4 * i + 1], 0, false); b = __builtin_amdgcn_cvt_pk_bf8_f32(p1[4 * i + 2], p1[4 * i + 3], b, true);
    auto r = __builtin_amdgcn_permlane32_swap((unsigned)a, (unsigned)b, false, false);
    P8[2 * i] = (int)r[0]; P8[2 * i + 1] = (int)r[1]; }
}
__device__ __forceinline__ void pv_f8(f32x16* o, f32x16& osum, const LAS3 char* Vs, int vb8, const v8i& P8, const v8i& ones8, int one) {
  _Pragma("unroll") for (int db = 0; db < 4; ++db) {
    const u32x4 x = *(const LAS3 u32x4*)(Vs + db * 2048 + vb8), y = *(const LAS3 u32x4*)(Vs + db * 2048 + (vb8 ^ 16));
    const v8i V8 = {(int)x.x, (int)x.y, (int)x.z, (int)x.w, (int)y.x, (int)y.y, (int)y.z, (int)y.w};
    asm volatile("v_mfma_scale_f32_32x32x64_f8f6f4 %0, %1, %2, %0, %3, %3 op_sel_hi:[0,0,0] cbsz:1" : "+v"(o[db]) : "v"(P8), "v"(V8), "v"(one)); }
  asm volatile("v_mfma_scale_f32_32x32x64_f8f6f4 %0, %1, %2, %0, %3, %3 op_sel_hi:[0,0,0] cbsz:1" : "+v"(osum) : "v"(P8), "v"(ones8), "v"(one));
}
template <int ZP, bool OUT8, bool CLAMP>
__device__ __forceinline__ void dense_unit_f8pv(const unsigned char* Q8b, const unsigned char* K8h, const unsigned char* VT8h, int vt_pitch, const bf16* Gb, bf16* Yb, int seq, char* lds) {
  int tid_ = threadIdx.x; asm volatile("" : "+v"(tid_));
  const int tid = tid_, wid = __builtin_amdgcn_readfirstlane(tid >> 6), lane = tid & 63, r32 = lane & 31, hi = lane >> 5;
  const LAS3 char* V_l = (const LAS3 char*)lds;
  const LAS3 char* K_l = (const LAS3 char*)lds + 2 * 16384;
  float* ws = (float*)(lds + ATT_WS_OFF) + wid * 64; float* li_l = ws;
  f32x16 o[4] = {}, osum = {}; v8i q8[2];
  v8i ones8; { int o1 = 0x38383838; asm volatile("" : "+v"(o1)); _Pragma("unroll") for (int i = 0; i < 8; ++i) ones8[i] = o1; }
  { const unsigned char* qp = Q8b + (size_t)(wid * QBLK + r32) * 2048 + 32 * hi;
#pragma unroll
    for (int ks = 0; ks < 2; ++ks) { const u32x4 x = *(const u32x4*)(qp + 64 * ks), y = *(const u32x4*)(qp + 64 * ks + 16);
      q8[ks] = (v8i){(int)x.x, (int)x.y, (int)x.z, (int)x.w, (int)y.x, (int)y.y, (int)y.z, (int)y.w}; } }
  const int kr = tid >> 3, kc = tid & 7, kst = kr * 128 + ((kc ^ ((kr >> 1) & 7)) << 4);
  const int vd = tid >> 2, vc = tid & 3, vst = vd * 64 + ((vc ^ ((vd >> 2) & 3)) << 4);
  const int kb0 = r32 * 128 + (((2 * hi) ^ ((r32 >> 1) & 7)) << 4);
  const int vb8 = r32 * 64 + (((2 * hi) ^ ((r32 >> 2) & 3)) << 4);
  int one = 0x7f7f7f7f; asm volatile("" : "+v"(one));
  struct { u32x4 v8a, k8a, v8b, k8b; } sr_[2];
  const unsigned koff = (unsigned)(kr * 512 + kc * 16); const size_t voff = (size_t)vd * vt_pitch + vc * 16;
#define SLOAD(i, k0) do { sr_[i].v8a = *reinterpret_cast<const u32x4*>(VT8h + voff + (k0)); sr_[i].k8a = *reinterpret_cast<const u32x4*>(K8h + (size_t)(k0) * 512 + koff); \
    sr_[i].v8b = *reinterpret_cast<const u32x4*>(VT8h + voff + (k0) + 64); sr_[i].k8b = *reinterpret_cast<const u32x4*>(K8h + (size_t)((k0) + 64) * 512 + koff); } while (0)
#define SWRITE(b, i) do { *(LAS3 u32x4*)((LAS3 char*)V_l + (b) * 16384 + vst) = sr_[i].v8a; *(LAS3 u32x4*)((LAS3 char*)K_l + (b) * 16384 + kst) = sr_[i].k8a; \
    *(LAS3 u32x4*)((LAS3 char*)V_l + (b) * 16384 + 8192 + vst) = sr_[i].v8b; *(LAS3 u32x4*)((LAS3 char*)K_l + (b) * 16384 + 8192 + kst) = sr_[i].k8b; } while (0)
#define SWAIT() asm volatile("s_waitcnt vmcnt(4)" ::: "memory")
#define TBAR() do { asm volatile("s_waitcnt lgkmcnt(0)" ::: "memory"); __builtin_amdgcn_s_barrier(); asm volatile("" ::: "memory"); } while (0)
  f32x16 p0, p1; v8i P8; const int NT = seq / (2 * KVBLK);
  constexpr int SE = 0, SO = 1;
#define TCL(t) (((t) < NT ? (t) : NT - 1) * (2 * KVBLK))
#define SUBT(SL, H) do { qkt_f8<true>(p0, p1, K_l + (SL) * 16384 + (H) * 8192, q8, kb0); f8SM1<CLAMP>(p0); f8SM2<CLAMP>(p0, p1, P8); SBAR(); \
    pv_f8(o, osum, V_l + (SL) * 16384 + (H) * 8192, vb8, P8, ones8, one); } while (0)
#define STEP(SL, SETN, jn) do { SWAIT(); SWRITE(1 - (SL), SETN); SLOAD(SETN, TCL(jn)); SBAR(); SUBT(SL, 0); SBAR(); SUBT(SL, 1); TBAR(); } while (0)
  SLOAD(SE, 0); asm volatile("s_waitcnt vmcnt(0)" ::: "memory"); SWRITE(0, SE); SLOAD(SO, 2 * KVBLK); SLOAD(SE, 4 * KVBLK); TBAR();
  for (int j = 0; j < NT; j += 2) {
    STEP(0, SO, j + 3);
    STEP(1, SE, j + 4);
  }
#undef SUBT
#undef STEP
#undef TCL
#undef TBAR
  asm volatile("s_nop 15\n\ts_nop 15" ::: "memory");
  if (r32 == 0) { _Pragma("unroll") for (int r = 0; r < 16; ++r) li_l[crow(r, hi)] = osum[r]; }
  store_gated<ZP, OUT8>(o, 0.f, li_l, (float*)(lds + ATT_OST_OFF) + wid * 2048, Gb, Yb, wid, lane, r32, hi, true);
#undef SLOAD
#undef SWRITE
#undef SWAIT
}

template <int MODE, int ZP, bool WLOC = false, int KVP = ZP, int VAR = 0>
__device__ __forceinline__ void local_unit(const bf16* Qb, const bf16* Kh, const bf16* Vh, const bf16* Gb, bf16* Yb, char* lds,
                                           int jlo, int jhi, int wlo, int whi, int pa, float fa, float fb, const float* rpbh, int rot = 0) {
  int tid_ = threadIdx.x; asm volatile("" : "+v"(tid_));
  const int tid = tid_, wid = __builtin_amdgcn_readfirstlane(tid >> 6), lane = tid & 63, r32 = lane & 31, hi = lane >> 5;
  bf16* V_lds = (bf16*)lds; bf16* K_lds = (bf16*)(lds + 2 * SHM_V);
  float* ws = (float*)(lds + ATT_WS_OFF) + wid * 64; float* li_l = ws; float* al_l = ws + 32;
  float* tab = (float*)(lds + ATT_TAB_OFF);
  __syncthreads();
  if (MODE == 1) { for (int i = tid; i < 465; i += 512) tab[64 + i] = rpbh[i] * LOG2E; }
  float m_reg = -1e30f, l_reg = 0; f32x16 o[4] = {}; bf16x8 qr[8];
  { const unsigned qoff = (unsigned)(((WLOC ? 0 : wid * QBLK) + r32) * ZP + hi * 8) * 2u;
#pragma unroll
    for (int d0 = 0; d0 < 8; ++d0) qr[d0] = *reinterpret_cast<const bf16x8*>((const char*)Qb + qoff + d0 * 32); }
  GateRegs GR; if (LU_GATE_EARLY) load_gate<ZP>(GR, Gb, WLOC ? 0 : wid * 32, lane);
  const int sr = tid >> 4, sc = (tid & 15) * 8, vst0 = v_st(sr, sc), vst1 = v_st(32 + sr, sc);
  const int vb0 = (int)(uintptr_t)V_lds + v_rd_base(lane);
  bf16x8 vs0, vs1, ks0, ks1;
  const unsigned soff = (unsigned)(sr * KVP + sc) * 2u;
#define LLOAD(k0) do { const char* vp_ = (const char*)Vh + (size_t)(k0) * (KVP * 2); const char* kp_ = (const char*)Kh + (size_t)(k0) * (KVP * 2); \
    vs0 = *reinterpret_cast<const bf16x8*>(vp_ + soff); vs1 = *reinterpret_cast<const bf16x8*>(vp_ + 32 * KVP * 2 + soff); \
    ks0 = *reinterpret_cast<const bf16x8*>(kp_ + soff); ks1 = *reinterpret_cast<const bf16x8*>(kp_ + 32 * KVP * 2 + soff); } while (0)
#define LWRITE(b) do { *(bf16x8*)((char*)V_lds + (b) * SHM_V + vst0) = vs0; *(bf16x8*)((char*)V_lds + (b) * SHM_V + vst1) = vs1; int kc = sc * 2;               \
    *(bf16x8*)((char*)K_lds + (b) * SHM_K + KSWZ(sr, kc)) = ks0; *(bf16x8*)((char*)K_lds + (b) * SHM_K + KSWZ(32 + sr, kc)) = ks1; } while (0)
  constexpr float C = SCALE * LOG2E;
  const float NEG_INF = -__builtin_inff();
  int cq = 0, cs = 0, tq = 0;
  if (MODE == 1) { cq = 32 * (wid & 1) + r32; cs = cq - 8; cs = cs < 0 ? 0 : (cs > 48 ? 48 : cs); }
  else { tq = pa + (WLOC ? 0 : wid * QBLK) + r32; }
  int j = jlo + rot;
  LLOAD(j * KVBLK);
  for (int t = jhi - jlo; t > 0; --t) {
    const int b = t & 1;
    int jn = j + 1; jn = jn >= jhi ? jlo : jn;
    if (!(VAR & 8)) { asm volatile("s_waitcnt vmcnt(0)" ::: "memory"); LWRITE(b);
    if (t > 1) LLOAD(jn * KVBLK); }
    __syncthreads();
    if (j >= wlo && j < whi) {
      f32x16 p0, p1;
      if (VAR & 1) { _Pragma("unroll") for (int r = 0; r < 16; ++r) { p0[r] = (float)(j + r) * 0.01f; p1[r] = (float)(j - r) * 0.01f; } }
      else qkt(p0, p1, (bf16*)((char*)K_lds + b * SHM_K), qr, r32, hi);
      if (VAR & 2) { l_reg += p0[0]; } else {
      if (MODE == 1) {
        const float* trow = tab + 64 + (j - pa + 7) * 31 + 15 + 4 * hi - cq;
        const int cb = 4 * hi - cs;
        float bv0[16], bv1[16];
#pragma unroll
        for (int r = 0; r < 16; ++r) { const int kc0 = (r & 3) + 8 * (r >> 2); bv0[r] = trow[kc0]; bv1[r] = trow[kc0 + 32]; }
#pragma unroll
        for (int r = 0; r < 16; ++r) { const int kc0 = (r & 3) + 8 * (r >> 2);
          const float x0 = fmaf(p0[r], C, bv0[r]), x1 = fmaf(p1[r], C, bv1[r]);
          p0[r] = ((unsigned)(kc0 + cb) < 16u) ? x0 : NEG_INF;
          p1[r] = ((unsigned)(kc0 + 32 + cb) < 16u) ? x1 : NEG_INF; }
      } else {
        const float basef = (float)(j * KVBLK + 4 * hi - tq);
#pragma unroll
        for (int r = 0; r < 16; ++r) { const float kcf = (float)((r & 3) + 8 * (r >> 2));
          const float d0 = fabsf(basef + kcf), d1 = fabsf(basef + (kcf + 32.0f));
          const float x0 = fmaf(d0, -fa, p0[r]), x1 = fmaf(d1, -fa, p1[r]);
          p0[r] = (d0 <= 128.0f) ? x0 : NEG_INF;
          p1[r] = (d1 <= 128.0f) ? x1 : NEG_INF; }
      }
      float pmax = p0[0];
#pragma unroll
      for (int r = 1; r < 16; ++r) pmax = fmaxf(pmax, p0[r]);
#pragma unroll
      for (int r = 0; r < 16; ++r) pmax = fmaxf(pmax, p1[r]);
      { auto rr = __builtin_amdgcn_permlane32_swap(__float_as_uint(pmax), __float_as_uint(pmax), false, false);
        pmax = fmaxf(__uint_as_float(rr[0]), __uint_as_float(rr[1])); }
      float mn = m_reg, alpha = 1.0f;
      if (!__all(pmax - m_reg <= 8.0f * LOG2E)) { mn = fmaxf(m_reg, pmax); alpha = __builtin_amdgcn_exp2f(m_reg - mn); m_reg = mn; }
      float ps = 0.f;
#pragma unroll
      for (int r = 0; r < 16; ++r) { p0[r] = __builtin_amdgcn_exp2f(p0[r] - mn); p1[r] = __builtin_amdgcn_exp2f(p1[r] - mn); ps += p0[r] + p1[r]; }
      { auto rr = __builtin_amdgcn_permlane32_swap(__float_as_uint(ps), __float_as_uint(ps), false, false);
        ps = __uint_as_float(rr[0]) + __uint_as_float(rr[1]); }
      l_reg = l_reg * alpha + ps;
      RESC(alpha);
      }
      bf16x8 pa0, pa1, pa2, pa3;
      pack_p(p0, p1, pa0, pa1, pa2, pa3);
      if (VAR & 4) { o[0][0] += (float)pa0[0] + (float)pa1[1] + (float)pa2[2] + (float)pa3[3]; }
      else pv_d0(o, vb0 + b * (int)SHM_V, pa0, pa1, pa2, pa3);
    }
    j = jn;
  }
  if (MODE == 2) l_reg += __builtin_amdgcn_exp2f(fb - m_reg);
  store_gated<ZP, false, LU_GATE_EARLY != 0>(o, l_reg, li_l, (float*)(lds + ATT_OST_OFF) + wid * 2048, Gb, Yb, wid, lane, r32, hi, false, WLOC ? 0 : wid * 32, &GR);
#undef LLOAD
#undef LWRITE
#undef RESC
}
#define PP_BAR() do { asm volatile("s_waitcnt lgkmcnt(0)" ::: "memory"); __builtin_amdgcn_s_barrier(); asm volatile("" ::: "memory"); } while (0)

template <int ZP, int VAR = 0>
__device__ __forceinline__ void dense_unit_pp(const bf16* Qb, const bf16* Kh, const bf16* Vh, const bf16* Gb, bf16* Yb, int NT, char* lds_g) {
  int tid_ = threadIdx.x; asm volatile("" : "+v"(tid_));
  const int tid = tid_, wid = __builtin_amdgcn_readfirstlane(tid >> 6), lane = tid & 63, r32 = lane & 31, hi = lane >> 5, grp = wid >> 2;
  LAS3 char* Vl = (LAS3 char*)lds_g; LAS3 char* Kl = Vl + 2 * SHM_V;
  float* ws = (float*)(lds_g + ATT_WS_OFF) + wid * 64; float* li_l = ws; float* al_l = ws + 32;
  float m_reg = -1e30f, l_reg = 0; f32x16 o[4] = {}; bf16x8 qr[8];
  { const unsigned qoff = (unsigned)((wid * QBLK + r32) * ZP + hi * 8) * 2u;
#pragma unroll
    for (int d0 = 0; d0 < 8; ++d0) qr[d0] = *reinterpret_cast<const bf16x8*>((const char*)Qb + qoff + d0 * 32); }
  const int sr = tid >> 4, sc = (tid & 15) * 8, vst0 = v_st(sr, sc), vst1 = v_st(32 + sr, sc), kst0 = KSWZ(sr, sc * 2), kst1 = KSWZ(32 + sr, sc * 2);
  const unsigned soff = (unsigned)(sr * ZP + sc) * 2u;
  const int vrb = v_rd_base(lane), kfb = r32 * 256 + ((hi * 16) ^ ((r32 & 7) << 4));
  bf16x8 aK0, aK1, aV0, aV1;
#define PP_TC(t) ((t) < NT ? (t) : NT - 1)
#define PP_GLD(r0, r1, base, t) do { const char* p_ = (const char*)(base) + (size_t)PP_TC(t) * (64 * ZP * 2); \
    r0 = *reinterpret_cast<const bf16x8*>(p_ + soff); r1 = *reinterpret_cast<const bf16x8*>(p_ + 32 * ZP * 2 + soff); } while (0)
#define PP_WRK(slot, r0, r1) do { *(LAS3 bf16x8*)(Kl + (slot) * SHM_K + kst0) = r0; *(LAS3 bf16x8*)(Kl + (slot) * SHM_K + kst1) = r1; } while (0)
#define PP_WRV(slot, r0, r1) do { *(LAS3 bf16x8*)(Vl + (slot) * SHM_V + vst0) = r0; *(LAS3 bf16x8*)(Vl + (slot) * SHM_V + vst1) = r1; } while (0)
#define PP_KF(Kp, rowoff, d0) (*(const LAS3 bf16x8*)((Kp) + (rowoff) + (kfb_ ^ ((d0) * 32))))
#define PP_KLD(dst, Kp, d0a) do { dst[0] = PP_KF(Kp, 0, d0a); dst[1] = PP_KF(Kp, 8192, d0a); dst[2] = PP_KF(Kp, 0, (d0a) + 1); dst[3] = PP_KF(Kp, 8192, (d0a) + 1); } while (0)
#define PP_KMM(src, d0a) do { p0 = __builtin_amdgcn_mfma_f32_32x32x16_bf16(src[0], qr[d0a], p0, 0, 0, 0); p1 = __builtin_amdgcn_mfma_f32_32x32x16_bf16(src[1], qr[d0a], p1, 0, 0, 0); \
    p0 = __builtin_amdgcn_mfma_f32_32x32x16_bf16(src[2], qr[(d0a) + 1], p0, 0, 0, 0); p1 = __builtin_amdgcn_mfma_f32_32x32x16_bf16(src[3], qr[(d0a) + 1], p1, 0, 0, 0); } while (0)
#define PP_VLD(dst, Vp, oda, ks0) do { dst[0] = vtr((Vp) + v_rd_off(oda, ks0, 0)); dst[1] = vtr((Vp) + v_rd_off(oda, ks0, 1)); dst[2] = vtr((Vp) + v_rd_off((oda) + 1, ks0, 0)); dst[3] = vtr((Vp) + v_rd_off((oda) + 1, ks0, 1)); \
    dst[4] = vtr((Vp) + v_rd_off(oda, (ks0) + 1, 0)); dst[5] = vtr((Vp) + v_rd_off(oda, (ks0) + 1, 1)); dst[6] = vtr((Vp) + v_rd_off((oda) + 1, (ks0) + 1, 0)); dst[7] = vtr((Vp) + v_rd_off((oda) + 1, (ks0) + 1, 1)); } while (0)
#define PP_PK(L, H) (bf16x8){L[0], L[1], L[2], L[3], H[0], H[1], H[2], H[3]}
#define PP_VMM(src, oda, pfa, pfb) do { o[oda] = __builtin_amdgcn_mfma_f32_32x32x16_bf16(pfa, PP_PK(src[0], src[1]), o[oda], 0, 0, 0); o[(oda) + 1] = __builtin_amdgcn_mfma_f32_32x32x16_bf16(pfa, PP_PK(src[2], src[3]), o[(oda) + 1], 0, 0, 0); \
    o[oda] = __builtin_amdgcn_mfma_f32_32x32x16_bf16(pfb, PP_PK(src[4], src[5]), o[oda], 0, 0, 0); o[(oda) + 1] = __builtin_amdgcn_mfma_f32_32x32x16_bf16(pfb, PP_PK(src[6], src[7]), o[(oda) + 1], 0, 0, 0); } while (0)
  f32x16 p0, p1; bf16x8 pa0, pa1, pa2, pa3;
#define RESC(a) do { if (__any((a) < 1.f)) { if (hi == 0) al_l[r32] = (a); asm volatile("s_waitcnt lgkmcnt(0)" ::: "memory"); \
    _Pragma("unroll") for (int d = 0; d < 4; ++d) _Pragma("unroll") for (int r = 0; r < 16; ++r) o[d][r] *= al_l[crow(r, hi)]; } } while (0)
#define PP_MF(KS, VS, DOQK) do { const LAS3 char* Kp_ = Kl + (KS) * SHM_K; const LAS3 char* Vp_ = Vl + (VS) * SHM_V + vrb; \
    bf16x8 ka_[4], kb_[4]; s16x4 va_[8], vb_[8]; int kfb_ = kfb; asm volatile("" : "+v"(kfb_)); \
    if (DOQK) { p0 = f32x16{}; p1 = f32x16{}; \
      PP_KLD(ka_, Kp_, 0); PP_KLD(kb_, Kp_, 2); SBAR(); PP_KMM(ka_, 0); SBAR(); PP_KLD(ka_, Kp_, 4); SBAR(); PP_KMM(kb_, 2); SBAR(); PP_KLD(kb_, Kp_, 6); SBAR(); \
      PP_KMM(ka_, 4); SBAR(); PP_VLD(va_, Vp_, 0, 0); SBAR(); PP_KMM(kb_, 6); SBAR(); } \
    else { PP_VLD(va_, Vp_, 0, 0); SBAR(); } \
    PP_VLD(vb_, Vp_, 0, 2); SBAR(); PP_VMM(va_, 0, pa0, pa1); SBAR(); PP_VLD(va_, Vp_, 2, 0); SBAR(); PP_VMM(vb_, 0, pa2, pa3); SBAR(); \
    PP_VLD(vb_, Vp_, 2, 2); SBAR(); PP_VMM(va_, 2, pa0, pa1); SBAR(); PP_VMM(vb_, 2, pa2, pa3); SBAR(); } while (0)
#define PP_SM() do { float mn_, al_; partialSM(p0, p1, m_reg, mn_, al_); finishSM(p0, p1, al_, l_reg, pa0, pa1, pa2, pa3); RESC(al_); } while (0)

  PP_GLD(aK0, aK1, Kh, 0); PP_GLD(aV0, aV1, Vh, 0);
  PP_WRK(0, aK0, aK1); PP_WRV(0, aV0, aV1);
  PP_GLD(aK0, aK1, Kh, 1);
  PP_WRK(1, aK0, aK1);
  PP_GLD(aK0, aK1, Kh, 2); PP_GLD(aV0, aV1, Vh, 1);
  PP_BAR();
  { const LAS3 char* Kp_ = Kl; bf16x8 ka_[4]; int kfb_ = kfb; asm volatile("" : "+v"(kfb_)); p0 = f32x16{}; p1 = f32x16{};
    PP_KLD(ka_, Kp_, 0); SBAR(); PP_KMM(ka_, 0); SBAR(); PP_KLD(ka_, Kp_, 2); SBAR(); PP_KMM(ka_, 2); SBAR(); PP_KLD(ka_, Kp_, 4); SBAR(); PP_KMM(ka_, 4); SBAR(); PP_KLD(ka_, Kp_, 6); SBAR(); PP_KMM(ka_, 6); SBAR(); }
  PP_SM();
  PP_BAR();
#define PP_STAGE(x, KSL, VSL) do { PP_WRK(KSL, aK0, aK1); PP_WRV(VSL, aV0, aV1); PP_GLD(aK0, aK1, Kh, (x) + 3); PP_GLD(aV0, aV1, Vh, (x) + 2); } while (0)
  if (grp == 1) { PP_STAGE(0, 0, 1); PP_BAR(); }
  for (int jt = 0; jt < NT; jt += 2) {
    if (grp == 0) PP_STAGE(jt, 0, 1);
    if (VAR != 2) { PP_MF(1, 0, true); } PP_BAR();
    if (grp == 1) PP_STAGE(jt + 1, 1, 0);
    if (VAR != 1) { PP_SM(); } PP_BAR();
    if (grp == 0) PP_STAGE(jt + 1, 1, 0);
    if (VAR != 2) { PP_MF(0, 1, jt + 2 < NT); } PP_BAR();
    if (grp == 1) PP_STAGE(jt + 2, 0, 1);
    if (VAR != 1 && jt + 2 < NT) { PP_SM(); }
    PP_BAR();
  }
  if (grp == 0) PP_BAR();
#undef PP_STAGE
  store_gated<ZP>(o, l_reg, li_l, (float*)(lds_g + ATT_OST_OFF) + wid * 2048, Gb, Yb, wid, lane, r32, hi);
#undef PP_TC
#undef PP_GLD
#undef PP_WRK
#undef PP_WRV
#undef PP_KF
#undef PP_KLD
#undef PP_KMM
#undef PP_VLD
#undef PP_PK
#undef PP_VMM
#undef PP_MF
#undef PP_SM
#undef RESC
}
}
constexpr int NWAVES = 8;
constexpr int S = 8192, DM = 4096, HD = 128, DEPTH = 4;
constexpr int NIN_E = 13312, NIN_O = 10240;
constexpr int E_QA = 0, E_KA = 2048, E_VA = 2560, E_QB = 3072, E_KB = 5120, E_VB = 7168, E_G = 9216;
constexpr int O_Q = 0, O_K = 4096, O_V = 5120, O_G = 6144;
constexpr float NORM_EPS = 1e-6f;
constexpr size_t MiB = 1u << 20;
#ifndef GATEB_F8
#define GATEB_F8 0
#endif
constexpr size_t WS_CTL = 0, CTL_ZERO_BYTES = 1 * MiB;
constexpr size_t WS_ROPE = 1 * MiB;
constexpr size_t WS_PART = 2 * MiB;
constexpr size_t WS_WIN_E = 8 * MiB, WIN_E_BYTES = (size_t)NIN_E * DM * 2;
constexpr size_t WS_WIN_O = WS_WIN_E + 2 * WIN_E_BYTES, WIN_O_BYTES = (size_t)NIN_O * DM * 2;
constexpr size_t WS_WOUT_E = WS_WIN_O + 2 * WIN_O_BYTES, WOUT_BYTES = (size_t)DM * DM * 2;
constexpr size_t WS_WOUT_O = WS_WOUT_E + 2 * WOUT_BYTES;
constexpr size_t WS_XB = WS_WOUT_O + 2 * WOUT_BYTES;
constexpr size_t WS_Y = WS_XB + (size_t)S * DM * 2;
constexpr size_t WS_Z = WS_Y + (size_t)S * DM * 2;
constexpr size_t WS_Q8 = WS_Z + (size_t)S * NIN_E * 2;
constexpr size_t WS_K8 = WS_Q8 + (size_t)S * 2048;
constexpr size_t WS_XB8 = WS_K8 + (size_t)S * 512;
constexpr size_t WS_W8 = WS_XB8 + (size_t)S * DM, W8_ROWS = GATEB_F8 ? 7168 : 5120, W8_BYTES = W8_ROWS * (size_t)DM;
constexpr size_t WS_VT8 = WS_W8 + 2 * W8_BYTES;
constexpr size_t WS_KVB = WS_VT8 + (size_t)512 * S;
constexpr size_t WS_XH = WS_KVB + (size_t)80 * S * 128 * 2;
constexpr size_t WS_END = WS_XH + (size_t)S * DM * 2;
constexpr float W8_SCALE = 64.0f;
constexpr int CW_BAR = 4096;
constexpr int RING_OFF = 0, RING_BYTES = 131072;
constexpr int LDSCTL_OFF = 143360, MISC_OFF = LDSCTL_OFF + 320;
constexpr int NRP_OFF = 131072;
constexpr int RSTD_OFF = 139264;
constexpr int LDS_BYTES = 147456;
static_assert(MISC_OFF + 128 <= LDS_BYTES && att::ATT_LDS_BYTES <= LDSCTL_OFF && RING_BYTES <= NRP_OFF && NRP_OFF + 8192 <= RSTD_OFF && RSTD_OFF + 1024 <= LDSCTL_OFF, "LDS map");

#define GAS __attribute__((address_space(1)))
#define LAS __attribute__((address_space(3)))
typedef unsigned short bf16;
typedef unsigned v4u __attribute__((ext_vector_type(4)));
typedef float f32x4 __attribute__((ext_vector_type(4)));
typedef GAS unsigned gu32;
#define LDS_WAIT() asm volatile("s_waitcnt lgkmcnt(0)" ::: "memory")
#define VM_WAIT() asm volatile("s_waitcnt vmcnt(0)" ::: "memory")
__device__ __forceinline__ unsigned pk2(float lo, float hi) { unsigned r; asm volatile("v_cvt_pk_bf16_f32 %0, %1, %2" : "=v"(r) : "v"(lo), "v"(hi)); return r; }
typedef _Float16 fh2 __attribute__((ext_vector_type(2)));
__device__ __forceinline__ unsigned pk2h(float lo, float hi) { const fh2 h = {(_Float16)lo, (_Float16)hi}; return __builtin_bit_cast(unsigned, h); }
#ifndef IN_F16
#define IN_F16 0
#endif
#define XB_TMO      128
#define XB_XCNT(j)  (256  + 64 * (j))
#define XB_XSUB(j)  (1280 + 64 * (j))
#define XB_XGEN(j)  (2304 + 64 * (j))
#define XB_TOP      3328
#define XB_TOPGEN   3392
#define XCD_BAR_WORDS 3456
#define XB_SPIN_CAP (1u << 18)

__device__ __forceinline__ unsigned xb_ld(unsigned* p)              { return __hip_atomic_load(p, __ATOMIC_RELAXED, __HIP_MEMORY_SCOPE_AGENT); }
__device__ __forceinline__ unsigned xb_add(unsigned* p, unsigned v) { return __hip_atomic_fetch_add(p, v, __ATOMIC_RELAXED, __HIP_MEMORY_SCOPE_AGENT); }
__device__ __forceinline__ unsigned xb_xcc_id() { return (unsigned)__builtin_amdgcn_s_getreg((3 << 11) | 20) & 0xFu; }
#define XB_SPIN(cond, bar) do { unsigned _sp = 0; while (cond) { __builtin_amdgcn_s_sleep(1); \
    if ((++_sp & 255u) == 0u) { if (xb_ld(&(bar)[XB_TMO])) break; if (_sp > XB_SPIN_CAP) { atomicAdd(&(bar)[XB_TMO], 1u); break; } } } } while (0)

struct XcdBarrier {
    unsigned* bar; unsigned x;
    volatile LAS unsigned* st;
};

__device__ __forceinline__ XcdBarrier xcd_barrier_post(unsigned* bar, volatile LAS unsigned* st) {
    XcdBarrier b; b.bar = bar; b.x = xb_xcc_id(); b.st = st;
    if (threadIdx.x == 0) (void)xb_add(&bar[XB_XCNT(b.x)], 1u);
    return b;
}
__device__ __forceinline__ void xcd_barrier_complete(unsigned* bar, unsigned x, unsigned& nloc, unsigned& nx) {
    const unsigned G = gridDim.x * gridDim.y * gridDim.z;
    unsigned sum, cnt, mine, sp = 0u;
    for (;;) {
        sum = 0u; cnt = 0u; mine = 0u;
#pragma unroll
        for (unsigned j = 0; j < 16; ++j) { const unsigned c = xb_ld(&bar[XB_XCNT(j)]); sum += c; cnt += (c > 0u) ? 1u : 0u; mine = (j == x) ? c : mine; }
        if (sum == G) break;
        __builtin_amdgcn_s_sleep(1);
        if ((++sp & 255u) == 0u) { if (xb_ld(&bar[XB_TMO])) break; if (sp > XB_SPIN_CAP) { atomicAdd(&bar[XB_TMO], 1u); break; } }
    }
    nloc = mine > 0u ? mine : 1u; nx = cnt > 0u ? cnt : 1u;
}

__device__ __forceinline__ void xcd_barrier(const XcdBarrier& b) {
    asm volatile("s_waitcnt vmcnt(0)" ::: "memory");
    __syncthreads();
    if (threadIdx.x == 0) {
        unsigned* bar = b.bar;
        __builtin_amdgcn_s_waitcnt(0);
        unsigned nloc = b.st[0], nx = b.st[1];
        if (nloc == 0u) { xcd_barrier_complete(bar, b.x, nloc, nx); b.st[0] = nloc; b.st[1] = nx; }
        const unsigned old = xb_add(&bar[XB_XSUB(b.x)], 1u);
        const unsigned gen = old / nloc;
        if (old + 1u == (gen + 1u) * nloc) {
            __builtin_amdgcn_fence(__ATOMIC_RELEASE, "agent");
            asm volatile("s_waitcnt vmcnt(0)" ::: "memory");
            const unsigned og = xb_add(&bar[XB_TOP], 1u);
            const unsigned tg = og / nx;
            if (og + 1u == (tg + 1u) * nx) xb_add(&bar[XB_TOPGEN], 1u);
            else XB_SPIN(xb_ld(&bar[XB_TOPGEN]) == tg, bar);
            __builtin_amdgcn_fence(__ATOMIC_ACQUIRE, "agent");
            xb_add(&bar[XB_XGEN(b.x)], 1u);
            asm volatile("s_waitcnt vmcnt(0)" ::: "memory");
        } else {
            XB_SPIN(xb_ld(&bar[XB_XGEN(b.x)]) == gen, bar);
            __builtin_amdgcn_fence(__ATOMIC_ACQUIRE, "agent");
            asm volatile("s_waitcnt vmcnt(0)" ::: "memory");
        }
    }
    __syncthreads();
}
#ifndef ITEM_KFAST
#define ITEM_KFAST 0
#endif
struct Frame {
    LAS unsigned char* lds;
    volatile LAS unsigned* MISC;
    gu32* ctl;
    int wave;
    int vcu, G;
};
__device__ __forceinline__ float wave_sum(float v) {
#pragma unroll
    for (int o = 1; o < 64; o <<= 1) v += __shfl_xor(v, o);
    return v;
}
struct ItemP { const float* W; int N; const float* kscale; bf16* WT; int item; int nperm; unsigned char* W8; int n8; int ksplit; int f16; };
__device__ __forceinline__ void ti_load(f32x4 (&v)[16], f32x4 (&ks)[2], const ItemP& P, int lane) {
    const float* W = P.W; const int N = P.N, item = P.item;
    const int kb = ITEM_KFAST ? (item & 63) : item / (N >> 6), nb = ITEM_KFAST ? (item >> 6) : item - kb * (N >> 6), k0 = kb << 6, n0 = nb << 6;
    const int lr = lane >> 4, lc = (lane & 15) << 2;
    { const float* kp = P.kscale ? P.kscale + k0 : W;
      ks[0] = *(const f32x4*)(kp + 8 * (lane & 7)); ks[1] = *(const f32x4*)(kp + 8 * (lane & 7) + 4); }
#pragma unroll
    for (int i = 0; i < 16; ++i) v[i] = *(const f32x4*)(W + (size_t)(k0 + 4 * i + lr) * N + n0 + lc);
}
__device__ __forceinline__ void ti_finish(f32x4 (&v)[16], const f32x4 (&ks)[2], const ItemP& P, LAS float* scr, int lane) {
    const int N = P.N, item = P.item, nperm = P.nperm, n8 = P.n8, ksplit = P.ksplit; bf16* WT = P.WT; unsigned char* W8 = P.W8; const bool f16 = P.f16 != 0;
    const int kb = ITEM_KFAST ? (item & 63) : item / (N >> 6), nb = ITEM_KFAST ? (item >> 6) : item - kb * (N >> 6), k0 = kb << 6, n0 = nb << 6;
    const int lr = lane >> 4, lc = (lane & 15) << 2; (void)lc;
#pragma unroll
    for (int i = 0; i < 16; ++i) { const int k = 4 * i + lr;
        *(LAS f32x4*)(scr + k * 64 + (lc ^ (((k >> 3) & 3) << 3))) = v[i]; }
    LDS_WAIT(); asm volatile("" ::: "memory");
    const int c = lane & 7, nn = lane >> 3, f = (c & 3) << 3;
    const bool hasg = P.kscale != nullptr; const f32x4 one4 = {1.f, 1.f, 1.f, 1.f}; const f32x4 g0 = hasg ? ks[0] : one4, g1 = hasg ? ks[1] : one4;
#pragma unroll
    for (int j = 0; j < 8; ++j) { const int n = nn + 8 * j; const LAS float* sp = scr + (8 * c) * 64 + (n ^ f);
                const float t0 = sp[0 * 64] * g0[0], t1 = sp[1 * 64] * g0[1], t2 = sp[2 * 64] * g0[2], t3 = sp[3 * 64] * g0[3], t4 = sp[4 * 64] * g1[0], t5 = sp[5 * 64] * g1[1], t6 = sp[6 * 64] * g1[2], t7 = sp[7 * 64] * g1[3];
        v4u o; if (f16) { o.x = pk2h(t0, t1); o.y = pk2h(t2, t3); o.z = pk2h(t4, t5); o.w = pk2h(t6, t7); }
        else { o.x = pk2(t0, t1); o.y = pk2(t2, t3); o.z = pk2(t4, t5); o.w = pk2(t6, t7); }
        const int cn = n0 + n, dn = cn < nperm ? (cn & ~63) + 8 * ((cn & 31) >> 2) + 4 * ((cn >> 5) & 1) + (cn & 3) : cn;
        const bool to8 = n8 > 0 && (n0 < 3072 || (n0 >= 9216 && n0 < (GATEB_F8 ? 13312 : 11264)));
        if (to8) { const int dn8 = n0 < 3072 ? dn : 3072 + (cn - 9216); int e0 = __builtin_amdgcn_cvt_pk_fp8_f32(t0 * W8_SCALE, t1 * W8_SCALE, 0, false); e0 = __builtin_amdgcn_cvt_pk_fp8_f32(t2 * W8_SCALE, t3 * W8_SCALE, e0, true);
            int e1 = __builtin_amdgcn_cvt_pk_fp8_f32(t4 * W8_SCALE, t5 * W8_SCALE, 0, false); e1 = __builtin_amdgcn_cvt_pk_fp8_f32(t6 * W8_SCALE, t7 * W8_SCALE, e1, true);
            typedef int i32x2t __attribute__((ext_vector_type(2))); *(GAS i32x2t*)(W8 + (size_t)dn8 * DM + k0 + 8 * c) = (i32x2t){e0, e1}; }
        else if (k0 < ksplit) { int e0 = __builtin_amdgcn_cvt_pk_fp8_f32(t0 * W8_SCALE, t1 * W8_SCALE, 0, false); e0 = __builtin_amdgcn_cvt_pk_fp8_f32(t2 * W8_SCALE, t3 * W8_SCALE, e0, true);
            int e1 = __builtin_amdgcn_cvt_pk_fp8_f32(t4 * W8_SCALE, t5 * W8_SCALE, 0, false); e1 = __builtin_amdgcn_cvt_pk_fp8_f32(t6 * W8_SCALE, t7 * W8_SCALE, e1, true);
            typedef int i32x2u __attribute__((ext_vector_type(2))); *(GAS i32x2u*)((GAS unsigned char*)(WT + (size_t)dn * DM) + k0 + 8 * c) = (i32x2u){e0, e1}; }
        else *(GAS v4u*)(WT + (size_t)dn * DM + k0 + 8 * c) = o; }
    LDS_WAIT(); asm volatile("" ::: "memory");
}
__device__ __forceinline__ void transpose_item(const float* W, int N, const float* kscale, bf16* WT, LAS float* scr, int item, int lane, int nperm = 0, unsigned char* W8 = nullptr, int n8 = 0, int ksplit = 0, bool f16 = false) {
    const ItemP P{W, N, kscale, WT, item, nperm, W8, n8, ksplit, f16 ? 1 : 0};
    f32x4 v[16], ks[2]; ti_load(v, ks, P, lane); ti_finish(v, ks, P, scr, lane);
}

__device__ __forceinline__ unsigned group_sync(gu32* cnt, unsigned need, unsigned* tmo, volatile LAS unsigned* bc) {
    asm volatile("s_waitcnt vmcnt(0)" ::: "memory");
    __syncthreads();
    if (threadIdx.x == 0) {
        __builtin_amdgcn_fence(__ATOMIC_RELEASE, "agent");
        asm volatile("s_waitcnt vmcnt(0)" ::: "memory");
        const unsigned ticket = __hip_atomic_fetch_add(cnt, 1u, __ATOMIC_RELAXED, __HIP_MEMORY_SCOPE_AGENT);
        unsigned sp = 0u;
        while (__hip_atomic_load(cnt, __ATOMIC_RELAXED, __HIP_MEMORY_SCOPE_AGENT) < need) { __builtin_amdgcn_s_sleep(1);
            if ((++sp & 255u) == 0u) { if (xb_ld(tmo)) break; if (sp > XB_SPIN_CAP) { atomicAdd(tmo, 1u); break; } } }
        __builtin_amdgcn_fence(__ATOMIC_ACQUIRE, "agent");
        asm volatile("s_waitcnt vmcnt(0)" ::: "memory");
        bc[0] = ticket;
    }
    __syncthreads();
    return bc[0];
}
constexpr int CW_GRP = 16384;

struct PanelOrder {
    int pm, k, f8;
    __device__ __forceinline__ bool next(int i, pg8::Unit& u) const {
        u.pm = pm;
#if GATEB_F8
        if (f8) { if (i < 3) { u.pn = k + 8 * i; return true; } if (i == 3 && k < 4) { u.pn = 24 + k; return true; } return false; }
        if (i < 3) { u.pn = 12 + k + 8 * i; return true; } return false;
#else
        if (f8) { if (i < 2) { u.pn = k + 8 * i; return true; } if (i == 2 && k < 4) { u.pn = 16 + k; return true; } return false; }
        if (i < 4) { const int j = k + 8 * i; u.pn = j < 24 ? 12 + j : 20 + j; return true; } return false;
#endif
    }
    __device__ __forceinline__ void a_ready(const pg8::Unit&) const {}
    __device__ __forceinline__ void done(const pg8::Unit&) const {}
};

struct Args { const float* in[11]; float* out; unsigned char* ws; int ph_lo, ph_hi; };
constexpr int PH_FINAL = 1 + 4 * DEPTH, PH_END = PH_FINAL + 1;
#ifndef DENSE_PP
#define DENSE_PP 1
#endif
#ifndef CONV_SH_LO
#define CONV_SH_LO 1
#endif
#ifndef CONV_SH_HI
#define CONV_SH_HI 2
#endif
#ifndef PV_F8
#define PV_F8 1
#endif
#ifndef OUT_F8
#define OUT_F8 1
#endif
#ifndef INP_F8
#define INP_F8 1
#endif
#ifndef DENSE_F8
#define DENSE_F8 1
#endif
#ifndef DENSE_FS
#define DENSE_FS 1
#endif
#ifndef F8_QS
#define F8_QS 1.0f
#endif
#if DENSE_F8
#define DENSE_QSCALE (att::SCALE * att::LOG2E * F8_QS)
#define DENSE_CALL(QO, KO, VP, GP, YP) do { const unsigned char* q8_ = ws + WS_Q8 + (size_t)(qb * 256) * 2048 + h * HD; const unsigned char* k8_ = ws + WS_K8 + kvh * HD; \
    bf16* yp_ = OUT_F8 ? (bf16*)((char*)Y + (size_t)(qb * 256) * (DM * 2) + h * HD) : (YP); \
    if (PV_F8) { if (dense_nm >= -19.5f) att::dense_unit_f8pv<NIN_E, OUT_F8 != 0, false>(q8_, k8_, ws + WS_VT8 + (size_t)kvh * HD * S, S, GP, yp_, S, al); \
                 else att::dense_unit_f8pv<NIN_E, OUT_F8 != 0, true>(q8_, k8_, ws + WS_VT8 + (size_t)kvh * HD * S, S, GP, yp_, S, al); }     \
    else if (dense_nm >= -40.0f) att::dense_unit_f8<NIN_E, false, OUT_F8 != 0>(q8_, k8_, VP, GP, yp_, S, dense_nm, al); else att::dense_unit_f8<NIN_E, true, OUT_F8 != 0>(q8_, k8_, VP, GP, yp_, S, dense_nm, al); } while (0)
#elif DENSE_FS
#define DENSE_QSCALE (att::SCALE * att::LOG2E)
#define DENSE_CALL(...) do { if (dense_nm >= -40.0f) att::dense_unit_fs<NIN_E, false>(__VA_ARGS__, S, dense_nm, al); else att::dense_unit_fs<NIN_E, true>(__VA_ARGS__, S, dense_nm, al); } while (0)
#elif DENSE_PP
#define DENSE_QSCALE 1.0f
#define DENSE_CALL(...) att::dense_unit_pp<NIN_E>(__VA_ARGS__, S / 64, al)
#else
#define DENSE_QSCALE 1.0f
#define DENSE_CALL(...) att::dense_unit<NIN_E>(__VA_ARGS__, S, al)
#endif
#ifndef ZP_O
#define ZP_O NIN_O
#endif
#ifndef WIN_GQA
#define WIN_GQA 1
#endif
#ifndef GROUP_SYNC
#define GROUP_SYNC 0
#endif
#ifndef TAIL_OUT_O
#define TAIL_OUT_O 0
#endif
#ifndef TAIL_INO_ITEMS
#define TAIL_INO_ITEMS 10240
#endif
#ifndef GEMM_ALIGN_OUT
#define GEMM_ALIGN_OUT true
#endif
#ifndef GEMM_SP2
#define GEMM_SP2 true
#endif
#ifndef GEMM_ALIGN
#define GEMM_ALIGN true
#endif
#ifndef REP_PRO
#define REP_PRO 1
#endif
#ifndef REP_IN
#define REP_IN 1
#endif
#ifndef REP_OUT0
#define REP_OUT0 1
#endif
#ifndef REP_DENSE
#define REP_DENSE 1
#endif
#ifndef CONV_SLOTS
#define CONV_SLOTS 1
#endif
#ifndef HM_ALL
#define HM_ALL 1
#endif
#ifndef RES_F16
#define RES_F16 15
#endif
constexpr bool res_combo(bool ob, bool nf, int parity) { for (int L = parity; L < DEPTH; L += 2) { const bool o = L > 0 && ((RES_F16 >> (L - 1)) & 1), n = !((RES_F16 >> L) & 1); if (o == ob && n == nf) return true; } return false; }
#ifndef NA_HALF_REPS
#define NA_HALF_REPS 0
#endif
#ifndef NA_HALF_DIV
#define NA_HALF_DIV 2
#endif
#ifndef NA_ROT
#define NA_ROT 1
#endif
#ifndef WIN_ROT
#define WIN_ROT 1
#endif
#ifndef REP_NA
#define REP_NA 1
#endif
#ifndef REP_LOCAL
#define REP_LOCAL 1
#endif

__global__ void __launch_bounds__(NWAVES * 64, 2) mk_fwd(Args args) {
    extern __shared__ __attribute__((aligned(16))) unsigned char lds[];
    Frame F;
    F.lds = (LAS unsigned char*)lds;
    F.MISC = (volatile LAS unsigned*)(F.lds + MISC_OFF);
    F.wave = __builtin_amdgcn_readfirstlane((int)threadIdx.x >> 6);
    F.G = gridDim.x; { const int bx = blockIdx.x; F.vcu = (F.G % 8 == 0) ? (bx % 8) * (F.G / 8) + bx / 8 : bx; }
    unsigned char* ws = args.ws;
    F.ctl = (gu32*)(ws + WS_CTL);
    for (int u = ((int)threadIdx.x); u < (LDS_BYTES - LDSCTL_OFF) / 4; u += NWAVES * 64) ((LAS unsigned*)(F.lds + LDSCTL_OFF))[u] = 0u;
    __syncthreads();
    const int lo = args.ph_lo, hi = args.ph_hi;
    const bool use_bar = (hi - lo) > 1;
    XcdBarrier bar; bar.bar = (unsigned*)(F.ctl + CW_BAR); bar.x = 0; bar.st = nullptr;
    if (use_bar) bar = xcd_barrier_post((unsigned*)(F.ctl + CW_BAR), F.MISC + 8);
#define IN(k) (lo <= (k) && (k) < hi)
#if defined(DIAG_IDLE)
    unsigned long long idle_acc = 0;
#define SEAM(k) do { if (IN(k) && IN((k) + 1)) { const unsigned long long t0_ = __builtin_amdgcn_s_memrealtime(); xcd_barrier(bar); \
        if ((DIAG_IDLE >> (k)) & 1) idle_acc += __builtin_amdgcn_s_memrealtime() - t0_; } } while (0)
#else
#define SEAM(k) do { if (IN(k) && IN((k) + 1)) xcd_barrier(bar); } while (0)
#endif

#if defined(DIAG_PHT)
    unsigned long long pht = 0;
    if (DIAG_PHT & 1) pht -= __builtin_amdgcn_s_memrealtime();
#undef SEAM
#define SEAM(k) do { if (IN(k) && IN((k) + 1)) xcd_barrier(bar); if ((DIAG_PHT >> (k)) & 1) pht += __builtin_amdgcn_s_memrealtime(); } while (0)
#define CLK_BEGIN(k) do { if ((k) > 0 && ((DIAG_PHT >> (k)) & 1)) pht -= __builtin_amdgcn_s_memrealtime(); } while (0)
#define CLK_END(k) do {} while (0)
#elif defined(DIAG_CLK)
    unsigned long long clk_m = 0, clk_r = 0;
#define CLK_BEGIN(k) do { if ((k) == DIAG_CLK) { clk_m -= __builtin_amdgcn_s_memtime(); clk_r -= __builtin_amdgcn_s_memrealtime(); } } while (0)
#define CLK_END(k) do { if ((k) == DIAG_CLK) { clk_m += __builtin_amdgcn_s_memtime(); clk_r += __builtin_amdgcn_s_memrealtime(); } } while (0)
#else
#define CLK_BEGIN(k) do {} while (0)
#define CLK_END(k) do {} while (0)
#endif
    const float* x_in = args.in[0];
    float* X = args.out;
    float* PART = (float*)(ws + WS_PART);
    bf16* XB = (bf16*)(ws + WS_XB); bf16* Y = (bf16*)(ws + WS_Y); bf16* Z = (bf16*)(ws + WS_Z); bf16* KVB = (bf16*)(ws + WS_KVB);
    unsigned short* XH = IN_F16 ? (unsigned short*)XB : (unsigned short*)(ws + WS_XH);
    static_assert(!IN_F16 || RES_F16 == 15, "IN_F16 needs the fp16 residual stream in every layer");
    float* ROPE = (float*)(ws + WS_ROPE);
    const int gw = F.vcu * NWAVES + F.wave, NGW = F.G * NWAVES;

    if (IN(0)) {
      _Pragma("nounroll") for (int rep = 0; rep < REP_PRO; ++rep) {
        LAS float* scr = (LAS float*)(F.lds + RING_OFF + F.wave * 16384);
        constexpr int I_INE = 64 * (NIN_E / 64), I_OUT = 64 * (DM / 64);
        constexpr int NITEMS = (CONV_SLOTS ? I_INE : 2 * I_INE + 4 * I_OUT) + 2 * (64 * (NIN_O / 64) - TAIL_INO_ITEMS);
        static_assert(!TAIL_OUT_O, "the prologue converts both out-projection weight sets");
        auto pro_item = [&](int it) __attribute__((always_inline)) -> ItemP {
            int r = it;
            if (r < I_INE) return ItemP{args.in[2], NIN_E, args.in[1], (bf16*)(ws + WS_WIN_E), r, E_VA, ws + WS_W8, INP_F8 ? (int)W8_ROWS : 0, 0, IN_F16 != 0};
            r -= I_INE;
            if (!CONV_SLOTS) {
            if (r < I_OUT) return ItemP{args.in[3], DM, nullptr, (bf16*)(ws + WS_WOUT_E), r, 0, nullptr, 0, OUT_F8 ? 2048 : 0, 0};
            r -= I_OUT;
            if (r < I_OUT) return ItemP{args.in[8], DM, nullptr, (bf16*)(ws + WS_WOUT_O), r, 0, nullptr, 0, 0, 0};
            r -= I_OUT;
            if (r < I_INE) return ItemP{args.in[2] + (size_t)DM * NIN_E, NIN_E, args.in[1] + 2 * DM, (bf16*)(ws + WS_WIN_E + WIN_E_BYTES), r, E_VA, ws + WS_W8 + W8_BYTES, INP_F8 ? (int)W8_ROWS : 0, 0, IN_F16 != 0};
            r -= I_INE;
            if (r < I_OUT) return ItemP{args.in[3] + (size_t)DM * DM, DM, nullptr, (bf16*)(ws + WS_WOUT_E + WOUT_BYTES), r, 0, nullptr, 0, OUT_F8 ? 2048 : 0, 0};
            r -= I_OUT;
            if (r < I_OUT) return ItemP{args.in[8] + (size_t)DM * DM, DM, nullptr, (bf16*)(ws + WS_WOUT_O + WOUT_BYTES), r, 0, nullptr, 0, 0, 0};
            r -= I_OUT;
            }
            constexpr int REST = 64 * (NIN_O / 64) - TAIL_INO_ITEMS; const int eo = r / (REST > 0 ? REST : 1); r -= eo * REST;
            return ItemP{args.in[7] + (size_t)eo * DM * NIN_O, NIN_O, args.in[1] + (2 * eo + 1) * DM, (bf16*)(ws + WS_WIN_O + eo * WIN_O_BYTES), TAIL_INO_ITEMS + r, 0, nullptr, 0, 0, IN_F16 != 0};
        };
        { int ln = ((int)threadIdx.x & 63); asm volatile("" : "+v"(ln));
          constexpr int LASTI = NITEMS - 1;
          int it = gw;
          if (it < NITEMS) {
            f32x4 va[16], vb[16], ka[2], kb[2];
            ItemP pa = pro_item(it), pb = pa;
            ti_load(va, ka, pa, ln);
            for (;;) {
                { const int itn = it + NGW; pb = pro_item(itn < NITEMS ? itn : LASTI); ti_load(vb, kb, pb, ln); asm volatile("" ::: "memory");
                  ti_finish(va, ka, pa, scr, ln); it = itn; if (it >= NITEMS) break; }
                { const int itn = it + NGW; pa = pro_item(itn < NITEMS ? itn : LASTI); ti_load(va, ka, pa, ln); asm volatile("" ::: "memory");
                  ti_finish(vb, kb, pb, scr, ln); it = itn; if (it >= NITEMS) break; }
            }
          }
        }
        for (int m = gw; m < S; m += NGW) {
            const GAS f32x4* xr = (const GAS f32x4*)(x_in + (size_t)m * DM) + ((int)threadIdx.x & 63);
            GAS unsigned long long* o8 = (GAS unsigned long long*)(XB + (size_t)m * DM) + ((int)threadIdx.x & 63);
            float ss = 0.f;
#pragma unroll
            for (int j = 0; j < 16; ++j) { const f32x4 v = xr[64 * j]; ss += (v.x * v.x + v.y * v.y) + (v.z * v.z + v.w * v.w);
                o8[64 * j] = IN_F16 ? ((unsigned long long)pk2h(v.x, v.y) | ((unsigned long long)pk2h(v.z, v.w) << 32)) : ((unsigned long long)pk2(v.x, v.y) | ((unsigned long long)pk2(v.z, v.w) << 32));
                if (INP_F8) { int e0 = __builtin_amdgcn_cvt_pk_fp8_f32(v.x, v.y, 0, false); e0 = __builtin_amdgcn_cvt_pk_fp8_f32(v.z, v.w, e0, true); ((GAS int*)(ws + WS_XB8 + (size_t)m * DM))[64 * j + ((int)threadIdx.x & 63)] = e0; } }
            ss = wave_sum(ss);
            PART[(size_t)m * 64 + ((int)threadIdx.x & 63)] = ((int)threadIdx.x & 63) == 0 ? ss : 0.f;
        }
        for (int i = blockIdx.x * 512 + ((int)threadIdx.x); i < 128 * 32; i += F.G * 512) {
            const int p = i >> 5, k = i & 31;
            double inv = 1.0; for (int q = 0; q < k; ++q) inv *= 0.7498942093324558;
            const double ang = (double)p * inv, n = __builtin_rint(ang * 0.6366197723675814);
            double r = __builtin_fma(-n, 1.5707963267948966, ang); r = __builtin_fma(-n, 6.123233995736766e-17, r);
            const double r2 = r * r;
            double sp = 2.8114572543455206e-15; sp = sp * r2 - 7.647163731819816e-13; sp = sp * r2 + 1.6059043836821613e-10; sp = sp * r2 - 2.505210838544172e-08; sp = sp * r2 + 2.7557319223985893e-06;
            sp = sp * r2 - 0.0001984126984126984; sp = sp * r2 + 0.008333333333333333; sp = sp * r2 - 0.16666666666666666; sp = sp * r2 + 1.0; sp *= r;
            double cp = 1.5619206968586225e-16; cp = cp * r2 - 4.779477332387385e-14; cp = cp * r2 + 1.1470745597729725e-11; cp = cp * r2 - 2.08767569878681e-09; cp = cp * r2 + 2.755731922398589e-07;
            cp = cp * r2 - 2.48015873015873e-05; cp = cp * r2 + 0.001388888888888889; cp = cp * r2 - 0.041666666666666664; cp = cp * r2 + 0.5; cp = 1.0 - cp * r2;
            const int q4 = (int)n & 3;
            const double cv = q4 == 0 ? cp : (q4 == 1 ? -sp : (q4 == 2 ? -cp : sp)), sv = q4 == 0 ? sp : (q4 == 1 ? cp : (q4 == 2 ? -sp : -cp));
            ROPE[2 * i] = (float)cv; ROPE[2 * i + 1] = (float)sv;
        }
      }
    }
    SEAM(0);

    int grp_ticket = 0, my_pm = 0;
    for (int L = 0; L < DEPTH; ++L) {
        const int e = L >> 1; const bool even = (L & 1) == 0;
        const int NIN = even ? NIN_E : NIN_O;
        const int pb = 1 + 4 * L;
        CLK_BEGIN(pb);
        if (IN(pb)) {
            const bf16* Wt = (const bf16*)(ws + (even ? WS_WIN_E + e * WIN_E_BYTES : WS_WIN_O + e * WIN_O_BYTES));
            pg8::Gemm g{XB, Wt, S, NIN, DM}; pg8::StaticOrder So; So.init(S, NIN, F.G, (int)blockIdx.x);
            LAS float* rstd = (LAS float*)(F.lds + RSTD_OFF);
            { pg8::Unit u0; So.next(0, u0);
                int t_ = ((int)threadIdx.x); asm volatile("" : "+v"(t_));
                const f32x4* pp = (const f32x4*)(PART + (size_t)(u0.pm * 256 + (t_ >> 1)) * 64 + (t_ & 1) * 32);
                f32x4 a = pp[0] + pp[1], b = pp[2] + pp[3], c = pp[4] + pp[5], d = pp[6] + pp[7]; a = (a + b) + (c + d);
                float s = (a[0] + a[1]) + (a[2] + a[3]); s += __shfl_xor(s, 1);
                if (!(t_ & 1)) rstd[t_ >> 1] = 1.0f / sqrtf(s * (1.0f / DM) + NORM_EPS);
                __syncthreads(); }
            pg8::EpiIn E{Z, even ? NIN_E : ZP_O, rstd, att::SCALE * att::LOG2E, even ? 0 : O_K / 256, KVB, HM_ALL ? (even ? E_QB / 256 : 0) : (even ? E_KB / 256 : O_K / 256), HM_ALL ? (even ? NIN_E / 256 : NIN_O / 256) : (even ? E_G / 256 : O_G / 256)};
#ifndef NO_GEMM_IN
            if (even) {
                PanelOrder Po; { pg8::Unit u0; So.next(0, u0); Po.pm = u0.pm; Po.k = ((int)blockIdx.x & 1) * 4 + ((int)blockIdx.x >> 6); }
                { pg8::EpiInA E8{Z, NIN_E, rstd, 1.0f / W8_SCALE, args.in[4] + e * HD, args.in[5] + e * HD, ROPE, (LAS float*)(F.lds + NRP_OFF), att::SCALE * att::LOG2E, ws + WS_Q8, ws + WS_K8, PV_F8 ? ws + WS_VT8 : nullptr, S};
                  pg8::Gemm g8{(const bf16*)(ws + WS_XB8), (const bf16*)(ws + WS_W8 + e * W8_BYTES), S, (int)W8_ROWS, DM / 2};
                  Po.f8 = 1; pg8::gemm_phase<pg8::EpiInA, PanelOrder, GEMM_ALIGN, GEMM_SP2, true>(F.lds + RING_OFF, g8, Po, E8); }
                Po.f8 = 0; pg8::gemm_phase<pg8::EpiIn, PanelOrder, GEMM_ALIGN, GEMM_SP2, false, 0, IN_F16 != 0>(F.lds + RING_OFF, g, Po, E);
                LAS float* scr = (LAS float*)(F.lds + RING_OFF + F.wave * 16384);
                constexpr int I_INO = 64 * (NIN_O / 64), SH_LO = CONV_SH_LO, SH_HI = CONV_SH_HI, PER_PANEL = I_INO / (S / 256);
                int ln = ((int)threadIdx.x & 63); asm volatile("" : "+v"(ln));
                constexpr int PER_LO = PER_PANEL * SH_LO / (4 * (SH_LO + SH_HI)), PER_HI = (PER_PANEL - 4 * PER_LO) / 4;
                const int i0 = Po.pm * PER_PANEL + (Po.k < 4 ? Po.k * PER_LO : 4 * PER_LO + (Po.k - 4) * PER_HI), i1 = i0 + (Po.k < 4 ? PER_LO : PER_HI);
                for (int it = i0 + F.wave; it < i1; it += NWAVES)
                    transpose_item(args.in[7] + (size_t)e * DM * NIN_O, NIN_O, args.in[1] + (2 * e + 1) * DM, (bf16*)(ws + WS_WIN_O + e * WIN_O_BYTES), scr, it, ln, 0, nullptr, 0, 0, IN_F16 != 0);
            } else {
            _Pragma("nounroll") for (int rep = 0; rep < REP_IN; ++rep)
            pg8::gemm_phase<pg8::EpiIn, pg8::StaticOrder, GEMM_ALIGN, GEMM_SP2, false, 0, IN_F16 != 0>(F.lds + RING_OFF, g, So, E);
            }
#endif
        }
        CLK_END(pb);
        SEAM(pb);
        CLK_BEGIN(pb + 2);
        if (IN(pb + 2)) {
            const int xcd = (int)blockIdx.x & 7, slot = (int)blockIdx.x >> 3;
            char* al = (char*)lds + RING_OFF;
            if (even) {
                float dense_nm;
                { const float* qw = args.in[4] + e * HD; const float* kw = args.in[5] + e * HD; int ln_ = (int)threadIdx.x & 63; asm volatile("" : "+v"(ln_));
                  float mq = fmaxf(fabsf(qw[ln_]), fabsf(qw[64 + ln_])), mk = fmaxf(fabsf(kw[ln_]), fabsf(kw[64 + ln_]));
#pragma unroll
                  for (int o_ = 1; o_ < 64; o_ <<= 1) { mq = fmaxf(mq, __shfl_xor(mq, o_)); mk = fmaxf(mk, __shfl_xor(mk, o_)); }
                  dense_nm = __builtin_amdgcn_readfirstlane(-(att::LOG2E * 11.313708498984761f * 1.01f) * mq * mk); }
#if CONV_SLOTS
                const int nd = (512 + F.G - 1) / F.G, cgrp = ((int)blockIdx.x >> 3) & 3;
                _Pragma("nounroll") for (int st = 0; st < 2 * nd; ++st) {
                    if (L == 0 && st == (cgrp < 2 * nd ? cgrp : 2 * nd - 1)) {
                        constexpr int I_INE = 64 * (NIN_E / 64), I_OUT = 64 * (DM / 64), NDEF = I_INE + 4 * I_OUT;
                        auto def_item = [&](int d) __attribute__((always_inline)) -> ItemP {
                            int r = d;
                            if (r < I_INE) return ItemP{args.in[2] + (size_t)DM * NIN_E, NIN_E, args.in[1] + 2 * DM, (bf16*)(ws + WS_WIN_E + WIN_E_BYTES), r, E_VA, ws + WS_W8 + W8_BYTES, INP_F8 ? (int)W8_ROWS : 0, 0, IN_F16 != 0};
                            r -= I_INE;
                            if (r < I_OUT) return ItemP{args.in[3] + (size_t)DM * DM, DM, nullptr, (bf16*)(ws + WS_WOUT_E + WOUT_BYTES), r, 0, nullptr, 0, OUT_F8 ? 2048 : 0, 0};
                            r -= I_OUT;
                            if (r < I_OUT) return ItemP{args.in[8] + (size_t)DM * DM, DM, nullptr, (bf16*)(ws + WS_WOUT_O + WOUT_BYTES), r, 0, nullptr, 0, 0, 0};
                            r -= I_OUT;
                            if (r < I_OUT) return ItemP{args.in[3], DM, nullptr, (bf16*)(ws + WS_WOUT_E), r, 0, nullptr, 0, OUT_F8 ? 2048 : 0, 0};
                            r -= I_OUT;
                            return ItemP{args.in[8], DM, nullptr, (bf16*)(ws + WS_WOUT_O), r, 0, nullptr, 0, 0, 0};
                        };
                        const int per = (NDEF + F.G - 1) / F.G, d0 = (int)blockIdx.x * per, d1 = d0 + per < NDEF ? d0 + per : NDEF;
                        LAS float* scr = (LAS float*)(F.lds + RING_OFF + F.wave * 16384);
                        int ln = ((int)threadIdx.x & 63); asm volatile("" : "+v"(ln));
                        __syncthreads();
                        int it = d0 + F.wave;
                        if (it < d1) {
                            f32x4 va[16], vb[16], ka[2], kb[2];
                            ItemP pa = def_item(it), pb = pa;
                            ti_load(va, ka, pa, ln);
                            for (;;) {
                                { const int itn = it + NWAVES; pb = def_item(itn < d1 ? itn : d1 - 1); ti_load(vb, kb, pb, ln); asm volatile("" ::: "memory");
                                  ti_finish(va, ka, pa, scr, ln); it = itn; if (it >= d1) break; }
                                { const int itn = it + NWAVES; pa = def_item(itn < d1 ? itn : d1 - 1); ti_load(va, ka, pa, ln); asm volatile("" ::: "memory");
                                  ti_finish(vb, kb, pb, scr, ln); it = itn; if (it >= d1) break; }
                            }
                        }
                        __syncthreads();
                    }
                    const int u = (int)blockIdx.x + (st < nd ? st : st - nd) * F.G;
                    if (u >= 512) continue;
                    if (st < nd) {
                        const int h = (u / 256) * 8 + (u & 7), qb = (u & 255) >> 3, kvh = h >> 2;
                        const bf16* Zq = Z + (size_t)(qb * 256) * NIN_E;
                        DENSE_CALL(Zq + E_QA + h * HD, Z + E_KA + kvh * HD, Z + E_VA + kvh * HD, Zq + E_G + h * HD, Y + (size_t)(qb * 256) * DM + h * HD);
                    } else {
                        const int h = (u / 256) * 8 + (u & 7), blk = (u & 255) >> 3;
                        const int r0 = 4 * blk, rw = r0 + (F.wave >> 1);
                        int jlo = r0 - 4; jlo = jlo < 0 ? 0 : (jlo > 120 ? 120 : jlo);
                        int jh = r0 + 3 - 4; jh = jh < 0 ? 0 : (jh > 120 ? 120 : jh); jh += 8;
                        int wlo = rw - 4; wlo = wlo < 0 ? 0 : (wlo > 120 ? 120 : wlo);
                        const bf16* Zq = Z + (size_t)(blk * 256) * NIN_E; (void)Zq;
                    att::local_unit<1, HM_ALL ? HD : NIN_E, false, 128>(HM_ALL ? KVB + ((size_t)h * S + blk * 256) * HD : Zq + E_QB + h * HD, KVB + (size_t)((HM_ALL ? 16 : 0) + h) * S * HD, KVB + (size_t)((HM_ALL ? 32 : 16) + h) * S * HD, HM_ALL ? KVB + ((size_t)(64 + h) * S + blk * 256) * HD : Zq + E_G + 2048 + h * HD, Y + (size_t)(blk * 256) * DM + 2048 + h * HD, al,
                                              jlo, jh, wlo, wlo + 8, rw, 0.f, 0.f, args.in[6] + ((size_t)e * 16 + h) * 465, (NA_ROT && jh - jlo == 12) ? (12 - jlo % 12) % 12 : 0);
                    }
                }
#else
                _Pragma("nounroll") for (int rep = 0; rep < REP_DENSE; ++rep)
                for (int u = (int)blockIdx.x; u < 512; u += F.G) {
                    const int h = (u / 256) * 8 + (u & 7), qb = (u & 255) >> 3, kvh = h >> 2;
                    const bf16* Zq = Z + (size_t)(qb * 256) * NIN_E;
#ifndef NO_DENSE
                    DENSE_CALL(Zq + E_QA + h * HD, Z + E_KA + kvh * HD, Z + E_VA + kvh * HD, Zq + E_G + h * HD, Y + (size_t)(qb * 256) * DM + h * HD);
#endif
                }
#if defined(PROBE_DENSE_VAR)
                if (L == 0) for (int u = (int)blockIdx.x; u < 512; u += F.G) {
                    const int h = (u / 256) * 8 + (u & 7), qb = (u & 255) >> 3, kvh = h >> 2;
                    const bf16* Zq = Z + (size_t)(qb * 256) * NIN_E;
                    att::dense_unit_pp<NIN_E, PROBE_DENSE_VAR>(Zq + E_QA + h * HD, Z + E_KA + kvh * HD, Z + E_VA + kvh * HD, Zq + E_G + h * HD, (bf16*)(ws + 900 * MiB) + (size_t)(qb * 256) * DM + h * HD, S / 64, al);
                }
#endif
                _Pragma("nounroll") for (int rep = 0; rep < REP_LOCAL * REP_NA; ++rep)
                for (int u = (int)blockIdx.x; u < 512; u += F.G) {
                    const int h = (u / 256) * 8 + (u & 7), blk = (u & 255) >> 3;
                    const int r0 = 4 * blk, rw = r0 + (F.wave >> 1);
                    int jlo = r0 - 4; jlo = jlo < 0 ? 0 : (jlo > 120 ? 120 : jlo);
                    int jh = r0 + 3 - 4; jh = jh < 0 ? 0 : (jh > 120 ? 120 : jh); jh += 8;
                    int wlo = rw - 4; wlo = wlo < 0 ? 0 : (wlo > 120 ? 120 : wlo);
                    const bf16* Zq = Z + (size_t)(blk * 256) * NIN_E;
#ifndef NO_NA
                    att::local_unit<1, HM_ALL ? HD : NIN_E, false, 128>(HM_ALL ? KVB + ((size_t)h * S + blk * 256) * HD : Zq + E_QB + h * HD, KVB + (size_t)((HM_ALL ? 16 : 0) + h) * S * HD, KVB + (size_t)((HM_ALL ? 32 : 16) + h) * S * HD, HM_ALL ? KVB + ((size_t)(64 + h) * S + blk * 256) * HD : Zq + E_G + 2048 + h * HD, Y + (size_t)(blk * 256) * DM + 2048 + h * HD, al,
                                              jlo, (rep < NA_HALF_REPS) ? jlo + (jh - jlo) / NA_HALF_DIV : jh, wlo, wlo + 8, rw, 0.f, 0.f, args.in[6] + ((size_t)e * 16 + h) * 465, (NA_ROT && jh - jlo == 12 && rep >= NA_HALF_REPS) ? (12 - jlo % 12) % 12 : 0);
#endif
                }
#endif
                (void)xcd; (void)slot;
            } else {
                _Pragma("nounroll") for (int rep = 0; rep < REP_LOCAL; ++rep)
#if WIN_GQA
#if defined(PROBE_WIN_VAR)
                for (int u = (int)blockIdx.x; u < 1024; u += F.G) {
                    const int kvh = u & 7, qblk = (u & 255) >> 3 | (u >> 8) << 5, q0 = qblk * 64, h = kvh * 4 + (F.wave >> 1), q0w = q0 + 32 * (F.wave & 1);
                    int klo = q0 - 128; klo = klo < 0 ? 0 : klo; int khi = q0 + 64 + 128; khi = khi > S ? S : khi;
                    int wl = q0w - 128; wl = wl < 0 ? 0 : wl; int wh = q0w + 31 + 128; wh = wh > S - 1 ? S - 1 : wh;
                    const float slope = exp2f(-8.0f * (float)(h + 1) / 32.0f);
                    const bf16* Zq = Z + (size_t)q0w * ZP_O;
                    att::local_unit<2, HD, true, 128, PROBE_WIN_VAR>(KVB + ((size_t)h * S + q0w) * HD, KVB + (size_t)(32 + kvh) * S * HD, KVB + (size_t)(40 + kvh) * S * HD, KVB + ((size_t)(48 + h) * S + q0w) * HD, (bf16*)(ws + 1100 * MiB) + (size_t)q0w * DM + h * HD, al,
                                              klo >> 6, khi >> 6, wl >> 6, (wh >> 6) + 1, q0w, slope * att::LOG2E, args.in[9][e * 32 + h] * att::LOG2E, nullptr, (WIN_ROT && (khi - klo) >> 6 == 5) ? (5 - (klo >> 6) % 5) % 5 : 0);
                }
#endif
                for (int u = (int)blockIdx.x; u < 1024; u += F.G) {
                    const int kvh = u & 7, qblk = (u & 255) >> 3 | (u >> 8) << 5, q0 = qblk * 64, h = kvh * 4 + (F.wave >> 1), q0w = q0 + 32 * (F.wave & 1);
                    int klo = q0 - 128; klo = klo < 0 ? 0 : klo; int khi = q0 + 64 + 128; khi = khi > S ? S : khi;
                    int wl = q0w - 128; wl = wl < 0 ? 0 : wl; int wh = q0w + 31 + 128; wh = wh > S - 1 ? S - 1 : wh;
                    const float slope = exp2f(-8.0f * (float)(h + 1) / 32.0f);
                    const bf16* Zq = Z + (size_t)q0w * ZP_O;
#ifndef NO_WIN
                    att::local_unit<2, HM_ALL ? HD : ZP_O, true, 128>(HM_ALL ? KVB + ((size_t)h * S + q0w) * HD : Zq + O_Q + h * HD, KVB + (size_t)((HM_ALL ? 32 : 0) + kvh) * S * HD, KVB + (size_t)((HM_ALL ? 40 : 8) + kvh) * S * HD, HM_ALL ? KVB + ((size_t)(48 + h) * S + q0w) * HD : Zq + O_G + h * HD, Y + (size_t)q0w * DM + h * HD, al,
                                              klo >> 6, khi >> 6, wl >> 6, (wh >> 6) + 1, q0w, slope * att::LOG2E, args.in[9][e * 32 + h] * att::LOG2E, nullptr, (WIN_ROT && (khi - klo) >> 6 == 5) ? (5 - (klo >> 6) % 5) % 5 : 0);
#endif
                }
#else
                for (int u = (int)blockIdx.x; u < 1024; u += F.G) {
                    const int h = (u / 256) * 8 + (u & 7), qb = (u & 255) >> 3, kvh = h >> 2, i0 = qb * 256, q0 = i0 + F.wave * 32;
                    int klo = i0 - 128; klo = klo < 0 ? 0 : klo; int khi = i0 + 256 + 128; khi = khi > S ? S : khi;
                    int wl = q0 - 128; wl = wl < 0 ? 0 : wl; int wh = q0 + 31 + 128; wh = wh > S - 1 ? S - 1 : wh;
                    const float slope = exp2f(-8.0f * (float)(h + 1) / 32.0f);
                    const bf16* Zq = Z + (size_t)i0 * ZP_O;
#ifndef NO_WIN
                    att::local_unit<2, ZP_O>(Zq + O_Q + h * HD, Z + O_K + kvh * HD, Z + O_V + kvh * HD, Zq + O_G + h * HD, Y + (size_t)i0 * DM + h * HD, al,
                                              klo >> 6, khi >> 6, wl >> 6, (wh >> 6) + 1, i0, slope * att::LOG2E, args.in[9][e * 32 + h] * att::LOG2E, nullptr);
#endif
                }
#endif
            }
        }
        CLK_END(pb + 2);
        SEAM(pb + 2);
        CLK_BEGIN(pb + 3);
        if (IN(pb + 3)) {
            const bf16* Wt = (const bf16*)(ws + (even ? WS_WOUT_E : WS_WOUT_O) + e * WOUT_BYTES);
            pg8::Gemm g{Y, Wt, S, DM, DM}; pg8::StaticOrder So; So.init(S, DM, F.G, (int)blockIdx.x);
            const bool oldb = L > 0 && ((RES_F16 >> (L - 1)) & 1), newf = !((RES_F16 >> L) & 1);
            bf16* xbo = (L == DEPTH - 1 || IN_F16) ? nullptr : XB; float* parto = L == DEPTH - 1 ? nullptr : PART;
            unsigned char* xb8o = (INP_F8 && L == 1) ? ws + WS_XB8 : nullptr;
#ifndef NO_GEMM_OUT
#define OUT_CASE(OB, NF) if (oldb == OB && newf == NF) { \
              if constexpr (res_combo(OB, NF, 0)) { if (even) { pg8::EpiOutT<OB, NF> E{L == 0 ? x_in : X, X, xbo, parto, xb8o, XH}; \
                if (OUT_F8) pg8::gemm_phase<pg8::EpiOutT<OB, NF>, pg8::StaticOrder, GEMM_ALIGN_OUT, GEMM_SP2, false, 16>(F.lds + RING_OFF, g, So, E, 1.0f / (att::Y8_SCALE * W8_SCALE)); \
                else pg8::gemm_phase<pg8::EpiOutT<OB, NF>, pg8::StaticOrder, GEMM_ALIGN_OUT, GEMM_SP2>(F.lds + RING_OFF, g, So, E); } } \
              if constexpr (res_combo(OB, NF, 1)) { if (!even) { pg8::EpiOutT<OB, NF> E{L == 0 ? x_in : X, X, xbo, parto, xb8o, XH}; \
                pg8::gemm_phase<pg8::EpiOutT<OB, NF>, pg8::StaticOrder, GEMM_ALIGN_OUT, GEMM_SP2>(F.lds + RING_OFF, g, So, E); } } }
            OUT_CASE(false, true) OUT_CASE(false, false) OUT_CASE(true, true) OUT_CASE(true, false)
#undef OUT_CASE
#endif
        }
#if defined(PROBE_OUT_LIGHT)
        if (IN(pb + 3) && L == 0) { const bf16* Wt = (const bf16*)(ws + WS_WOUT_E);
            pg8::Gemm g{Y, Wt, S, DM, DM}; pg8::StaticOrder So; So.init(S, DM, F.G, (int)blockIdx.x);
            pg8::EpiLight E{(bf16*)(ws + 900 * MiB)};
            pg8::gemm_phase<pg8::EpiLight, pg8::StaticOrder, GEMM_ALIGN, GEMM_SP2>(F.lds + RING_OFF, g, So, E); }
#endif
        CLK_END(pb + 3);
#if !GROUP_SYNC
        SEAM(pb + 3);
#else
        if (IN(pb + 3) && IN(pb + 4)) {
            pg8::StaticOrder So; So.init(S, DM, F.G, (int)blockIdx.x); pg8::Unit u0; So.next(0, u0); my_pm = u0.pm;
            grp_ticket = (int)group_sync(F.ctl + CW_GRP + (L * 32 + u0.pm) * 64, (unsigned)(F.G / (S / 256)), (unsigned*)(F.ctl + CW_BAR) + XB_TMO, F.MISC + 12);
        }
#endif
    }
    if (IN(PH_FINAL)) {
        const float* fw = args.in[10]; const int per = 256 / (F.G / (S / 256)), ln = (int)threadIdx.x & 63;
#if GROUP_SYNC
        for (int i = F.wave; i < per; i += NWAVES) { const int m = my_pm * 256 + grp_ticket * per + i;
#else
        (void)per; (void)my_pm; (void)grp_ticket;
        for (int m = gw; m < S; m += NGW) {
#endif
            GAS f32x4* xr = (GAS f32x4*)(X + (size_t)m * DM) + ln;
            f32x4 v[16]; float ss = 0.f;
            if ((RES_F16 >> (DEPTH - 1)) & 1) {
                const GAS v4u* xb = (const GAS v4u*)(XH + (size_t)m * DM) + ln;
#pragma unroll
                for (int j = 0; j < 8; ++j) { const v4u t = xb[64 * j];
                    v[2 * j] = f32x4{pg8::h_lo(t.x), pg8::h_hi(t.x), pg8::h_lo(t.y), pg8::h_hi(t.y)};
                    v[2 * j + 1] = f32x4{pg8::h_lo(t.z), pg8::h_hi(t.z), pg8::h_lo(t.w), pg8::h_hi(t.w)}; }
#pragma unroll
                for (int j = 0; j < 16; ++j) ss += (v[j].x * v[j].x + v[j].y * v[j].y) + (v[j].z * v[j].z + v[j].w * v[j].w);
                const float rs = 1.0f / sqrtf(wave_sum(ss) * (1.0f / DM) + NORM_EPS);
                GAS f32x4* xo = (GAS f32x4*)(X + (size_t)m * DM) + 2 * ln;
#pragma unroll
                for (int j = 0; j < 16; ++j) { const f32x4 w = ((const f32x4*)fw)[128 * (j >> 1) + 2 * ln + (j & 1)]; xo[128 * (j >> 1) + (j & 1)] = v[j] * rs * w; }
                continue;
            }
#pragma unroll
            for (int j = 0; j < 16; ++j) { v[j] = xr[64 * j]; ss += (v[j].x * v[j].x + v[j].y * v[j].y) + (v[j].z * v[j].z + v[j].w * v[j].w); }
            const float rs = 1.0f / sqrtf(wave_sum(ss) * (1.0f / DM) + NORM_EPS);
#pragma unroll
            for (int j = 0; j < 16; ++j) { const f32x4 w = ((const f32x4*)fw)[64 * j + ln]; xr[64 * j] = v[j] * rs * w; }
        }
    }
#if defined(DIAG_PHT)
    if (blockIdx.x == 0 && ((int)threadIdx.x) == 0) { const unsigned long long dt = pht * DIAG_PHT_K, t0_ = __builtin_amdgcn_s_memrealtime();
        while (__builtin_amdgcn_s_memrealtime() - t0_ < dt) __builtin_amdgcn_s_sleep(32); }
#elif defined(DIAG_CLK)
    if (blockIdx.x == 0 && ((int)threadIdx.x) == 0) { const unsigned long long mhz = (clk_m * 100ull) / (clk_r ? clk_r : 1ull);
        const unsigned long long dt = mhz * 50ull, t0_ = __builtin_amdgcn_s_memrealtime();
        while (__builtin_amdgcn_s_memrealtime() - t0_ < dt) __builtin_amdgcn_s_sleep(32); }
#endif
#if defined(DIAG_IDLE)
    if (((int)threadIdx.x) == 0) { atomicAdd((unsigned long long*)(F.ctl + 2048), idle_acc); atomicAdd((unsigned long long*)(F.ctl + 2048 + 64 + 64 * (bar.x & 7u)), idle_acc); }
    xcd_barrier(bar);
    if (blockIdx.x == 0 && ((int)threadIdx.x) == 0) { const unsigned long long tot = __hip_atomic_load((unsigned long long*)(F.ctl + 2048), __ATOMIC_RELAXED, __HIP_MEMORY_SCOPE_AGENT);
#if defined(DIAG_XCD_SPREAD)
        unsigned long long mx = 0, mnv = ~0ull; for (int j = 0; j < 8; ++j) { const unsigned long long v = __hip_atomic_load((unsigned long long*)(F.ctl + 2048 + 64 + 64 * j), __ATOMIC_RELAXED, __HIP_MEMORY_SCOPE_AGENT); mx = v > mx ? v : mx; mnv = v < mnv ? v : mnv; }
#if defined(DIAG_XCD_ARGMIN)
        int amin = 0; for (int j = 0; j < 8; ++j) { const unsigned long long v = __hip_atomic_load((unsigned long long*)(F.ctl + 2048 + 64 + 64 * j), __ATOMIC_RELAXED, __HIP_MEMORY_SCOPE_AGENT); if (v == mnv) amin = j; }
        const unsigned long long dt = (unsigned long long)(amin + 1) * 10000ull, t0_ = __builtin_amdgcn_s_memrealtime();
#else
        const unsigned long long dt = ((mx - mnv) / (unsigned long long)(F.G / 8)) * DIAG_K, t0_ = __builtin_amdgcn_s_memrealtime();
#endif
#else
        const unsigned long long dt = (tot / (unsigned long long)F.G) * DIAG_K, t0_ = __builtin_amdgcn_s_memrealtime();
#endif
        while (__builtin_amdgcn_s_memrealtime() - t0_ < dt) __builtin_amdgcn_s_sleep(32); }
#endif
#undef IN
#undef SEAM
}

#ifndef MK_SPLIT
#define MK_SPLIT 0
#endif
extern "C" void kernel_launch(void* const* d_in, const int* in_sizes, int n_in, void* d_out, int out_size, void* d_ws, size_t ws_size, hipStream_t stream) {
    static int grid = 0;
    if (grid == 0) {
        if (n_in != 11 || in_sizes[0] != S * DM || out_size != S * DM || ws_size < WS_END) {
            fprintf(stderr, "kernel_launch: shape mismatch: n_in %d in0 %d out %d ws %zu (need %zu)\n", n_in, n_in > 0 ? in_sizes[0] : -1, out_size, ws_size, (size_t)WS_END); grid = -1; return; }
        int dev = 0, cus = 0, per_cu = 0;
        if (hipGetDevice(&dev) != hipSuccess || hipDeviceGetAttribute(&cus, hipDeviceAttributeMultiprocessorCount, dev) != hipSuccess) { grid = -1; return; }
        if (hipFuncSetAttribute((const void*)mk_fwd, hipFuncAttributeMaxDynamicSharedMemorySize, LDS_BYTES) != hipSuccess) { fprintf(stderr, "kernel_launch: hipFuncSetAttribute failed\n"); grid = -1; return; }
        if (hipOccupancyMaxActiveBlocksPerMultiprocessor(&per_cu, (const void*)mk_fwd, NWAVES * 64, LDS_BYTES) != hipSuccess || per_cu < 1)
            fprintf(stderr, "kernel_launch: note: occupancy query reports %d workgroups per CU\n", per_cu);
        (void)hipGetLastError();
        grid = cus;
        if (grid % (S / 256) != 0 || 256 % (grid / (S / 256)) != 0) { fprintf(stderr, "kernel_launch: grid %d does not split into equal panel groups; nothing launched\n", grid); grid = -1; return; }
        { int cntp[S / 256] = {0};
            for (int c = 0; c < grid; ++c) { pg8::StaticOrder A_, B_, C_; A_.init(S, NIN_E, grid, c); B_.init(S, NIN_O, grid, c); C_.init(S, DM, grid, c); pg8::Unit a, b, d; A_.next(0, a); B_.next(0, b); C_.next(0, d);
                if (a.pm != d.pm || b.pm != d.pm) { fprintf(stderr, "kernel_launch: workgroup %d owns different row panels in different GEMMs; nothing launched\n", c); grid = -1; return; } ++cntp[d.pm]; }
            for (int p = 0; p < S / 256; ++p) if (cntp[p] != grid / (S / 256)) { fprintf(stderr, "kernel_launch: panel %d has %d owners; nothing launched\n", p, cntp[p]); grid = -1; return; } }
        { const int Ns[3] = {NIN_E, NIN_O, DM};
            for (int k = 0; k < 3; ++k) for (int c = 0; c < grid; ++c) { pg8::StaticOrder So; So.init(S, Ns[k], grid, c); pg8::Unit u0, u; if (!So.next(0, u0)) continue;
                for (int i = 1; So.next(i, u); ++i) if (u.pm != u0.pm) { fprintf(stderr, "kernel_launch: unit order gives workgroup %d two row panels (N %d); nothing launched\n", c, Ns[k]); grid = -1; return; } } }
    }
    if (grid < 0) return;
    if (hipMemsetAsync((char*)d_ws + WS_CTL, 0, CTL_ZERO_BYTES, stream) != hipSuccess) { fprintf(stderr, "kernel_launch: memset failed\n"); return; }
    Args a{};
    for (int i = 0; i < 11; ++i) a.in[i] = (const float*)d_in[i];
    a.out = (float*)d_out; a.ws = (unsigned char*)d_ws;
#if MK_SPLIT
    for (int p = 0; p < PH_END; ++p) { a.ph_lo = p; a.ph_hi = p + 1; hipLaunchKernelGGL(mk_fwd, dim3(grid), dim3(NWAVES * 64), LDS_BYTES, stream, a); }
#else
    a.ph_lo = 0; a.ph_hi = PH_END;
    hipLaunchKernelGGL(mk_fwd, dim3(grid), dim3(NWAVES * 64), LDS_BYTES, stream, a);
#endif
    const hipError_t le = hipPeekAtLastError();
    if (le != hipSuccess) fprintf(stderr, "kernel_launch: launch failed: %s\n", hipGetErrorName(le));
}
```

```cpp
#ifndef GATEB_F8
#define GATEB_F8 1
#endif
#include <hip/hip_runtime.h>
#include <cstdio>
#include <cstdint>
namespace pg8 {
#define PG8_LAS __attribute__((address_space(3)))
typedef unsigned short bf16_t;
typedef short bf16x8 __attribute__((ext_vector_type(8)));
typedef float f32x4 __attribute__((ext_vector_type(4)));
typedef unsigned u32x4 __attribute__((ext_vector_type(4)));
constexpr int BM = 256, BK = 64, HALF = 128, HTB = HALF * BK * 2  , STAGE_BYTES = 8 * HTB, NXCD = 8, WGM = 8;

__host__ __device__ __forceinline__ int lds_byte(int r, int c) { const int st = (r >> 4) * 2 + (c >> 5), rr = r & 15, cc = c & 31, ob = rr * 64 + cc * 2; return st * 1024 + (ob ^ (((ob >> 9) & 1) << 5)); }
__host__ __device__ __forceinline__ void stage_rc(int b, int& R, int& C) { const int st = b / 1024, sb = b % 1024, swz = sb ^ (((sb >> 9) & 1) << 5); R = (st >> 1) * 16 + swz / 64; C = (st & 1) * 32 + (swz % 64) / 2; }
__host__ __device__ __forceinline__ int perm32(int rho) { const int n = rho >> 4, i = rho & 15; return 8 * (i >> 2) + 4 * n + (i & 3); }

struct Unit { int pm, pn; };
struct Gemm { const bf16_t* A; const bf16_t* Bt; int M, N, K; };

struct StaticOrder {
    int nM, nN, nwg, G, c;
    __host__ __device__ void init(int M, int N, int G_, int c_) { nM = M / BM; nN = N / BM; nwg = nM * nN; G = G_; c = c_; }
    __host__ __device__ bool next(int i, Unit& u) const {
        const long L = (long)i * G + c; if (L >= nwg) return false;
        int wgid = (int)L; { const int q = nwg / NXCD, r = nwg % NXCD, xcd = wgid % NXCD, off = wgid / NXCD; wgid = (xcd < r ? xcd * (q + 1) : r * (q + 1) + (xcd - r) * q) + off; }
        const int nig = WGM * nN, gid = wgid / nig, fm = gid * WGM, gsz = (nM - fm) < WGM ? (nM - fm) : WGM;
        u.pm = fm + ((wgid % nig) % gsz); u.pn = (wgid % nig) / gsz; return true;
    }
    __device__ __forceinline__ void a_ready(const Unit&) const {}
    __device__ __forceinline__ void done(const Unit&) const {}
};

__device__ __forceinline__ unsigned cvt_pk_bf16(float lo, float hi) { unsigned r; asm volatile("v_cvt_pk_bf16_f32 %0, %1, %2" : "=v"(r) : "v"(lo), "v"(hi)); return r; }
typedef float f32x2 __attribute__((ext_vector_type(2)));
#ifndef NT_Z
#define NT_Z 0
#endif
#ifndef NT_X
#define NT_X 0
#endif
#if NT_Z
#define ST_Z(p, v) __builtin_nontemporal_store((v), (p))
#else
#define ST_Z(p, v) (*(p) = (v))
#endif
#if NT_X
#define ST_X(p, v) __builtin_nontemporal_store((v), (p))
#else
#define ST_X(p, v) (*(p) = (v))
#endif
struct EpiIn {
    static constexpr bool PERM = true, AFTER_DRAIN = false;
    bf16_t* Z; int ldz; const PG8_LAS float* rstd; float qscale; int sc_tiles;
    bf16_t* kv; int kv_t0, kv_t1;
    __device__ __forceinline__ void operator()(const f32x4 (&acc)[2][2][4][2], const Unit& u, int wr, int wc, int fr, int fq) const {
        const float cs = u.pn < sc_tiles ? qscale : 1.0f;
        const bool tokv = u.pn >= kv_t0 && u.pn < kv_t1;
        char* base = tokv ? (char*)(kv + (size_t)(u.pn - kv_t0) * 2 * 8192 * 128) : (char*)(Z + u.pn * BM);
        const unsigned pitch = tokv ? 256u : (unsigned)ldz * 2u, bjs = tokv ? 8192u * 256u : (unsigned)HALF * 2u;
        const unsigned lane_off = (unsigned)(u.pm * BM + wr * 64 + fr) * pitch + (unsigned)(wc * 32 + 8 * fq) * 2u;
#pragma unroll
        for (int ai = 0; ai < 2; ++ai)
#pragma unroll
            for (int m = 0; m < 4; ++m) {
                const float rs = rstd[ai * HALF + wr * 64 + m * 16 + fr] * cs;
                char* rowp = base + (lane_off + (unsigned)(ai * HALF + m * 16) * pitch);
#pragma unroll
                for (int bj = 0; bj < 2; ++bj) { const f32x4 v0 = acc[ai][bj][m][0] * rs, v1 = acc[ai][bj][m][1] * rs;
                    u32x4 w; w.x = cvt_pk_bf16(v0[0], v0[1]); w.y = cvt_pk_bf16(v0[2], v0[3]); w.z = cvt_pk_bf16(v1[0], v1[1]); w.w = cvt_pk_bf16(v1[2], v1[3]);
                    ST_Z((u32x4*)(rowp + bj * bjs), w); }
            }
    }
};
struct EpiInA {
    static constexpr bool PERM = true, AFTER_DRAIN = false;
    bf16_t* Z; int ldz; const PG8_LAS float* rstd; float zmul;
    const float* qn; const float* kn; const float* rope; PG8_LAS float* P; float qscale; unsigned char* q8; unsigned char* k8; unsigned char* vt8; int vt_pitch;
    bf16_t* kv;
    __device__ __forceinline__ void operator()(const f32x4 (&acc)[2][2][4][2], const Unit& u, int wr, int wc, int fr_, int fq_) const {
        int fr = fr_, fq = fq_; asm volatile("" : "+v"(fr), "+v"(fq));
        const int row0 = u.pm * BM + wr * 64 + fr, col0 = (u.pn < 12 ? u.pn * BM : 9216 + (u.pn - 12) * BM) + wc * 32 + 8 * fq;
        const PG8_LAS float* rsp = rstd + wr * 64 + fr;
#define RS_(ai, m) (rsp[(ai) * HALF + (m) * 16] * zmul)
        if (vt8 && (u.pn == 10 || u.pn == 11)) {
            const int c0 = (u.pn - 10) * BM + wc * 32 + 8 * fq;
#pragma unroll
            for (int ai = 0; ai < 2; ++ai)
#pragma unroll
                for (int m = 0; m < 4; ++m) { const float r_ = RS_(ai, m); const int row = row0 + ai * HALF + m * 16;
#pragma unroll
                    for (int bj = 0; bj < 2; ++bj) { const f32x4 v0 = acc[ai][bj][m][0] * r_, v1 = acc[ai][bj][m][1] * r_;
                        int e0 = __builtin_amdgcn_cvt_pk_fp8_f32(v0[0], v0[1], 0, false); e0 = __builtin_amdgcn_cvt_pk_fp8_f32(v0[2], v0[3], e0, true);
                        int e1 = __builtin_amdgcn_cvt_pk_fp8_f32(v1[0], v1[1], 0, false); e1 = __builtin_amdgcn_cvt_pk_fp8_f32(v1[2], v1[3], e1, true);
                        unsigned char* dp = vt8 + (size_t)(c0 + bj * HALF) * vt_pitch + row;
                        dp[0] = (unsigned char)e0; dp[vt_pitch] = (unsigned char)(e0 >> 8); dp[2 * (size_t)vt_pitch] = (unsigned char)(e0 >> 16); dp[3 * (size_t)vt_pitch] = (unsigned char)((unsigned)e0 >> 24);
                        dp[4 * (size_t)vt_pitch] = (unsigned char)e1; dp[5 * (size_t)vt_pitch] = (unsigned char)(e1 >> 8); dp[6 * (size_t)vt_pitch] = (unsigned char)(e1 >> 16); dp[7 * (size_t)vt_pitch] = (unsigned char)((unsigned)e1 >> 24); } }
#if GATEB_F8
        } else if (u.pn >= 20) {
            bf16_t* hb = kv + (size_t)(64 + (u.pn - 20) * 2) * 8192 * 128;
#pragma unroll
            for (int ai = 0; ai < 2; ++ai)
#pragma unroll
                for (int m = 0; m < 4; ++m) {
                    bf16_t* rowp = hb + (unsigned)((row0 + ai * HALF + m * 16) * 128 + wc * 32 + 8 * fq);
                    const float r_ = RS_(ai, m);
#pragma unroll
                    for (int bj = 0; bj < 2; ++bj) { const f32x4 v0 = acc[ai][bj][m][0] * r_, v1 = acc[ai][bj][m][1] * r_;
                        u32x4 w; w.x = cvt_pk_bf16(v0[0], v0[1]); w.y = cvt_pk_bf16(v0[2], v0[3]); w.z = cvt_pk_bf16(v1[0], v1[1]); w.w = cvt_pk_bf16(v1[2], v1[3]);
                        ST_Z((u32x4*)(rowp + bj * (8192 * 128)), w); }
                }
#endif
        } else if (u.pn >= 10) {
#pragma unroll
            for (int ai = 0; ai < 2; ++ai)
#pragma unroll
                for (int m = 0; m < 4; ++m) {
                    bf16_t* rowp = Z + (size_t)(row0 + ai * HALF + m * 16) * ldz + col0;
                    const float r_ = RS_(ai, m);
#pragma unroll
                    for (int bj = 0; bj < 2; ++bj) { const f32x4 v0 = acc[ai][bj][m][0] * r_, v1 = acc[ai][bj][m][1] * r_;
                        u32x4 w; w.x = cvt_pk_bf16(v0[0], v0[1]); w.y = cvt_pk_bf16(v0[2], v0[3]); w.z = cvt_pk_bf16(v1[0], v1[1]); w.w = cvt_pk_bf16(v1[2], v1[3]);
                        ST_Z((u32x4*)(rowp + bj * HALF), w); }
                }
        } else {
#pragma unroll
            for (int ai = 0; ai < 2; ++ai)
#pragma unroll
                for (int m = 0; m < 4; ++m) { const float r_ = RS_(ai, m);
#pragma unroll
                    for (int bj = 0; bj < 2; ++bj) { const f32x4 a = acc[ai][bj][m][0] * r_, b = acc[ai][bj][m][1] * r_;
                        float ss = ((a[0] * a[0] + a[1] * a[1]) + (a[2] * a[2] + a[3] * a[3])) + ((b[0] * b[0] + b[1] * b[1]) + (b[2] * b[2] + b[3] * b[3]));
                        ss += __shfl_xor(ss, 16); ss += __shfl_xor(ss, 32);
                        if (fq == 0) P[(ai * HALF + wr * 64 + m * 16 + fr) * 8 + bj * 4 + wc] = ss; } }
            asm volatile("s_waitcnt lgkmcnt(0)" ::: "memory"); __builtin_amdgcn_s_barrier(); asm volatile("" ::: "memory");
            const int hf = wc >> 1, i0 = (16 * wc + 4 * fq) & 31;
            const float* wn = (u.pn < 8 ? qn : kn) + 64 * hf + i0;
            const float qsc = u.pn < 8 ? qscale : 1.0f;
            const f32x4 w1 = *(const f32x4*)wn * qsc, w2 = *(const f32x4*)(wn + 32) * qsc;
            unsigned char* dst0 = u.pn < 8 ? q8 + col0 : k8 + (col0 - 2048);
            const int dpitch = u.pn < 8 ? 2048 : 512;
#pragma unroll
            for (int ai = 0; ai < 2; ++ai)
#pragma unroll
                for (int m = 0; m < 4; ++m) {
                    const int row = row0 + ai * HALF + m * 16, pos = hf ? (row & 63) : (row >> 6); const float r_ = RS_(ai, m);
                    const f32x4 cs0 = *(const f32x4*)(rope + (size_t)(pos * 32 + i0) * 2), cs1 = *(const f32x4*)(rope + (size_t)(pos * 32 + i0) * 2 + 4);
#pragma unroll
                    for (int bj = 0; bj < 2; ++bj) {
                        const f32x4 pp = *(const PG8_LAS f32x4*)(P + (ai * HALF + wr * 64 + m * 16 + fr) * 8 + bj * 4);
                        const float hr = r_ / sqrtf(((pp[0] + pp[1]) + (pp[2] + pp[3])) * (1.0f / 128.0f) + 1e-6f);
                        const f32x4 x1 = acc[ai][bj][m][0] * hr * w1, x2 = acc[ai][bj][m][1] * hr * w2;
                        const float a0 = x1[0] * cs0[0] - x2[0] * cs0[1], b0 = x2[0] * cs0[0] + x1[0] * cs0[1];
                        const float a1 = x1[1] * cs0[2] - x2[1] * cs0[3], b1 = x2[1] * cs0[2] + x1[1] * cs0[3];
                        const float a2 = x1[2] * cs1[0] - x2[2] * cs1[1], b2 = x2[2] * cs1[0] + x1[2] * cs1[1];
                        const float a3 = x1[3] * cs1[2] - x2[3] * cs1[3], b3 = x2[3] * cs1[2] + x1[3] * cs1[3];
                        int w0 = __builtin_amdgcn_cvt_pk_fp8_f32(a0, a1, 0, false); w0 = __builtin_amdgcn_cvt_pk_fp8_f32(a2, a3, w0, true);
                        int w1_ = __builtin_amdgcn_cvt_pk_fp8_f32(b0, b1, 0, false); w1_ = __builtin_amdgcn_cvt_pk_fp8_f32(b2, b3, w1_, true);
                        typedef int i32x2v __attribute__((ext_vector_type(2))); *(i32x2v*)(dst0 + (size_t)row * dpitch + bj * HALF) = (i32x2v){w0, w1_}; }
                }
        }
#undef RS_
    }
};
typedef _Float16 h16x2 __attribute__((ext_vector_type(2)));
__device__ __forceinline__ unsigned pk_h2(float a, float b) { const h16x2 h = {(_Float16)a, (_Float16)b}; return __builtin_bit_cast(unsigned, h); }
__device__ __forceinline__ float h_lo(unsigned u) { return (float)__builtin_bit_cast(h16x2, u)[0]; }
__device__ __forceinline__ float h_hi(unsigned u) { return (float)__builtin_bit_cast(h16x2, u)[1]; }
template <bool OLDB, bool NEWF>
struct EpiOutT {
    static constexpr bool PERM = true, AFTER_DRAIN = false;
    const float* Xold; float* Xnew; bf16_t* XB  ; float* part  ; unsigned char* xb8; unsigned short* XH;
    __device__ __forceinline__ void operator()(const f32x4 (&acc)[2][2][4][2], const Unit& u, int wr, int wc, int fr, int fq) const {
        const int row0 = u.pm * BM + wr * 64 + fr, col0 = u.pn * BM + wc * 32 + 8 * fq;
        f32x4 xs[2][2][2][2];
#define EO_LD(slot, g) do { _Pragma("unroll") for (int mi = 0; mi < 2; ++mi) _Pragma("unroll") for (int bj = 0; bj < 2; ++bj) { \
            const size_t off = (size_t)(row0 + ((g) >> 1) * HALF + (((g) & 1) * 2 + mi) * 16) * 4096 + col0 + bj * HALF; \
            if (OLDB) { const u32x4 t_ = *(const u32x4*)(XH + off); \
                xs[slot][mi][bj][0] = f32x4{h_lo(t_.x), h_hi(t_.x), h_lo(t_.y), h_hi(t_.y)}; \
                xs[slot][mi][bj][1] = f32x4{h_lo(t_.z), h_hi(t_.z), h_lo(t_.w), h_hi(t_.w)}; } \
            else { xs[slot][mi][bj][0] = *(const f32x4*)(Xold + off); xs[slot][mi][bj][1] = *(const f32x4*)(Xold + off + 4); } } } while (0)
#define EO_PR(slot, g) do { _Pragma("unroll") for (int mi = 0; mi < 2; ++mi) { const int ai = (g) >> 1, m = ((g) & 1) * 2 + mi; const int row = row0 + ai * HALF + m * 16; float ss = 0.f; \
            _Pragma("unroll") for (int bj = 0; bj < 2; ++bj) { const size_t off = (size_t)row * 4096 + col0 + bj * HALF; \
                const f32x4 x0 = xs[slot][mi][bj][0] + acc[ai][bj][m][0], x1 = xs[slot][mi][bj][1] + acc[ai][bj][m][1]; \
                if (NEWF) { ST_X((f32x4*)(Xnew + off), x0); ST_X((f32x4*)(Xnew + off + 4), x1); } \
                else { u32x4 hh; hh.x = pk_h2(x0[0], x0[1]); hh.y = pk_h2(x0[2], x0[3]); hh.z = pk_h2(x1[0], x1[1]); hh.w = pk_h2(x1[2], x1[3]); *(u32x4*)(XH + off) = hh; } \
                u32x4 w; w.x = cvt_pk_bf16(x0[0], x0[1]); w.y = cvt_pk_bf16(x0[2], x0[3]); w.z = cvt_pk_bf16(x1[0], x1[1]); w.w = cvt_pk_bf16(x1[2], x1[3]); \
                if (XB) *(u32x4*)(XB + off) = w; \
                if (xb8) { int e0 = __builtin_amdgcn_cvt_pk_fp8_f32(x0[0], x0[1], 0, false); e0 = __builtin_amdgcn_cvt_pk_fp8_f32(x0[2], x0[3], e0, true); int e1 = __builtin_amdgcn_cvt_pk_fp8_f32(x1[0], x1[1], 0, false); e1 = __builtin_amdgcn_cvt_pk_fp8_f32(x1[2], x1[3], e1, true); \
                    typedef int i32x2e __attribute__((ext_vector_type(2))); *(i32x2e*)(xb8 + off) = (i32x2e){e0, e1}; } \
                ss += ((x0[0] * x0[0] + x0[1] * x0[1]) + (x0[2] * x0[2] + x0[3] * x0[3])) + ((x1[0] * x1[0] + x1[1] * x1[1]) + (x1[2] * x1[2] + x1[3] * x1[3])); } \
            ss += __shfl_xor(ss, 16); ss += __shfl_xor(ss, 32); \
            if (part && fq == 0) part[(size_t)row * 64 + u.pn * 4 + wc] = ss; } } while (0)
        EO_LD(0, 0); EO_LD(1, 1); asm volatile("" ::: "memory");
        EO_PR(0, 0); asm volatile("" ::: "memory"); EO_LD(0, 2); asm volatile("" ::: "memory");
        EO_PR(1, 1); asm volatile("" ::: "memory"); EO_LD(1, 3); asm volatile("" ::: "memory");
        EO_PR(0, 2); EO_PR(1, 3);
#undef EO_LD
#undef EO_PR
    }
};
typedef EpiOutT<false, true> EpiOut;

struct EpiLight {
    static constexpr bool PERM = true, AFTER_DRAIN = false;
    bf16_t* O;
    __device__ __forceinline__ void operator()(const f32x4 (&acc)[2][2][4][2], const Unit& u, int wr, int wc, int fr, int fq) const {
        const int row0 = u.pm * BM + wr * 64 + fr, col0 = u.pn * BM + wc * 32 + 8 * fq;
#pragma unroll
        for (int ai = 0; ai < 2; ++ai)
#pragma unroll
            for (int m = 0; m < 4; ++m) { bf16_t* rowp = O + (size_t)(row0 + ai * HALF + m * 16) * 4096 + col0;
#pragma unroll
                for (int bj = 0; bj < 2; ++bj) { const f32x4 v0 = acc[ai][bj][m][0], v1 = acc[ai][bj][m][1];
                    u32x4 w; w.x = cvt_pk_bf16(v0[0], v0[1]); w.y = cvt_pk_bf16(v0[2], v0[3]); w.z = cvt_pk_bf16(v1[0], v1[1]); w.w = cvt_pk_bf16(v1[2], v1[3]);
                    *(u32x4*)(rowp + bj * HALF) = w; } }
    }
};
template <class Epi, class Sched, bool ALIGN_EPI = false, bool SP2 = false, bool F8 = false, int SPLIT8 = 0, bool F16 = false>
__device__ __forceinline__ void gemm_phase(PG8_LAS unsigned char* lds, const Gemm g, const Sched& S, const Epi& E, float split_scale = 1.0f) {
    int tid_ = threadIdx.x; asm volatile("" : "+v"(tid_));
    const int tid = tid_, wid = __builtin_amdgcn_readfirstlane(tid >> 6), lane = tid & 63, wr = wid >> 2, wc = wid & 3, fr = lane & 15, fq = lane >> 4;
    typedef int i32x4_ __attribute__((ext_vector_type(4)));
    typedef _Float16 f16x8_ __attribute__((ext_vector_type(8)));
    const int f8one = 0x7f7f7f7f;
    const int K = g.K, nt = K / BK - SPLIT8;
    unsigned voffA[2], voffB[2];
#pragma unroll
    for (int i = 0; i < 2; ++i) { int R, C; stage_rc(tid * 16 + i * 8192, R, C); const int Rb = Epi::PERM ? ((R & ~31) + perm32(R & 31)) : R;
        voffA[i] = (unsigned)(R * K + C) * 2u; voffB[i] = (unsigned)(Rb * K + C) * 2u; }
    const size_t kstep = (size_t)(BK * 2);
    const size_t hstep = (size_t)HALF * K * 2;
    const size_t tstep = 2 * hstep;
    const unsigned ldsw = (unsigned)wid * 1024u;
    const int aoff = lds_byte(wr * 64 + fr, fq * 8), boff = lds_byte(wc * 32 + fr, fq * 8);
#define PG8_SA(b, h) (((b) * 2 + (h)) * HTB)
#define PG8_SB(b, h) ((4 + (b) * 2 + (h)) * HTB)
#define PG8_STAGE(bufoff, gbase, voff) do { _Pragma("unroll") for (int _i = 0; _i < 2; ++_i) \
        __builtin_amdgcn_global_load_lds((const unsigned*)((const char*)(gbase) + (voff)[_i]), (PG8_LAS unsigned*)(lds + (bufoff) + ldsw + _i * 8192), 16, 0, 0); } while (0)
#define PG8_LDA(dst, b, h) do { _Pragma("unroll") for (int m = 0; m < 4; ++m) _Pragma("unroll") for (int k = 0; k < 2; ++k) dst[m][k] = *(const PG8_LAS bf16x8*)(lds + PG8_SA(b, h) + aoff + m * 2048 + k * 1024); } while (0)
#define PG8_LDB(dst, b, h) do { _Pragma("unroll") for (int n = 0; n < 2; ++n) _Pragma("unroll") for (int k = 0; k < 2; ++k) dst[n][k] = *(const PG8_LAS bf16x8*)(lds + PG8_SB(b, h) + boff + n * 2048 + k * 1024); } while (0)
#define PG8_CAT8(x, y) __builtin_shufflevector(__builtin_bit_cast(i32x4_, x), __builtin_bit_cast(i32x4_, y), 0, 1, 2, 3, 4, 5, 6, 7)
#define PG8_MMA(ai, bj, At, Bt) do { __builtin_amdgcn_s_setprio(1); _Pragma("unroll") for (int m = 0; m < 4; ++m) _Pragma("unroll") for (int n = 0; n < 2; ++n) { \
        if constexpr (f8t) { asm volatile("v_mfma_scale_f32_16x16x128_f8f6f4 %0, %1, %2, %0, %3, %3 op_sel_hi:[0,0,0]" : "+v"(acc[ai][bj][m][n]) : "v"(PG8_CAT8(Bt[n][0], Bt[n][1])), "v"(PG8_CAT8(At[m][0], At[m][1])), "v"(f8one)); } \
        else if constexpr (SPLIT8 > 0) { _Pragma("unroll") for (int k = 0; k < 2; ++k) asm volatile("v_mfma_f32_16x16x32_bf16 %0, %1, %2, %0" : "+v"(acc[ai][bj][m][n]) : "v"(Bt[n][k]), "v"(At[m][k])); } \
        else if constexpr (F16) { _Pragma("unroll") for (int k = 0; k < 2; ++k) acc[ai][bj][m][n] = __builtin_amdgcn_mfma_f32_16x16x32_f16(__builtin_bit_cast(f16x8_, Bt[n][k]), __builtin_bit_cast(f16x8_, At[m][k]), acc[ai][bj][m][n], 0, 0, 0); } \
        else { _Pragma("unroll") for (int k = 0; k < 2; ++k) acc[ai][bj][m][n] = __builtin_amdgcn_mfma_f32_16x16x32_bf16(Bt[n][k], At[m][k], acc[ai][bj][m][n], 0, 0, 0); } } \
        __builtin_amdgcn_s_setprio(0); } while (0)
#define PG8_WAIT_V(n) asm volatile("s_waitcnt vmcnt(" #n ")" ::: "memory")
#define PG8_WAIT_L(n) asm volatile("s_waitcnt lgkmcnt(" #n ")" ::: "memory")
#define PG8_BAR __builtin_amdgcn_s_barrier()
#define PG8_SCHED __builtin_amdgcn_sched_barrier(0)
#define PG8_KBODY(F8T) do { constexpr bool f8t = (F8T); (void)f8t; \
            const bool last = (t == nt - 2); \
            const size_t k1 = (size_t)((t + 1 < SPLIT8 || SPLIT8 == 0) ? t + 1 : t + 1 + SPLIT8) * kstep, k2 = (size_t)((t + 2 < SPLIT8 || SPLIT8 == 0) ? t + 2 : t + 2 + SPLIT8) * kstep; \
            const char* a1 = cA + k1; \
            const char* a2 = last ? nA : cA + k2; const char* b2 = last ? nB : cB + k2; \
            const char* a3 = a2 + kstep; const char* b3 = b2 + kstep; \
            if (last && has_next) S.a_ready(nxt); \
            if constexpr (SP2) { \
            PG8_LDB(B0, 0, 0); PG8_LDB(B1, 0, 1); PG8_SCHED; PG8_LDA(At, 0, 0); PG8_STAGE(PG8_SA(1, 1), a1 + hstep, voffA); \
            PG8_WAIT_V(8); PG8_WAIT_L(0); PG8_BAR; PG8_MMA(0, 0, At, B0); PG8_MMA(0, 1, At, B1); PG8_BAR; PG8_SCHED; \
            PG8_LDA(At, 0, 1); PG8_STAGE(PG8_SB(0, 0), b2, voffB); PG8_STAGE(PG8_SB(0, 1), b2 + hstep, voffB); PG8_STAGE(PG8_SA(0, 0), a2, voffA); \
            PG8_WAIT_V(8); PG8_WAIT_L(0); PG8_BAR; PG8_MMA(1, 0, At, B0); PG8_MMA(1, 1, At, B1); PG8_BAR; PG8_SCHED; \
            PG8_LDB(B0, 1, 0); PG8_LDB(B1, 1, 1); PG8_SCHED; PG8_LDA(At, 1, 0); PG8_STAGE(PG8_SA(0, 1), a2 + hstep, voffA); \
            PG8_WAIT_V(8); PG8_WAIT_L(0); PG8_BAR; PG8_MMA(0, 0, At, B0); PG8_MMA(0, 1, At, B1); PG8_BAR; PG8_SCHED; \
            PG8_LDA(At, 1, 1); PG8_STAGE(PG8_SB(1, 0), b3, voffB); PG8_STAGE(PG8_SB(1, 1), b3 + hstep, voffB); PG8_STAGE(PG8_SA(1, 0), a3, voffA); \
            PG8_WAIT_V(8); PG8_WAIT_L(0); PG8_BAR; PG8_MMA(1, 0, At, B0); PG8_MMA(1, 1, At, B1); PG8_BAR; PG8_SCHED; \
            } else { \
            PG8_LDB(B0, 0, 0); PG8_SCHED; PG8_LDA(At, 0, 0); PG8_STAGE(PG8_SA(1, 1), a1 + hstep, voffA); \
            PG8_WAIT_L(8); PG8_BAR; PG8_WAIT_L(0); PG8_MMA(0, 0, At, B0); PG8_BAR; PG8_SCHED; \
            PG8_LDB(B1, 0, 1); PG8_STAGE(PG8_SB(0, 0), b2, voffB); \
            PG8_BAR; PG8_WAIT_L(0); PG8_MMA(0, 1, At, B1); PG8_BAR; \
            PG8_LDA(At, 0, 1); PG8_STAGE(PG8_SA(0, 0), a2, voffA); \
            PG8_BAR; PG8_WAIT_L(0); PG8_MMA(1, 0, At, B0); PG8_BAR; PG8_SCHED; \
            PG8_STAGE(PG8_SB(0, 1), b2 + hstep, voffB); \
            PG8_WAIT_V(6); PG8_BAR; PG8_MMA(1, 1, At, B1); PG8_BAR; \
            PG8_LDB(B0, 1, 0); PG8_SCHED; PG8_LDA(At, 1, 0); PG8_STAGE(PG8_SA(0, 1), a2 + hstep, voffA); \
            PG8_WAIT_L(8); PG8_BAR; PG8_WAIT_L(0); PG8_MMA(0, 0, At, B0); PG8_BAR; PG8_SCHED; \
            PG8_LDB(B1, 1, 1); PG8_STAGE(PG8_SB(1, 0), b3, voffB); \
            PG8_BAR; PG8_WAIT_L(0); PG8_MMA(0, 1, At, B1); PG8_BAR; \
            PG8_LDA(At, 1, 1); PG8_STAGE(PG8_SA(1, 0), a3, voffA); \
            PG8_BAR; PG8_WAIT_L(0); PG8_MMA(1, 0, At, B0); PG8_BAR; PG8_SCHED; \
            PG8_STAGE(PG8_SB(1, 1), b3 + hstep, voffB); \
            PG8_WAIT_V(6); PG8_BAR; PG8_MMA(1, 1, At, B1); PG8_BAR; \
            } \
        } while (0)
    Unit cur, nxt; int ui = 0;
    if (!S.next(0, cur)) return;
    f32x4 acc[2][2][4][2];
#pragma unroll
    for (int a = 0; a < 2; ++a)
#pragma unroll
        for (int b = 0; b < 2; ++b)
#pragma unroll
            for (int m = 0; m < 4; ++m)
#pragma unroll
                for (int n = 0; n < 2; ++n) acc[a][b][m][n] = (f32x4){0.f, 0.f, 0.f, 0.f};
    bf16x8 At[4][2], B0[2][2], B1[2][2];
    const char* cA = (const char*)g.A + (size_t)cur.pm * tstep; const char* cB = (const char*)g.Bt + (size_t)cur.pn * tstep;
    S.a_ready(cur);
    if constexpr (SP2) {
        PG8_STAGE(PG8_SB(0, 0), cB, voffB); PG8_STAGE(PG8_SB(0, 1), cB + hstep, voffB); PG8_STAGE(PG8_SA(0, 0), cA, voffA); PG8_STAGE(PG8_SA(0, 1), cA + hstep, voffA);
        if (wr == 1) PG8_BAR;
        PG8_WAIT_V(2); PG8_BAR;
        PG8_STAGE(PG8_SB(1, 0), cB + kstep, voffB); PG8_STAGE(PG8_SA(1, 0), cA + kstep, voffA); PG8_STAGE(PG8_SB(1, 1), cB + hstep + kstep, voffB);
        PG8_WAIT_V(6); PG8_BAR;
    } else {
        PG8_STAGE(PG8_SB(0, 0), cB, voffB); PG8_STAGE(PG8_SA(0, 0), cA, voffA); PG8_STAGE(PG8_SB(0, 1), cB + hstep, voffB); PG8_STAGE(PG8_SA(0, 1), cA + hstep, voffA);
        if (wr == 1) PG8_BAR;
        PG8_WAIT_V(4); PG8_BAR;
        PG8_STAGE(PG8_SB(1, 0), cB + kstep, voffB); PG8_STAGE(PG8_SA(1, 0), cA + kstep, voffA); PG8_STAGE(PG8_SB(1, 1), cB + hstep + kstep, voffB);
        PG8_WAIT_V(6); PG8_BAR;
    }
    for (;;) {
        const bool has_next = S.next(ui + 1, nxt);
        const char* nA = has_next ? (const char*)g.A + (size_t)nxt.pm * tstep : cA; const char* nB = has_next ? (const char*)g.Bt + (size_t)nxt.pn * tstep : cB;
        if constexpr (SPLIT8 > 0) {
            for (int t = 0; t < SPLIT8; t += 2) PG8_KBODY(true);
#pragma unroll
            for (int a = 0; a < 2; ++a)
#pragma unroll
                for (int b = 0; b < 2; ++b)
#pragma unroll
                    for (int m = 0; m < 4; ++m)
#pragma unroll
                        for (int n = 0; n < 2; ++n) acc[a][b][m][n] *= split_scale;
            for (int t = SPLIT8; t < nt; t += 2) PG8_KBODY(false);
        } else {
            for (int t = 0; t < nt; t += 2) PG8_KBODY(F8);
        }
        if constexpr (F8 || SPLIT8 > 0) asm volatile("s_nop 15\n\ts_nop 15" ::: "memory");
        if constexpr (ALIGN_EPI) { if (wr == 0) PG8_BAR; }
        if constexpr (!Epi::AFTER_DRAIN) { E(acc, cur, wr, wc, fr, fq); S.done(cur); }
        if (!has_next) break;
#pragma unroll
        for (int a = 0; a < 2; ++a)
#pragma unroll
            for (int b = 0; b < 2; ++b)
#pragma unroll
                for (int m = 0; m < 4; ++m)
#pragma unroll
                    for (int n = 0; n < 2; ++n) acc[a][b][m][n] = (f32x4){0.f, 0.f, 0.f, 0.f};
        cur = nxt; cA = nA; cB = nB; ++ui;
        if constexpr (ALIGN_EPI) { if (wr == 1) PG8_BAR; }
    }
    PG8_WAIT_V(0);
    if constexpr (!ALIGN_EPI) { if (wr == 0) PG8_BAR; }
    PG8_BAR;
    if constexpr (Epi::AFTER_DRAIN) { E.fused(acc, cur, wr, wc, fr, fq, lds, wid, lane); S.done(cur); }
#undef PG8_SA
#undef PG8_SB
#undef PG8_STAGE
#undef PG8_LDA
#undef PG8_LDB
#undef PG8_MMA
#undef PG8_KBODY
#undef PG8_CAT8
#undef PG8_WAIT_V
#undef PG8_WAIT_L
#undef PG8_BAR
#undef PG8_SCHED
}
}
namespace att {
using bf16 = unsigned short;
constexpr int D = 128, NW = 8, QBLK = 32, KVBLK = 64;
constexpr float SCALE = 0.088388347648318440f;
constexpr float THR = 8.f;
using f32x4 = __attribute__((ext_vector_type(4))) float;
using bf16x8 = __attribute__((ext_vector_type(8))) short;
using s16x4  = __attribute__((ext_vector_type(4))) short;
using f32x16 = __attribute__((ext_vector_type(16))) float;
using f32x8  = __attribute__((ext_vector_type(8))) float;
using u32x4  = __attribute__((ext_vector_type(4))) unsigned;
#define KSWZ(row, colB) ((row) * 256 + ((colB) ^ (((row) & 15) << 4)))
#define SBAR() __builtin_amdgcn_sched_barrier(0)
__device__ __forceinline__ int crow(int r, int hi) { return (r & 3) + 8 * (r >> 2) + 4 * hi; }
__device__ __forceinline__ unsigned cvtpk(float lo, float hi) {
  unsigned r; asm volatile("v_cvt_pk_bf16_f32 %0, %1, %2" : "=v"(r) : "v"(lo), "v"(hi)); return r;
}
__device__ __forceinline__ void partialSM(f32x16& p0, f32x16& p1, float& m_reg, float& mn, float& alpha) {
  constexpr float C = SCALE * 1.4426950408889634f;
  float pmax = p0[0]; _Pragma("unroll") for (int r = 1; r < 16; ++r) pmax = fmaxf(pmax, p0[r]); _Pragma("unroll") for (int r = 0; r < 16; ++r) pmax = fmaxf(pmax, p1[r]);
  { auto rr = __builtin_amdgcn_permlane32_swap(__float_as_uint(pmax), __float_as_uint(pmax), false, false);
    pmax = fmaxf(__uint_as_float(rr[0]), __uint_as_float(rr[1])); }
  if (__builtin_expect(__all(pmax - m_reg <= THR / SCALE), 1)) { mn = m_reg; alpha = 1.f; }
  else { mn = fmaxf(m_reg, pmax); alpha = __builtin_amdgcn_exp2f((m_reg - mn) * C); m_reg = mn; }
  float mnC = -mn * C;
  _Pragma("unroll") for (int r = 0; r < 16; ++r) p0[r] = fmaf(p0[r], C, mnC); _Pragma("unroll") for (int r = 0; r < 16; ++r) p1[r] = fmaf(p1[r], C, mnC);
  _Pragma("unroll") for (int r = 0; r < 16; ++r) p0[r] = __builtin_amdgcn_exp2f(p0[r]);
}
__device__ __forceinline__ void finishSM(f32x16& p0, f32x16& p1, float alpha, float& l_reg, bf16x8& pa0, bf16x8& pa1, bf16x8& pa2, bf16x8& pa3) {
  _Pragma("unroll") for (int r = 0; r < 16; ++r) p1[r] = __builtin_amdgcn_exp2f(p1[r]);
  float ps = 0; _Pragma("unroll") for (int r = 0; r < 16; ++r) ps += p0[r]; _Pragma("unroll") for (int r = 0; r < 16; ++r) ps += p1[r];
  { auto rr = __builtin_amdgcn_permlane32_swap(__float_as_uint(ps), __float_as_uint(ps), false, false);
    ps = __uint_as_float(rr[0]) + __uint_as_float(rr[1]); }
  l_reg = l_reg * alpha + ps;
#define PK4(P, BASE, OUT) do { unsigned a0 = cvtpk(P[BASE + 0], P[BASE + 1]), a1 = cvtpk(P[BASE + 2], P[BASE + 3]);   \
    unsigned b0 = cvtpk(P[BASE + 4], P[BASE + 5]), b1 = cvtpk(P[BASE + 6], P[BASE + 7]);                              \
    auto r0 = __builtin_amdgcn_permlane32_swap(a0, b0, false, false); auto r1 = __builtin_amdgcn_permlane32_swap(a1, b1, false, false); \
    u32x4 w = {r0[0], r1[0], r0[1], r1[1]}; OUT = *reinterpret_cast<bf16x8*>(&w); } while (0)
  PK4(p0, 0, pa0); PK4(p0, 8, pa1); PK4(p1, 0, pa2); PK4(p1, 8, pa3);
#undef PK4
}
__device__ __forceinline__ void qkt(f32x16& p0, f32x16& p1, const bf16* Ks, const bf16x8* qr, int r32, int hi) {
  p0 = f32x16{}; p1 = f32x16{};
  _Pragma("unroll") for (int d0 = 0; d0 < 8; ++d0) { int cb = (d0 * 16 + hi * 8) * 2;
    bf16x8 b0 = *reinterpret_cast<const bf16x8*>((const char*)Ks + KSWZ(r32, cb));
    bf16x8 b1 = *reinterpret_cast<const bf16x8*>((const char*)Ks + KSWZ(32 + r32, cb));
    p0 = __builtin_amdgcn_mfma_f32_32x32x16_bf16(b0, qr[d0], p0, 0, 0, 0);
    p1 = __builtin_amdgcn_mfma_f32_32x32x16_bf16(b1, qr[d0], p1, 0, 0, 0); }
}
__device__ __forceinline__ int v_st(int k, int c) { const int kk = (k & ~0xC) | ((k & 4) << 1) | ((k & 8) >> 1); return ((kk >> 3) * 4 + (c >> 5)) * 512 + ((kk & 7) * 32 + (c & 31)) * 2; }
__device__ __forceinline__ int v_rd_base(int lane) { return ((lane & 3) << 3) | (((lane >> 2) & 3) << 6) | (((lane >> 4) & 1) << 5) | (((lane >> 5) & 1) << 8); }
constexpr int v_rd_off(int d0, int ks, int half) { return d0 * 512 + ks * 4096 + half * 2048; }
template <int OFF> __device__ __forceinline__ s16x4 tr_read(int vb) {
  s16x4 r; asm volatile("ds_read_b64_tr_b16 %0, %1 offset:%2" : "=&v"(r) : "v"(vb), "i"(OFF) : "memory"); return r;
}
template <int D0> __device__ __forceinline__ void pv_one(f32x16& od, int vb, bf16x8 pa0, bf16x8 pa1, bf16x8 pa2, bf16x8 pa3) {
  const s16x4 l0 = tr_read<v_rd_off(D0, 0, 0)>(vb), h0 = tr_read<v_rd_off(D0, 0, 1)>(vb), l1 = tr_read<v_rd_off(D0, 1, 0)>(vb), h1 = tr_read<v_rd_off(D0, 1, 1)>(vb);
  const s16x4 l2 = tr_read<v_rd_off(D0, 2, 0)>(vb), h2 = tr_read<v_rd_off(D0, 2, 1)>(vb), l3 = tr_read<v_rd_off(D0, 3, 0)>(vb), h3 = tr_read<v_rd_off(D0, 3, 1)>(vb);
  asm volatile("s_waitcnt lgkmcnt(0)" ::: "memory"); SBAR();
#define PK(L, H) (bf16x8){L[0], L[1], L[2], L[3], H[0], H[1], H[2], H[3]}
  od = __builtin_amdgcn_mfma_f32_32x32x16_bf16(pa0, PK(l0, h0), od, 0, 0, 0);
  od = __builtin_amdgcn_mfma_f32_32x32x16_bf16(pa1, PK(l1, h1), od, 0, 0, 0);
  od = __builtin_amdgcn_mfma_f32_32x32x16_bf16(pa2, PK(l2, h2), od, 0, 0, 0);
  od = __builtin_amdgcn_mfma_f32_32x32x16_bf16(pa3, PK(l3, h3), od, 0, 0, 0);
#undef PK
}
__device__ __forceinline__ void pv_d0(f32x16* o, int vb, bf16x8 pa0, bf16x8 pa1, bf16x8 pa2, bf16x8 pa3) {
  pv_one<0>(o[0], vb, pa0, pa1, pa2, pa3); pv_one<1>(o[1], vb, pa0, pa1, pa2, pa3); pv_one<2>(o[2], vb, pa0, pa1, pa2, pa3); pv_one<3>(o[3], vb, pa0, pa1, pa2, pa3);
}
#define LAS3 __attribute__((address_space(3)))
typedef short v4i16_t __attribute__((ext_vector_type(4)));
__device__ __forceinline__ s16x4 vtr(const LAS3 char* p) { return __builtin_bit_cast(s16x4, __builtin_amdgcn_ds_read_tr16_b64_v4i16((LAS3 v4i16_t*)p)); }
__device__ __forceinline__ void partialSM_bf(f32x16& p0, f32x16& p1, float& m_reg, float& mn, float& alpha) {
  constexpr float C = SCALE * 1.4426950408889634f;
  float pmax = p0[0];
  _Pragma("unroll") for (int r = 1; r < 16; ++r) pmax = fmaxf(pmax, p0[r]);
  _Pragma("unroll") for (int r = 0; r < 16; ++r) pmax = fmaxf(pmax, p1[r]);
  { auto rr = __builtin_amdgcn_permlane32_swap(__float_as_uint(pmax), __float_as_uint(pmax), false, false);
    pmax = fmaxf(__uint_as_float(rr[0]), __uint_as_float(rr[1])); }
  const bool keep = __all(pmax - m_reg <= THR / SCALE);
  mn = keep ? m_reg : fmaxf(m_reg, pmax); alpha = __builtin_amdgcn_exp2f((m_reg - mn) * C); m_reg = mn;
  const float mnC = -mn * C;
  _Pragma("unroll") for (int r = 0; r < 16; ++r) p0[r] = fmaf(p0[r], C, mnC);
  _Pragma("unroll") for (int r = 0; r < 16; ++r) p1[r] = fmaf(p1[r], C, mnC);
  _Pragma("unroll") for (int r = 0; r < 16; ++r) p0[r] = __builtin_amdgcn_exp2f(p0[r]);
}
__device__ __forceinline__ void pv_all(f32x16* o, const LAS3 char* vp, bf16x8 pa0, bf16x8 pa1, bf16x8 pa2, bf16x8 pa3) {
#define PKV(L, H) (bf16x8){L[0], L[1], L[2], L[3], H[0], H[1], H[2], H[3]}
  _Pragma("unroll") for (int d0 = 0; d0 < 4; ++d0) {
    const s16x4 l0 = vtr(vp + v_rd_off(d0, 0, 0)), h0 = vtr(vp + v_rd_off(d0, 0, 1)), l1 = vtr(vp + v_rd_off(d0, 1, 0)), h1 = vtr(vp + v_rd_off(d0, 1, 1));
    const s16x4 l2 = vtr(vp + v_rd_off(d0, 2, 0)), h2 = vtr(vp + v_rd_off(d0, 2, 1)), l3 = vtr(vp + v_rd_off(d0, 3, 0)), h3 = vtr(vp + v_rd_off(d0, 3, 1));
    o[d0] = __builtin_amdgcn_mfma_f32_32x32x16_bf16(pa0, PKV(l0, h0), o[d0], 0, 0, 0);
    o[d0] = __builtin_amdgcn_mfma_f32_32x32x16_bf16(pa1, PKV(l1, h1), o[d0], 0, 0, 0);
    o[d0] = __builtin_amdgcn_mfma_f32_32x32x16_bf16(pa2, PKV(l2, h2), o[d0], 0, 0, 0);
    o[d0] = __builtin_amdgcn_mfma_f32_32x32x16_bf16(pa3, PKV(l3, h3), o[d0], 0, 0, 0); }
#undef PKV
}
#ifndef SGB_VALU_A
#define SGB_VALU_A 4
#endif
#ifndef SGB_VALU_B
#define SGB_VALU_B 4
#endif
#define PIN_A() asm volatile("" : "+v"(pa0), "+v"(pa1), "+v"(pa2), "+v"(pa3), "+v"(l_reg))
#define PIN_B(P0, P1, AL) asm volatile("" : "+v"(P0), "+v"(P1), "+v"(AL), "+v"(m_reg))
#define SGB_A() do { __builtin_amdgcn_sched_group_barrier(0x100, 2, 0); _Pragma("unroll") for (int i_ = 0; i_ < 16; ++i_) { __builtin_amdgcn_sched_group_barrier(0x008, 1, 0); \
    __builtin_amdgcn_sched_group_barrier(0x100, 1, 0); __builtin_amdgcn_sched_group_barrier(0x400, 1, 0); __builtin_amdgcn_sched_group_barrier(0x002, SGB_VALU_A, 0); } } while (0)
#define SGB_B() do { __builtin_amdgcn_sched_group_barrier(0x100, 2, 0); _Pragma("unroll") for (int i_ = 0; i_ < 16; ++i_) { __builtin_amdgcn_sched_group_barrier(0x008, 1, 0); \
    __builtin_amdgcn_sched_group_barrier(0x100, 2, 0); __builtin_amdgcn_sched_group_barrier(0x002, SGB_VALU_B, 0); __builtin_amdgcn_sched_group_barrier(0x400, 1, 0); } } while (0)
constexpr int DMODEL = 4096;
constexpr size_t SHM_V = 64 * 128 * 2, SHM_K = 64 * 128 * 2;
constexpr int ATT_WS_OFF = 2 * SHM_V + 2 * SHM_K, ATT_TAB_OFF = ATT_WS_OFF + 8 * 256, ATT_OST_OFF = ATT_TAB_OFF + 704 * 4 + 256  , ATT_LDS_BYTES = ATT_OST_OFF + 8 * 8192;
constexpr float LOG2E = 1.4426950408889634f;
constexpr float Y8_SCALE = 64.0f;
__device__ __forceinline__ float bf2f(bf16 v) { return __uint_as_float((unsigned)v << 16); }
__device__ __forceinline__ bf16 f2bf(float f) { return (bf16)(cvtpk(f, 0.f) & 0xffffu); }
__device__ __forceinline__ float silu_f(float g) { return g * __builtin_amdgcn_rcpf(1.0f + __builtin_amdgcn_exp2f(-g * LOG2E)); }
__device__ __forceinline__ void pack_p(const f32x16& p0, const f32x16& p1, bf16x8& pa0, bf16x8& pa1, bf16x8& pa2, bf16x8& pa3) {
#define PK4(P, BASE, OUT) do { unsigned a0 = cvtpk(P[BASE + 0], P[BASE + 1]), a1 = cvtpk(P[BASE + 2], P[BASE + 3]);   \
    unsigned b0 = cvtpk(P[BASE + 4], P[BASE + 5]), b1 = cvtpk(P[BASE + 6], P[BASE + 7]);                              \
    auto r0 = __builtin_amdgcn_permlane32_swap(a0, b0, false, false); auto r1 = __builtin_amdgcn_permlane32_swap(a1, b1, false, false); \
    u32x4 w = {r0[0], r1[0], r0[1], r1[1]}; OUT = *reinterpret_cast<bf16x8*>(&w); } while (0)
  PK4(p0, 0, pa0); PK4(p0, 8, pa1); PK4(p1, 0, pa2); PK4(p1, 8, pa3);
#undef PK4
}
#ifndef LU_GATE_EARLY
#define LU_GATE_EARLY 0
#endif
struct GateRegs { u32x4 g[2][4]; };
template <int ZP> __device__ __forceinline__ void load_gate(GateRegs& G, const bf16* Gb, int rowb, int lane) {
  const int rr = lane >> 3, c8 = (lane & 7) * 8;
#pragma unroll
  for (int h = 0; h < 2; ++h)
#pragma unroll
    for (int i = 0; i < 4; ++i) G.g[h][i] = *reinterpret_cast<const u32x4*>((const char*)Gb + (unsigned)(((rowb + 8 * i + rr) * ZP + h * 64 + c8) * 2));
}
template <int ZP, bool OUT8 = false, bool PRE = false>
__device__ __forceinline__ void store_gated(const f32x16* o, float l_reg, float* li_l, float* ost, const bf16* Gb, bf16* Yb, int wid, int lane, int r32, int hi, bool li_ready = false, int rowb = -1, const GateRegs* gpre = nullptr) {
  if (rowb < 0) rowb = wid * 32;
  if (!li_ready && hi == 0) li_l[r32] = l_reg;
  const int rr = lane >> 3, c8 = (lane & 7) * 8;
  u32x4 g[2][4];
#pragma unroll
  for (int h = 0; h < 2; ++h)
#pragma unroll
    for (int i = 0; i < 4; ++i) { if (PRE) g[h][i] = gpre->g[h][i]; else g[h][i] = *reinterpret_cast<const u32x4*>((const char*)Gb + (unsigned)(((rowb + 8 * i + rr) * ZP + h * 64 + c8) * 2)); }
#pragma unroll
  for (int h = 0; h < 2; ++h) {
#pragma unroll
    for (int d = 0; d < 2; ++d)
#pragma unroll
      for (int r = 0; r < 16; ++r) ost[crow(r, hi) * 64 + d * 32 + r32] = o[2 * h + d][r];
    asm volatile("s_waitcnt lgkmcnt(0)" ::: "memory");
#pragma unroll
    for (int i = 0; i < 4; ++i) { const int row = 8 * i + rr;
      const f32x4 a = *reinterpret_cast<const f32x4*>(ost + row * 64 + c8), b = *reinterpret_cast<const f32x4*>(ost + row * 64 + c8 + 4);
      const float rl = __builtin_amdgcn_rcpf(li_l[row]); const u32x4 gg = g[h][i];
      u32x4 w;
      w.x = cvtpk(a[0] * rl * silu_f(__uint_as_float(gg.x << 16)), a[1] * rl * silu_f(__uint_as_float(gg.x & 0xffff0000u)));
      w.y = cvtpk(a[2] * rl * silu_f(__uint_as_float(gg.y << 16)), a[3] * rl * silu_f(__uint_as_float(gg.y & 0xffff0000u)));
      w.z = cvtpk(b[0] * rl * silu_f(__uint_as_float(gg.z << 16)), b[1] * rl * silu_f(__uint_as_float(gg.z & 0xffff0000u)));
      w.w = cvtpk(b[2] * rl * silu_f(__uint_as_float(gg.w << 16)), b[3] * rl * silu_f(__uint_as_float(gg.w & 0xffff0000u)));
      if (OUT8) { const float ys = rl * Y8_SCALE;
        int e0 = __builtin_amdgcn_cvt_pk_fp8_f32(a[0] * ys * silu_f(__uint_as_float(gg.x << 16)), a[1] * ys * silu_f(__uint_as_float(gg.x & 0xffff0000u)), 0, false);
        e0 = __builtin_amdgcn_cvt_pk_fp8_f32(a[2] * ys * silu_f(__uint_as_float(gg.y << 16)), a[3] * ys * silu_f(__uint_as_float(gg.y & 0xffff0000u)), e0, true);
        int e1 = __builtin_amdgcn_cvt_pk_fp8_f32(b[0] * ys * silu_f(__uint_as_float(gg.z << 16)), b[1] * ys * silu_f(__uint_as_float(gg.z & 0xffff0000u)), 0, false);
        e1 = __builtin_amdgcn_cvt_pk_fp8_f32(b[2] * ys * silu_f(__uint_as_float(gg.w << 16)), b[3] * ys * silu_f(__uint_as_float(gg.w & 0xffff0000u)), e1, true);
        typedef int i32x2y __attribute__((ext_vector_type(2))); *reinterpret_cast<i32x2y*>((char*)Yb + (unsigned)((rowb + row) * (DMODEL * 2) + h * 64 + c8)) = (i32x2y){e0, e1};
      } else
      *reinterpret_cast<u32x4*>((char*)Yb + (unsigned)(((rowb + row) * DMODEL + h * 64 + c8) * 2)) = w; }
    asm volatile("s_waitcnt lgkmcnt(0)" ::: "memory");
  }
}

template <int ZP>
__device__ __forceinline__ void dense_unit(const bf16* Qb, const bf16* Kh, const bf16* Vh, const bf16* Gb, bf16* Yb, int seq, char* lds) {
  int tid_ = threadIdx.x; asm volatile("" : "+v"(tid_));
  const int tid = tid_, wid = __builtin_amdgcn_readfirstlane(tid >> 6), lane = tid & 63, r32 = lane & 31, hi = lane >> 5;
  bf16* V_lds = (bf16*)lds; bf16* K_lds = (bf16*)(lds + 2 * SHM_V);
  float* ws = (float*)(lds + ATT_WS_OFF) + wid * 64; float* li_l = ws; float* al_l = ws + 32;
  float m_reg = -1e30f, l_reg = 0; f32x16 o[4] = {}; bf16x8 qr[8];
  { const unsigned qoff = (unsigned)((wid * QBLK + r32) * ZP + hi * 8) * 2u;
#pragma unroll
    for (int d0 = 0; d0 < 8; ++d0) qr[d0] = *reinterpret_cast<const bf16x8*>((const char*)Qb + qoff + d0 * 32); }
  const int sr = tid >> 4, sc = (tid & 15) * 8, vst0 = v_st(sr, sc), vst1 = v_st(32 + sr, sc);
  const LAS3 char* vp0 = (const LAS3 char*)V_lds + v_rd_base(lane);
  struct { bf16x8 vs0, vs1, ks0, ks1; } sr_[2];
  const unsigned soff = (unsigned)(sr * ZP + sc) * 2u;
#define SLOAD(i, k0) do { const char* vp_ = (const char*)Vh + (size_t)(k0) * (ZP * 2); const char* kp_ = (const char*)Kh + (size_t)(k0) * (ZP * 2); \
    sr_[i].vs0 = *reinterpret_cast<const bf16x8*>(vp_ + soff); sr_[i].vs1 = *reinterpret_cast<const bf16x8*>(vp_ + 32 * ZP * 2 + soff); \
    sr_[i].ks0 = *reinterpret_cast<const bf16x8*>(kp_ + soff); sr_[i].ks1 = *reinterpret_cast<const bf16x8*>(kp_ + 32 * ZP * 2 + soff); } while (0)
#define SWRITE(b, i) do { *(bf16x8*)((char*)V_lds + (b) * SHM_V + vst0) = sr_[i].vs0;          \
    *(bf16x8*)((char*)V_lds + (b) * SHM_V + vst1) = sr_[i].vs1; int kc = sc * 2;               \
    *(bf16x8*)((char*)K_lds + (b) * SHM_K + KSWZ(sr, kc)) = sr_[i].ks0;                       \
    *(bf16x8*)((char*)K_lds + (b) * SHM_K + KSWZ(32 + sr, kc)) = sr_[i].ks1; } while (0)
#define SWAIT() asm volatile("s_waitcnt vmcnt(4)" ::: "memory")
#define RESC(a) do { if (__any((a) < 1.f)) { if (hi == 0) al_l[r32] = (a); asm volatile("s_waitcnt lgkmcnt(0)" ::: "memory"); \
    _Pragma("unroll") for (int d = 0; d < 4; ++d) _Pragma("unroll") for (int r = 0; r < 16; ++r) o[d][r] *= al_l[crow(r, hi)]; } } while (0)
  f32x16 pA0, pA1, pB0, pB1; float mnA, mnB, alA, alB; bf16x8 pa0, pa1, pa2, pa3; const int NT = seq / KVBLK;
  constexpr int SE = 0, SO = 1;
  SLOAD(SE, 0); asm volatile("s_waitcnt vmcnt(0)" ::: "memory"); SWRITE(0, SE); __syncthreads();
  qkt(pA0, pA1, K_lds, qr, r32, hi); partialSM(pA0, pA1, m_reg, mnA, alA);
  SLOAD(SO, KVBLK); if (2 < NT) SLOAD(SE, 2 * KVBLK);
  SWAIT(); SWRITE(1, SO); __syncthreads();
  for (int j = 1; j + 1 < NT; j += 2) {
    SBAR(); qkt(pB0, pB1, (bf16*)((char*)K_lds + SHM_K), qr, r32, hi);
    finishSM(pA0, pA1, alA, l_reg, pa0, pa1, pa2, pa3); PIN_A(); SGB_A(); SBAR();
    SLOAD(SO, (j + 2) * KVBLK); SBAR();
    pv_all(o, vp0, pa0, pa1, pa2, pa3); partialSM_bf(pB0, pB1, m_reg, mnB, alB); PIN_B(pB0, pB1, alB); SGB_B(); SBAR();
    __syncthreads(); SWAIT(); SWRITE(0, SE);
    RESC(alB); __syncthreads();
    SBAR(); qkt(pA0, pA1, K_lds, qr, r32, hi);
    finishSM(pB0, pB1, alB, l_reg, pa0, pa1, pa2, pa3); PIN_A(); SGB_A(); SBAR();
    if (j + 3 < NT) SLOAD(SE, (j + 3) * KVBLK); SBAR();
    pv_all(o, vp0 + SHM_V, pa0, pa1, pa2, pa3); partialSM_bf(pA0, pA1, m_reg, mnA, alA); PIN_B(pA0, pA1, alA); SGB_B(); SBAR();
    __syncthreads(); SWAIT(); SWRITE(1, SO);
    RESC(alA); __syncthreads();
  }
  SBAR(); qkt(pB0, pB1, (bf16*)((char*)K_lds + SHM_K), qr, r32, hi);
  finishSM(pA0, pA1, alA, l_reg, pa0, pa1, pa2, pa3); SBAR();
  pv_all(o, vp0, pa0, pa1, pa2, pa3); partialSM(pB0, pB1, m_reg, mnB, alB);
  __syncthreads(); RESC(alB);
  finishSM(pB0, pB1, alB, l_reg, pa0, pa1, pa2, pa3); SBAR();
  pv_all(o, vp0 + SHM_V, pa0, pa1, pa2, pa3);
  store_gated<ZP>(o, l_reg, li_l, (float*)(lds + ATT_OST_OFF) + wid * 2048, Gb, Yb, wid, lane, r32, hi);
#undef SLOAD
#undef SWRITE
#undef SWAIT
}

template <bool SHIFT> __device__ __forceinline__ void fsSM1(f32x16& p0, float& ps, float nm) {
  _Pragma("unroll") for (int r = 0; r < 16; ++r) p0[r] = __builtin_amdgcn_exp2f(SHIFT ? p0[r] + nm : p0[r]);
  float s = p0[0];
  _Pragma("unroll") for (int r = 1; r < 16; ++r) s += p0[r];
  ps = s;
}
template <bool SHIFT> __device__ __forceinline__ void fsSM2(f32x16& p0, f32x16& p1, float ps, float nm, float& l_reg, bf16x8& pa0, bf16x8& pa1, bf16x8& pa2, bf16x8& pa3) {
  _Pragma("unroll") for (int r = 0; r < 16; ++r) p1[r] = __builtin_amdgcn_exp2f(SHIFT ? p1[r] + nm : p1[r]);
  _Pragma("unroll") for (int r = 0; r < 16; ++r) ps += p1[r];
  { auto rr = __builtin_amdgcn_permlane32_swap(__float_as_uint(ps), __float_as_uint(ps), false, false);
    ps = __uint_as_float(rr[0]) + __uint_as_float(rr[1]); }
  l_reg += ps;
  pack_p(p0, p1, pa0, pa1, pa2, pa3);
}
#define SGB_FA() do { __builtin_amdgcn_sched_group_barrier(0x100, 2, 0); _Pragma("unroll") for (int i_ = 0; i_ < 16; ++i_) { __builtin_amdgcn_sched_group_barrier(0x008, 1, 0); \
    __builtin_amdgcn_sched_group_barrier(0x100, 1, 0); __builtin_amdgcn_sched_group_barrier(0x400, 1, 0); __builtin_amdgcn_sched_group_barrier(0x002, 4, 0); } } while (0)
#define SGB_FB() do { __builtin_amdgcn_sched_group_barrier(0x100, 2, 0); _Pragma("unroll") for (int i_ = 0; i_ < 16; ++i_) { __builtin_amdgcn_sched_group_barrier(0x008, 1, 0); \
    __builtin_amdgcn_sched_group_barrier(0x100, 2, 0); __builtin_amdgcn_sched_group_barrier(0x400, 1, 0); __builtin_amdgcn_sched_group_barrier(0x002, 1, 0); } } while (0)
template <int ZP, bool SHIFT>
__device__ __forceinline__ void dense_unit_fs(const bf16* Qb, const bf16* Kh, const bf16* Vh, const bf16* Gb, bf16* Yb, int seq, float nm, char* lds) {
  int tid_ = threadIdx.x; asm volatile("" : "+v"(tid_));
  const int tid = tid_, wid = __builtin_amdgcn_readfirstlane(tid >> 6), lane = tid & 63, r32 = lane & 31, hi = lane >> 5;
  bf16* V_lds = (bf16*)lds; bf16* K_lds = (bf16*)(lds + 2 * SHM_V);
  float* ws = (float*)(lds + ATT_WS_OFF) + wid * 64; float* li_l = ws;
  float l_reg = 0; f32x16 o[4] = {}; bf16x8 qr[8];
  { const unsigned qoff = (unsigned)((wid * QBLK + r32) * ZP + hi * 8) * 2u;
#pragma unroll
    for (int d0 = 0; d0 < 8; ++d0) qr[d0] = *reinterpret_cast<const bf16x8*>((const char*)Qb + qoff + d0 * 32); }
  const int sr = tid >> 4, sc = (tid & 15) * 8, vst0 = v_st(sr, sc), vst1 = v_st(32 + sr, sc);
  const int vb0 = (int)(uintptr_t)V_lds + v_rd_base(lane);
  struct { bf16x8 vs0, vs1, ks0, ks1; } sr_[2];
  const unsigned soff = (unsigned)(sr * ZP + sc) * 2u;
#define SLOAD(i, k0) do { const char* vp_ = (const char*)Vh + (size_t)(k0) * (ZP * 2); const char* kp_ = (const char*)Kh + (size_t)(k0) * (ZP * 2); \
    sr_[i].vs0 = *reinterpret_cast<const bf16x8*>(vp_ + soff); sr_[i].vs1 = *reinterpret_cast<const bf16x8*>(vp_ + 32 * ZP * 2 + soff); \
    sr_[i].ks0 = *reinterpret_cast<const bf16x8*>(kp_ + soff); sr_[i].ks1 = *reinterpret_cast<const bf16x8*>(kp_ + 32 * ZP * 2 + soff); } while (0)
#define SWRITE(b, i) do { *(bf16x8*)((char*)V_lds + (b) * SHM_V + vst0) = sr_[i].vs0;          \
    *(bf16x8*)((char*)V_lds + (b) * SHM_V + vst1) = sr_[i].vs1; int kc = sc * 2;               \
    *(bf16x8*)((char*)K_lds + (b) * SHM_K + KSWZ(sr, kc)) = sr_[i].ks0;                       \
    *(bf16x8*)((char*)K_lds + (b) * SHM_K + KSWZ(32 + sr, kc)) = sr_[i].ks1; } while (0)
#define SWAIT() asm volatile("s_waitcnt vmcnt(4)" ::: "memory")
#define PINF_A() asm volatile("" : "+v"(pa0), "+v"(pa1), "+v"(pa2), "+v"(pa3), "+v"(l_reg))
#define PINF_B(P0, PS) asm volatile("" : "+v"(P0), "+v"(PS))
  f32x16 pA0, pA1, pB0, pB1; float psA, psB; bf16x8 pa0, pa1, pa2, pa3; const int NT = seq / KVBLK;
  constexpr int SE = 0, SO = 1;
  SLOAD(SE, 0); asm volatile("s_waitcnt vmcnt(0)" ::: "memory"); SWRITE(0, SE); __syncthreads();
  qkt(pA0, pA1, K_lds, qr, r32, hi); fsSM1<SHIFT>(pA0, psA, nm);
  SLOAD(SO, KVBLK); if (2 < NT) SLOAD(SE, 2 * KVBLK);
  SWAIT(); SWRITE(1, SO); __syncthreads();
  for (int j = 1; j + 1 < NT; j += 2) {
    SBAR(); qkt(pB0, pB1, (bf16*)((char*)K_lds + SHM_K), qr, r32, hi);
    fsSM2<SHIFT>(pA0, pA1, psA, nm, l_reg, pa0, pa1, pa2, pa3); SBAR();
    SLOAD(SO, (j + 2) * KVBLK); SBAR();
    pv_d0(o, vb0, pa0, pa1, pa2, pa3); fsSM1<SHIFT>(pB0, psB, nm); SBAR();
    __syncthreads(); SWAIT(); SWRITE(0, SE);
    __syncthreads();
    SBAR(); qkt(pA0, pA1, K_lds, qr, r32, hi);
    fsSM2<SHIFT>(pB0, pB1, psB, nm, l_reg, pa0, pa1, pa2, pa3); SBAR();
    if (j + 3 < NT) SLOAD(SE, (j + 3) * KVBLK); SBAR();
    pv_d0(o, vb0 + (int)SHM_V, pa0, pa1, pa2, pa3); fsSM1<SHIFT>(pA0, psA, nm); SBAR();
    __syncthreads(); SWAIT(); SWRITE(1, SO);
    __syncthreads();
  }
  SBAR(); qkt(pB0, pB1, (bf16*)((char*)K_lds + SHM_K), qr, r32, hi);
  fsSM2<SHIFT>(pA0, pA1, psA, nm, l_reg, pa0, pa1, pa2, pa3); SBAR();
  pv_d0(o, vb0, pa0, pa1, pa2, pa3); fsSM1<SHIFT>(pB0, psB, nm);
  __syncthreads();
  fsSM2<SHIFT>(pB0, pB1, psB, nm, l_reg, pa0, pa1, pa2, pa3); SBAR();
  pv_d0(o, vb0 + (int)SHM_V, pa0, pa1, pa2, pa3);
  store_gated<ZP>(o, l_reg, li_l, (float*)(lds + ATT_OST_OFF) + wid * 2048, Gb, Yb, wid, lane, r32, hi);
#undef SLOAD
#undef SWRITE
#undef SWAIT
#undef PINF_A
#undef PINF_B
}

typedef int v8i __attribute__((ext_vector_type(8)));
#ifndef F8_SCALE_B
#define F8_SCALE_B 0x7f7f7f7f
#endif
template <bool M4 = false>
__device__ __forceinline__ void qkt_f8(f32x16& p0, f32x16& p1, const LAS3 char* Ks, const v8i* q8, int kb0) {
  _Pragma("unroll") for (int r = 0; r < 16; ++r) { p0[r] = M4 ? -4.0f : 0.0f; p1[r] = M4 ? -4.0f : 0.0f; }
  _Pragma("unroll") for (int ks = 0; ks < 2; ++ks) {
    const int o0 = kb0 ^ (ks << 6);
    const u32x4 a0 = *(const LAS3 u32x4*)(Ks + o0), a1 = *(const LAS3 u32x4*)(Ks + (o0 ^ 16));
    const u32x4 b0 = *(const LAS3 u32x4*)(Ks + 4096 + o0), b1 = *(const LAS3 u32x4*)(Ks + 4096 + (o0 ^ 16));
    const v8i A0 = {(int)a0.x, (int)a0.y, (int)a0.z, (int)a0.w, (int)a1.x, (int)a1.y, (int)a1.z, (int)a1.w};
    const v8i A1 = {(int)b0.x, (int)b0.y, (int)b0.z, (int)b0.w, (int)b1.x, (int)b1.y, (int)b1.z, (int)b1.w};
    p0 = __builtin_amdgcn_mfma_scale_f32_32x32x64_f8f6f4(A0, q8[ks], p0, 0, 0, 0, 0x7f7f7f7f, 0, F8_SCALE_B);
    p1 = __builtin_amdgcn_mfma_scale_f32_32x32x64_f8f6f4(A1, q8[ks], p1, 0, 0, 0, 0x7f7f7f7f, 0, F8_SCALE_B); }
}
template <int ZP, bool SHIFT, bool OUT8>
__device__ __forceinline__ void dense_unit_f8(const unsigned char* Q8b, const unsigned char* K8h, const bf16* Vh, const bf16* Gb, bf16* Yb, int seq, float nm, char* lds) {
  int tid_ = threadIdx.x; asm volatile("" : "+v"(tid_));
  const int tid = tid_, wid = __builtin_amdgcn_readfirstlane(tid >> 6), lane = tid & 63, r32 = lane & 31, hi = lane >> 5;
  bf16* V_lds = (bf16*)lds; const LAS3 char* K_l = (const LAS3 char*)lds + 2 * SHM_V;
  float* ws = (float*)(lds + ATT_WS_OFF) + wid * 64; float* li_l = ws;
  float l_reg = 0; f32x16 o[4] = {}; v8i q8[2];
  { const unsigned char* qp = Q8b + (size_t)(wid * QBLK + r32) * 2048 + 32 * hi;
#pragma unroll
    for (int ks = 0; ks < 2; ++ks) { const u32x4 x = *(const u32x4*)(qp + 64 * ks), y = *(const u32x4*)(qp + 64 * ks + 16);
      q8[ks] = (v8i){(int)x.x, (int)x.y, (int)x.z, (int)x.w, (int)y.x, (int)y.y, (int)y.z, (int)y.w}; } }
  const int sr = tid >> 4, sc = (tid & 15) * 8, vst0 = v_st(sr, sc), vst1 = v_st(32 + sr, sc);
  const int kr = tid >> 3, kc = tid & 7, kst = kr * 128 + ((kc ^ ((kr >> 1) & 7)) << 4);
  const int kb0 = r32 * 128 + (((2 * hi) ^ ((r32 >> 1) & 7)) << 4);
  const int vb0 = (int)(uintptr_t)V_lds + v_rd_base(lane);
  struct { bf16x8 vs0, vs1; u32x4 k8; } sr_[2];
  const unsigned soff = (unsigned)(sr * ZP + sc) * 2u, koff = (unsigned)(kr * 512 + kc * 16);
#define SLOAD(i, k0) do { const char* vp_ = (const char*)Vh + (size_t)(k0) * (ZP * 2); \
    sr_[i].vs0 = *reinterpret_cast<const bf16x8*>(vp_ + soff); sr_[i].vs1 = *reinterpret_cast<const bf16x8*>(vp_ + 32 * ZP * 2 + soff); \
    sr_[i].k8 = *reinterpret_cast<const u32x4*>(K8h + (size_t)(k0) * 512 + koff); } while (0)
#define SWRITE(b, i) do { *(bf16x8*)((char*)V_lds + (b) * SHM_V + vst0) = sr_[i].vs0; *(bf16x8*)((char*)V_lds + (b) * SHM_V + vst1) = sr_[i].vs1; \
    *(LAS3 u32x4*)((LAS3 char*)K_l + (b) * SHM_K + kst) = sr_[i].k8; } while (0)
#define SWAIT() asm volatile("s_waitcnt vmcnt(3)" ::: "memory")
  f32x16 pA0, pA1, pB0, pB1; float psA, psB; bf16x8 pa0, pa1, pa2, pa3; const int NT = seq / KVBLK;
  constexpr int SE = 0, SO = 1;
  SLOAD(SE, 0); asm volatile("s_waitcnt vmcnt(0)" ::: "memory"); SWRITE(0, SE); __syncthreads();
  qkt_f8(pA0, pA1, K_l, q8, kb0); fsSM1<SHIFT>(pA0, psA, nm);
  SLOAD(SO, KVBLK); if (2 < NT) SLOAD(SE, 2 * KVBLK);
  SWAIT(); SWRITE(1, SO); __syncthreads();
  for (int j = 1; j + 1 < NT; j += 2) {
    SBAR(); qkt_f8(pB0, pB1, K_l + SHM_K, q8, kb0);
    fsSM2<SHIFT>(pA0, pA1, psA, nm, l_reg, pa0, pa1, pa2, pa3); SBAR();
    SLOAD(SO, (j + 2) * KVBLK); SBAR();
    pv_d0(o, vb0, pa0, pa1, pa2, pa3); fsSM1<SHIFT>(pB0, psB, nm);
    __syncthreads(); SWAIT(); SWRITE(0, SE);
    __syncthreads();
    SBAR(); qkt_f8(pA0, pA1, K_l, q8, kb0);
    fsSM2<SHIFT>(pB0, pB1, psB, nm, l_reg, pa0, pa1, pa2, pa3); SBAR();
    if (j + 3 < NT) SLOAD(SE, (j + 3) * KVBLK); SBAR();
    pv_d0(o, vb0 + (int)SHM_V, pa0, pa1, pa2, pa3); fsSM1<SHIFT>(pA0, psA, nm);
    __syncthreads(); SWAIT(); SWRITE(1, SO);
    __syncthreads();
  }
  SBAR(); qkt_f8(pB0, pB1, K_l + SHM_K, q8, kb0);
  fsSM2<SHIFT>(pA0, pA1, psA, nm, l_reg, pa0, pa1, pa2, pa3); SBAR();
  pv_d0(o, vb0, pa0, pa1, pa2, pa3); fsSM1<SHIFT>(pB0, psB, nm);
  __syncthreads();
  fsSM2<SHIFT>(pB0, pB1, psB, nm, l_reg, pa0, pa1, pa2, pa3); SBAR();
  pv_d0(o, vb0 + (int)SHM_V, pa0, pa1, pa2, pa3);
  store_gated<ZP, OUT8>(o, l_reg, li_l, (float*)(lds + ATT_OST_OFF) + wid * 2048, Gb, Yb, wid, lane, r32, hi);
#undef SLOAD
#undef SWRITE
#undef SWAIT
}

template <bool CLAMP> __device__ __forceinline__ void f8SM1(f32x16& p0) {
  _Pragma("unroll") for (int r = 0; r < 16; ++r) { const float e = __builtin_amdgcn_exp2f(p0[r]); p0[r] = CLAMP ? fminf(e, 49152.0f) : e; }
}
template <bool CLAMP> __device__ __forceinline__ void f8SM2(const f32x16& p0, f32x16& p1, v8i& P8) {
  _Pragma("unroll") for (int r = 0; r < 16; ++r) { const float e = __builtin_amdgcn_exp2f(p1[r]); p1[r] = CLAMP ? fminf(e, 49152.0f) : e; }
  _Pragma("unroll") for (int i = 0; i < 4; ++i) {
    int a = __builtin_amdgcn_cvt_pk_bf8_f32(p0[4 * i], p0[4 * i + 1], 0, false); a = __builtin_amdgcn_cvt_pk_bf8_f32(p0[4 * i + 2], p0[4 * i + 3], a, true);
    int b = __builtin_amdgcn_cvt_pk_bf8_f32(p1[4 * i], p1[4 * i + 1], 0, false); b = __builtin_amdgcn_cvt_pk_bf8_f32(p1[4 * i + 2], p1[4 * i + 3], b, true);
    auto r = __builtin_amdgcn_permlane32_swap((unsigned)a, (unsigned)b, false, false);
    P8[2 * i] = (int)r[0]; P8[2 * i + 1] = (int)r[1]; }
}
__device__ __forceinline__ void pv_f8(f32x16* o, f32x16& osum, const LAS3 char* Vs, int vb8, const v8i& P8, const v8i& ones8, int one) {
  _Pragma("unroll") for (int db = 0; db < 4; ++db) {
    const u32x4 x = *(const LAS3 u32x4*)(Vs + db * 2048 + vb8), y = *(const LAS3 u32x4*)(Vs + db * 2048 + (vb8 ^ 16));
    const v8i V8 = {(int)x.x, (int)x.y, (int)x.z, (int)x.w, (int)y.x, (int)y.y, (int)y.z, (int)y.w};
    asm volatile("v_mfma_scale_f32_32x32x64_f8f6f4 %0, %1, %2, %0, %3, %3 op_sel_hi:[0,0,0] cbsz:1" : "+v"(o[db]) : "v"(P8), "v"(V8), "v"(one)); }
  asm volatile("v_mfma_scale_f32_32x32x64_f8f6f4 %0, %1, %2, %0, %3, %3 op_sel_hi:[0,0,0] cbsz:1" : "+v"(osum) : "v"(P8), "v"(ones8), "v"(one));
}
template <int ZP, bool OUT8, bool CLAMP>
__device__ __forceinline__ void dense_unit_f8pv(const unsigned char* Q8b, const unsigned char* K8h, const unsigned char* VT8h, int vt_pitch, const bf16* Gb, bf16* Yb, int seq, char* lds) {
  int tid_ = threadIdx.x; asm volatile("" : "+v"(tid_));
  const int tid = tid_, wid = __builtin_amdgcn_readfirstlane(tid >> 6), lane = tid & 63, r32 = lane & 31, hi = lane >> 5;
  const LAS3 char* V_l = (const LAS3 char*)lds;
  const LAS3 char* K_l = (const LAS3 char*)lds + 2 * 16384;
  float* ws = (float*)(lds + ATT_WS_OFF) + wid * 64; float* li_l = ws;
  f32x16 o[4] = {}, osum = {}; v8i q8[2];
  v8i ones8; { int o1 = 0x38383838; asm volatile("" : "+v"(o1)); _Pragma("unroll") for (int i = 0; i < 8; ++i) ones8[i] = o1; }
  { const unsigned char* qp = Q8b + (size_t)(wid * QBLK + r32) * 2048 + 32 * hi;
#pragma unroll
    for (int ks = 0; ks < 2; ++ks) { const u32x4 x = *(const u32x4*)(qp + 64 * ks), y = *(const u32x4*)(qp + 64 * ks + 16);
      q8[ks] = (v8i){(int)x.x, (int)x.y, (int)x.z, (int)x.w, (int)y.x, (int)y.y, (int)y.z, (int)y.w}; } }
  const int kr = tid >> 3, kc = tid & 7, kst = kr * 128 + ((kc ^ ((kr >> 1) & 7)) << 4);
  const int vd = tid >> 2, vc = tid & 3, vst = vd * 64 + ((vc ^ ((vd >> 2) & 3)) << 4);
  const int kb0 = r32 * 128 + (((2 * hi) ^ ((r32 >> 1) & 7)) << 4);
  const int vb8 = r32 * 64 + (((2 * hi) ^ ((r32 >> 2) & 3)) << 4);
  int one = 0x7f7f7f7f; asm volatile("" : "+v"(one));
  struct { u32x4 v8a, k8a, v8b, k8b; } sr_[2];
  const unsigned koff = (unsigned)(kr * 512 + kc * 16); const size_t voff = (size_t)vd * vt_pitch + vc * 16;
#define SLOAD(i, k0) do { sr_[i].v8a = *reinterpret_cast<const u32x4*>(VT8h + voff + (k0)); sr_[i].k8a = *reinterpret_cast<const u32x4*>(K8h + (size_t)(k0) * 512 + koff); \
    sr_[i].v8b = *reinterpret_cast<const u32x4*>(VT8h + voff + (k0) + 64); sr_[i].k8b = *reinterpret_cast<const u32x4*>(K8h + (size_t)((k0) + 64) * 512 + koff); } while (0)
#define SWRITE(b, i) do { *(LAS3 u32x4*)((LAS3 char*)V_l + (b) * 16384 + vst) = sr_[i].v8a; *(LAS3 u32x4*)((LAS3 char*)K_l + (b) * 16384 + kst) = sr_[i].k8a; \
    *(LAS3 u32x4*)((LAS3 char*)V_l + (b) * 16384 + 8192 + vst) = sr_[i].v8b; *(LAS3 u32x4*)((LAS3 char*)K_l + (b) * 16384 + 8192 + kst) = sr_[i].k8b; } while (0)
#define SWAIT() asm volatile("s_waitcnt vmcnt(4)" ::: "memory")
#define TBAR() do { asm volatile("s_waitcnt lgkmcnt(0)" ::: "memory"); __builtin_amdgcn_s_barrier(); asm volatile("" ::: "memory"); } while (0)
  f32x16 p0, p1; v8i P8; const int NT = seq / (2 * KVBLK);
  constexpr int SE = 0, SO = 1;
#define TCL(t) (((t) < NT ? (t) : NT - 1) * (2 * KVBLK))
#define SUBT(SL, H) do { qkt_f8<true>(p0, p1, K_l + (SL) * 16384 + (H) * 8192, q8, kb0); f8SM1<CLAMP>(p0); f8SM2<CLAMP>(p0, p1, P8); SBAR(); \
    pv_f8(o, osum, V_l + (SL) * 16384 + (H) * 8192, vb8, P8, ones8, one); } while (0)
#define STEP(SL, SETN, jn) do { SWAIT(); SWRITE(1 - (SL), SETN); SLOAD(SETN, TCL(jn)); SBAR(); SUBT(SL, 0); SBAR(); SUBT(SL, 1); TBAR(); } while (0)
  SLOAD(SE, 0); asm volatile("s_waitcnt vmcnt(0)" ::: "memory"); SWRITE(0, SE); SLOAD(SO, 2 * KVBLK); SLOAD(SE, 4 * KVBLK); TBAR();
  for (int j = 0; j < NT; j += 2) {
    STEP(0, SO, j + 3);
    STEP(1, SE, j + 4);
  }
#undef SUBT
#undef STEP
#undef TCL
#undef TBAR
  asm volatile("s_nop 15\n\ts_nop 15" ::: "memory");
  if (r32 == 0) { _Pragma("unroll") for (int r = 0; r < 16; ++r) li_l[crow(r, hi)] = osum[r]; }
  store_gated<ZP, OUT8>(o, 0.f, li_l, (float*)(lds + ATT_OST_OFF) + wid * 2048, Gb, Yb, wid, lane, r32, hi, true);
#undef SLOAD
#undef SWRITE
#undef SWAIT
}

template <int MODE, int ZP, bool WLOC = false, int KVP = ZP, int VAR = 0>
__device__ __forceinline__ void local_unit(const bf16* Qb, const bf16* Kh, const bf16* Vh, const bf16* Gb, bf16* Yb, char* lds,
                                           int jlo, int jhi, int wlo, int whi, int pa, float fa, float fb, const float* rpbh, int rot = 0) {
  int tid_ = threadIdx.x; asm volatile("" : "+v"(tid_));
  const int tid = tid_, wid = __builtin_amdgcn_readfirstlane(tid >> 6), lane = tid & 63, r32 = lane & 31, hi = lane >> 5;
  bf16* V_lds = (bf16*)lds; bf16* K_lds = (bf16*)(lds + 2 * SHM_V);
  float* ws = (float*)(lds + ATT_WS_OFF) + wid * 64; float* li_l = ws; float* al_l = ws + 32;
  float* tab = (float*)(lds + ATT_TAB_OFF);
  __syncthreads();
  if (MODE == 1) { for (int i = tid; i < 465; i += 512) tab[64 + i] = rpbh[i] * LOG2E; }
  float m_reg = -1e30f, l_reg = 0; f32x16 o[4] = {}; bf16x8 qr[8];
  { const unsigned qoff = (unsigned)(((WLOC ? 0 : wid * QBLK) + r32) * ZP + hi * 8) * 2u;
#pragma unroll
    for (int d0 = 0; d0 < 8; ++d0) qr[d0] = *reinterpret_cast<const bf16x8*>((const char*)Qb + qoff + d0 * 32); }
  GateRegs GR; if (LU_GATE_EARLY) load_gate<ZP>(GR, Gb, WLOC ? 0 : wid * 32, lane);
  const int sr = tid >> 4, sc = (tid & 15) * 8, vst0 = v_st(sr, sc), vst1 = v_st(32 + sr, sc);
  const int vb0 = (int)(uintptr_t)V_lds + v_rd_base(lane);
  bf16x8 vs0, vs1, ks0, ks1;
  const unsigned soff = (unsigned)(sr * KVP + sc) * 2u;
#define LLOAD(k0) do { const char* vp_ = (const char*)Vh + (size_t)(k0) * (KVP * 2); const char* kp_ = (const char*)Kh + (size_t)(k0) * (KVP * 2); \
    vs0 = *reinterpret_cast<const bf16x8*>(vp_ + soff); vs1 = *reinterpret_cast<const bf16x8*>(vp_ + 32 * KVP * 2 + soff); \
    ks0 = *reinterpret_cast<const bf16x8*>(kp_ + soff); ks1 = *reinterpret_cast<const bf16x8*>(kp_ + 32 * KVP * 2 + soff); } while (0)
#define LWRITE(b) do { *(bf16x8*)((char*)V_lds + (b) * SHM_V + vst0) = vs0; *(bf16x8*)((char*)V_lds + (b) * SHM_V + vst1) = vs1; int kc = sc * 2;               \
    *(bf16x8*)((char*)K_lds + (b) * SHM_K + KSWZ(sr, kc)) = ks0; *(bf16x8*)((char*)K_lds + (b) * SHM_K + KSWZ(32 + sr, kc)) = ks1; } while (0)
  constexpr float C = SCALE * LOG2E;
  const float NEG_INF = -__builtin_inff();
  int cq = 0, cs = 0, tq = 0;
  if (MODE == 1) { cq = 32 * (wid & 1) + r32; cs = cq - 8; cs = cs < 0 ? 0 : (cs > 48 ? 48 : cs); }
  else { tq = pa + (WLOC ? 0 : wid * QBLK) + r32; }
  int j = jlo + rot;
  LLOAD(j * KVBLK);
  for (int t = jhi - jlo; t > 0; --t) {
    const int b = t & 1;
    int jn = j + 1; jn = jn >= jhi ? jlo : jn;
    if (!(VAR & 8)) { asm volatile("s_waitcnt vmcnt(0)" ::: "memory"); LWRITE(b);
    if (t > 1) LLOAD(jn * KVBLK); }
    __syncthreads();
    if (j >= wlo && j < whi) {
      f32x16 p0, p1;
      if (VAR & 1) { _Pragma("unroll") for (int r = 0; r < 16; ++r) { p0[r] = (float)(j + r) * 0.01f; p1[r] = (float)(j - r) * 0.01f; } }
      else qkt(p0, p1, (bf16*)((char*)K_lds + b * SHM_K), qr, r32, hi);
      if (VAR & 2) { l_reg += p0[0]; } else {
      if (MODE == 1) {
        const float* trow = tab + 64 + (j - pa + 7) * 31 + 15 + 4 * hi - cq;
        const int cb = 4 * hi - cs;
        float bv0[16], bv1[16];
#pragma unroll
        for (int r = 0; r < 16; ++r) { const int kc0 = (r & 3) + 8 * (r >> 2); bv0[r] = trow[kc0]; bv1[r] = trow[kc0 + 32]; }
#pragma unroll
        for (int r = 0; r < 16; ++r) { const int kc0 = (r & 3) + 8 * (r >> 2);
          const float x0 = fmaf(p0[r], C, bv0[r]), x1 = fmaf(p1[r], C, bv1[r]);
          p0[r] = ((unsigned)(kc0 + cb) < 16u) ? x0 : NEG_INF;
          p1[r] = ((unsigned)(kc0 + 32 + cb) < 16u) ? x1 : NEG_INF; }
      } else {
        const float basef = (float)(j * KVBLK + 4 * hi - tq);
#pragma unroll
        for (int r = 0; r < 16; ++r) { const float kcf = (float)((r & 3) + 8 * (r >> 2));
          const float d0 = fabsf(basef + kcf), d1 = fabsf(basef + (kcf + 32.0f));
          const float x0 = fmaf(d0, -fa, p0[r]), x1 = fmaf(d1, -fa, p1[r]);
          p0[r] = (d0 <= 128.0f) ? x0 : NEG_INF;
          p1[r] = (d1 <= 128.0f) ? x1 : NEG_INF; }
      }
      float pmax = p0[0];
#pragma unroll
      for (int r = 1; r < 16; ++r) pmax = fmaxf(pmax, p0[r]);
#pragma unroll
      for (int r = 0; r < 16; ++r) pmax = fmaxf(pmax, p1[r]);
      { auto rr = __builtin_amdgcn_permlane32_swap(__float_as_uint(pmax), __float_as_uint(pmax), false, false);
        pmax = fmaxf(__uint_as_float(rr[0]), __uint_as_float(rr[1])); }
      float mn = m_reg, alpha = 1.0f;
      if (!__all(pmax - m_reg <= 8.0f * LOG2E)) { mn = fmaxf(m_reg, pmax); alpha = __builtin_amdgcn_exp2f(m_reg - mn); m_reg = mn; }
      float ps = 0.f;
#pragma unroll
      for (int r = 0; r < 16; ++r) { p0[r] = __builtin_amdgcn_exp2f(p0[r] - mn); p1[r] = __builtin_amdgcn_exp2f(p1[r] - mn); ps += p0[r] + p1[r]; }
      { auto rr = __builtin_amdgcn_permlane32_swap(__float_as_uint(ps), __float_as_uint(ps), false, false);
        ps = __uint_as_float(rr[0]) + __uint_as_float(rr[1]); }
      l_reg = l_reg * alpha + ps;
      RESC(alpha);
      }
      bf16x8 pa0, pa1, pa2, pa3;
      pack_p(p0, p1, pa0, pa1, pa2, pa3);
      if (VAR & 4) { o[0][0] += (float)pa0[0] + (float)pa1[1] + (float)pa2[2] + (float)pa3[3]; }
      else pv_d0(o, vb0 + b * (int)SHM_V, pa0, pa1, pa2, pa3);
    }
    j = jn;
  }
  if (MODE == 2) l_reg += __builtin_amdgcn_exp2f(fb - m_reg);
  store_gated<ZP, false, LU_GATE_EARLY != 0>(o, l_reg, li_l, (float*)(lds + ATT_OST_OFF) + wid * 2048, Gb, Yb, wid, lane, r32, hi, false, WLOC ? 0 : wid * 32, &GR);
#undef LLOAD
#undef LWRITE
#undef RESC
}
#define PP_BAR() do { asm volatile("s_waitcnt lgkmcnt(0)" ::: "memory"); __builtin_amdgcn_s_barrier(); asm volatile("" ::: "memory"); } while (0)

template <int ZP, int VAR = 0>
__device__ __forceinline__ void dense_unit_pp(const bf16* Qb, const bf16* Kh, const bf16* Vh, const bf16* Gb, bf16* Yb, int NT, char* lds_g) {
  int tid_ = threadIdx.x; asm volatile("" : "+v"(tid_));
  const int tid = tid_, wid = __builtin_amdgcn_readfirstlane(tid >> 6), lane = tid & 63, r32 = lane & 31, hi = lane >> 5, grp = wid >> 2;
  LAS3 char* Vl = (LAS3 char*)lds_g; LAS3 char* Kl = Vl + 2 * SHM_V;
  float* ws = (float*)(lds_g + ATT_WS_OFF) + wid * 64; float* li_l = ws; float* al_l = ws + 32;
  float m_reg = -1e30f, l_reg = 0; f32x16 o[4] = {}; bf16x8 qr[8];
  { const unsigned qoff = (unsigned)((wid * QBLK + r32) * ZP + hi * 8) * 2u;
#pragma unroll
    for (int d0 = 0; d0 < 8; ++d0) qr[d0] = *reinterpret_cast<const bf16x8*>((const char*)Qb + qoff + d0 * 32); }
  const int sr = tid >> 4, sc = (tid & 15) * 8, vst0 = v_st(sr, sc), vst1 = v_st(32 + sr, sc), kst0 = KSWZ(sr, sc * 2), kst1 = KSWZ(32 + sr, sc * 2);
  const unsigned soff = (unsigned)(sr * ZP + sc) * 2u;
  const int vrb = v_rd_base(lane), kfb = r32 * 256 + ((hi * 16) ^ ((r32 & 7) << 4));
  bf16x8 aK0, aK1, aV0, aV1;
#define PP_TC(t) ((t) < NT ? (t) : NT - 1)
#define PP_GLD(r0, r1, base, t) do { const char* p_ = (const char*)(base) + (size_t)PP_TC(t) * (64 * ZP * 2); \
    r0 = *reinterpret_cast<const bf16x8*>(p_ + soff); r1 = *reinterpret_cast<const bf16x8*>(p_ + 32 * ZP * 2 + soff); } while (0)
#define PP_WRK(slot, r0, r1) do { *(LAS3 bf16x8*)(Kl + (slot) * SHM_K + kst0) = r0; *(LAS3 bf16x8*)(Kl + (slot) * SHM_K + kst1) = r1; } while (0)
#define PP_WRV(slot, r0, r1) do { *(LAS3 bf16x8*)(Vl + (slot) * SHM_V + vst0) = r0; *(LAS3 bf16x8*)(Vl + (slot) * SHM_V + vst1) = r1; } while (0)
#define PP_KF(Kp, rowoff, d0) (*(const LAS3 bf16x8*)((Kp) + (rowoff) + (kfb_ ^ ((d0) * 32))))
#define PP_KLD(dst, Kp, d0a) do { dst[0] = PP_KF(Kp, 0, d0a); dst[1] = PP_KF(Kp, 8192, d0a); dst[2] = PP_KF(Kp, 0, (d0a) + 1); dst[3] = PP_KF(Kp, 8192, (d0a) + 1); } while (0)
#define PP_KMM(src, d0a) do { p0 = __builtin_amdgcn_mfma_f32_32x32x16_bf16(src[0], qr[d0a], p0, 0, 0, 0); p1 = __builtin_amdgcn_mfma_f32_32x32x16_bf16(src[1], qr[d0a], p1, 0, 0, 0); \
    p0 = __builtin_amdgcn_mfma_f32_32x32x16_bf16(src[2], qr[(d0a) + 1], p0, 0, 0, 0); p1 = __builtin_amdgcn_mfma_f32_32x32x16_bf16(src[3], qr[(d0a) + 1], p1, 0, 0, 0); } while (0)
#define PP_VLD(dst, Vp, oda, ks0) do { dst[0] = vtr((Vp) + v_rd_off(oda, ks0, 0)); dst[1] = vtr((Vp) + v_rd_off(oda, ks0, 1)); dst[2] = vtr((Vp) + v_rd_off((oda) + 1, ks0, 0)); dst[3] = vtr((Vp) + v_rd_off((oda) + 1, ks0, 1)); \
    dst[4] = vtr((Vp) + v_rd_off(oda, (ks0) + 1, 0)); dst[5] = vtr((Vp) + v_rd_off(oda, (ks0) + 1, 1)); dst[6] = vtr((Vp) + v_rd_off((oda) + 1, (ks0) + 1, 0)); dst[7] = vtr((Vp) + v_rd_off((oda) + 1, (ks0) + 1, 1)); } while (0)
#define PP_PK(L, H) (bf16x8){L[0], L[1], L[2], L[3], H[0], H[1], H[2], H[3]}
#define PP_VMM(src, oda, pfa, pfb) do { o[oda] = __builtin_amdgcn_mfma_f32_32x32x16_bf16(pfa, PP_PK(src[0], src[1]), o[oda], 0, 0, 0); o[(oda) + 1] = __builtin_amdgcn_mfma_f32_32x32x16_bf16(pfa, PP_PK(src[2], src[3]), o[(oda) + 1], 0, 0, 0); \
    o[oda] = __builtin_amdgcn_mfma_f32_32x32x16_bf16(pfb, PP_PK(src[4], src[5]), o[oda], 0, 0, 0); o[(oda) + 1] = __builtin_amdgcn_mfma_f32_32x32x16_bf16(pfb, PP_PK(src[6], src[7]), o[(oda) + 1], 0, 0, 0); } while (0)
  f32x16 p0, p1; bf16x8 pa0, pa1, pa2, pa3;
#define RESC(a) do { if (__any((a) < 1.f)) { if (hi == 0) al_l[r32] = (a); asm volatile("s_waitcnt lgkmcnt(0)" ::: "memory"); \
    _Pragma("unroll") for (int d = 0; d < 4; ++d) _Pragma("unroll") for (int r = 0; r < 16; ++r) o[d][r] *= al_l[crow(r, hi)]; } } while (0)
#define PP_MF(KS, VS, DOQK) do { const LAS3 char* Kp_ = Kl + (KS) * SHM_K; const LAS3 char* Vp_ = Vl + (VS) * SHM_V + vrb; \
    bf16x8 ka_[4], kb_[4]; s16x4 va_[8], vb_[8]; int kfb_ = kfb; asm volatile("" : "+v"(kfb_)); \
    if (DOQK) { p0 = f32x16{}; p1 = f32x16{}; \
      PP_KLD(ka_, Kp_, 0); PP_KLD(kb_, Kp_, 2); SBAR(); PP_KMM(ka_, 0); SBAR(); PP_KLD(ka_, Kp_, 4); SBAR(); PP_KMM(kb_, 2); SBAR(); PP_KLD(kb_, Kp_, 6); SBAR(); \
      PP_KMM(ka_, 4); SBAR(); PP_VLD(va_, Vp_, 0, 0); SBAR(); PP_KMM(kb_, 6); SBAR(); } \
    else { PP_VLD(va_, Vp_, 0, 0); SBAR(); } \
    PP_VLD(vb_, Vp_, 0, 2); SBAR(); PP_VMM(va_, 0, pa0, pa1); SBAR(); PP_VLD(va_, Vp_, 2, 0); SBAR(); PP_VMM(vb_, 0, pa2, pa3); SBAR(); \
    PP_VLD(vb_, Vp_, 2, 2); SBAR(); PP_VMM(va_, 2, pa0, pa1); SBAR(); PP_VMM(vb_, 2, pa2, pa3); SBAR(); } while (0)
#define PP_SM() do { float mn_, al_; partialSM(p0, p1, m_reg, mn_, al_); finishSM(p0, p1, al_, l_reg, pa0, pa1, pa2, pa3); RESC(al_); } while (0)

  PP_GLD(aK0, aK1, Kh, 0); PP_GLD(aV0, aV1, Vh, 0);
  PP_WRK(0, aK0, aK1); PP_WRV(0, aV0, aV1);
  PP_GLD(aK0, aK1, Kh, 1);
  PP_WRK(1, aK0, aK1);
  PP_GLD(aK0, aK1, Kh, 2); PP_GLD(aV0, aV1, Vh, 1);
  PP_BAR();
  { const LAS3 char* Kp_ = Kl; bf16x8 ka_[4]; int kfb_ = kfb; asm volatile("" : "+v"(kfb_)); p0 = f32x16{}; p1 = f32x16{};
    PP_KLD(ka_, Kp_, 0); SBAR(); PP_KMM(ka_, 0); SBAR(); PP_KLD(ka_, Kp_, 2); SBAR(); PP_KMM(ka_, 2); SBAR(); PP_KLD(ka_, Kp_, 4); SBAR(); PP_KMM(ka_, 4); SBAR(); PP_KLD(ka_, Kp_, 6); SBAR(); PP_KMM(ka_, 6); SBAR(); }
  PP_SM();
  PP_BAR();
#define PP_STAGE(x, KSL, VSL) do { PP_WRK(KSL, aK0, aK1); PP_WRV(VSL, aV0, aV1); PP_GLD(aK0, aK1, Kh, (x) + 3); PP_GLD(aV0, aV1, Vh, (x) + 2); } while (0)
  if (grp == 1) { PP_STAGE(0, 0, 1); PP_BAR(); }
  for (int jt = 0; jt < NT; jt += 2) {
    if (grp == 0) PP_STAGE(jt, 0, 1);
    if (VAR != 2) { PP_MF(1, 0, true); } PP_BAR();
    if (grp == 1) PP_STAGE(jt + 1, 1, 0);
    if (VAR != 1) { PP_SM(); } PP_BAR();
    if (grp == 0) PP_STAGE(jt + 1, 1, 0);
    if (VAR != 2) { PP_MF(0, 1, jt + 2 < NT); } PP_BAR();
    if (grp == 1) PP_STAGE(jt + 2, 0, 1);
    if (VAR != 1 && jt + 2 < NT) { PP_SM(); }
    PP_BAR();
  }
  if (grp == 0) PP_BAR();
#undef PP_STAGE
  store_gated<ZP>(o, l_reg, li_l, (float*)(lds_g + ATT_OST_OFF) + wid * 2048, Gb, Yb, wid, lane, r32, hi);
#undef PP_TC
#undef PP_GLD
#undef PP_WRK
#undef PP_WRV
#undef PP_KF
#undef PP_KLD
#undef PP_KMM
#undef PP_VLD
#undef PP_PK
#undef PP_VMM
#undef PP_MF
#undef PP_SM
#undef RESC
}
}
constexpr int NWAVES = 8;
constexpr int S = 8192, DM = 4096, HD = 128, DEPTH = 4;
constexpr int NIN_E = 13312, NIN_O = 10240;
constexpr int E_QA = 0, E_KA = 2048, E_VA = 2560, E_QB = 3072, E_KB = 5120, E_VB = 7168, E_G = 9216;
constexpr int O_Q = 0, O_K = 4096, O_V = 5120, O_G = 6144;
constexpr float NORM_EPS = 1e-6f;
constexpr size_t MiB = 1u << 20;
#ifndef GATEB_F8
#define GATEB_F8 1
#endif
constexpr size_t WS_CTL = 0, CTL_ZERO_BYTES = 1 * MiB;
constexpr size_t WS_ROPE = 1 * MiB;
constexpr size_t WS_PART = 2 * MiB;
constexpr size_t WS_WIN_E = 8 * MiB, WIN_E_BYTES = (size_t)NIN_E * DM * 2;
constexpr size_t WS_WIN_O = WS_WIN_E + 2 * WIN_E_BYTES, WIN_O_BYTES = (size_t)NIN_O * DM * 2;
constexpr size_t WS_WOUT_E = WS_WIN_O + 2 * WIN_O_BYTES, WOUT_BYTES = (size_t)DM * DM * 2;
constexpr size_t WS_WOUT_O = WS_WOUT_E + 2 * WOUT_BYTES;
constexpr size_t WS_XB = WS_WOUT_O + 2 * WOUT_BYTES;
constexpr size_t WS_Y = WS_XB + (size_t)S * DM * 2;
constexpr size_t WS_Z = WS_Y + (size_t)S * DM * 2;
constexpr size_t WS_Q8 = WS_Z + (size_t)S * NIN_E * 2;
constexpr size_t WS_K8 = WS_Q8 + (size_t)S * 2048;
constexpr size_t WS_XB8 = WS_K8 + (size_t)S * 512;
constexpr size_t WS_W8 = WS_XB8 + (size_t)S * DM, W8_ROWS = GATEB_F8 ? 7168 : 5120, W8_BYTES = W8_ROWS * (size_t)DM;
constexpr size_t WS_VT8 = WS_W8 + 2 * W8_BYTES;
constexpr size_t WS_KVB = WS_VT8 + (size_t)512 * S;
constexpr size_t WS_XH = WS_KVB + (size_t)80 * S * 128 * 2;
constexpr size_t WS_END = WS_XH + (size_t)S * DM * 2;
constexpr float W8_SCALE = 64.0f;
constexpr int CW_BAR = 4096;
constexpr int RING_OFF = 0, RING_BYTES = 131072;
constexpr int LDSCTL_OFF = 143360, MISC_OFF = LDSCTL_OFF + 320;
constexpr int NRP_OFF = 131072;
constexpr int RSTD_OFF = 139264;
constexpr int LDS_BYTES = 147456;
static_assert(MISC_OFF + 128 <= LDS_BYTES && att::ATT_LDS_BYTES <= LDSCTL_OFF && RING_BYTES <= NRP_OFF && NRP_OFF + 8192 <= RSTD_OFF && RSTD_OFF + 1024 <= LDSCTL_OFF, "LDS map");

#define GAS __attribute__((address_space(1)))
#define LAS __attribute__((address_space(3)))
typedef unsigned short bf16;
typedef unsigned v4u __attribute__((ext_vector_type(4)));
typedef float f32x4 __attribute__((ext_vector_type(4)));
typedef GAS unsigned gu32;
#define LDS_WAIT() asm volatile("s_waitcnt lgkmcnt(0)" ::: "memory")
#define VM_WAIT() asm volatile("s_waitcnt vmcnt(0)" ::: "memory")
__device__ __forceinline__ unsigned pk2(float lo, float hi) { unsigned r; asm volatile("v_cvt_pk_bf16_f32 %0, %1, %2" : "=v"(r) : "v"(lo), "v"(hi)); return r; }
typedef _Float16 fh2 __attribute__((ext_vector_type(2)));
__device__ __forceinline__ unsigned pk2h(float lo, float hi) { const fh2 h = {(_Float16)lo, (_Float16)hi}; return __builtin_bit_cast(unsigned, h); }
#ifndef IN_F16
#define IN_F16 0
#endif
#define XB_TMO      128
#define XB_XCNT(j)  (256  + 64 * (j))
#define XB_XSUB(j)  (1280 + 64 * (j))
#define XB_XGEN(j)  (2304 + 64 * (j))
#define XB_TOP      3328
#define XB_TOPGEN   3392
#define XCD_BAR_WORDS 3456
#define XB_SPIN_CAP (1u << 18)

__device__ __forceinline__ unsigned xb_ld(unsigned* p)              { return __hip_atomic_load(p, __ATOMIC_RELAXED, __HIP_MEMORY_SCOPE_AGENT); }
__device__ __forceinline__ unsigned xb_add(unsigned* p, unsigned v) { return __hip_atomic_fetch_add(p, v, __ATOMIC_RELAXED, __HIP_MEMORY_SCOPE_AGENT); }
__device__ __forceinline__ unsigned xb_xcc_id() { return (unsigned)__builtin_amdgcn_s_getreg((3 << 11) | 20) & 0xFu; }
#define XB_SPIN(cond, bar) do { unsigned _sp = 0; while (cond) { __builtin_amdgcn_s_sleep(1); \
    if ((++_sp & 255u) == 0u) { if (xb_ld(&(bar)[XB_TMO])) break; if (_sp > XB_SPIN_CAP) { atomicAdd(&(bar)[XB_TMO], 1u); break; } } } } while (0)

struct XcdBarrier {
    unsigned* bar; unsigned x;
    volatile LAS unsigned* st;
};

__device__ __forceinline__ XcdBarrier xcd_barrier_post(unsigned* bar, volatile LAS unsigned* st) {
    XcdBarrier b; b.bar = bar; b.x = xb_xcc_id(); b.st = st;
    if (threadIdx.x == 0) (void)xb_add(&bar[XB_XCNT(b.x)], 1u);
    return b;
}
__device__ __forceinline__ void xcd_barrier_complete(unsigned* bar, unsigned x, unsigned& nloc, unsigned& nx) {
    const unsigned G = gridDim.x * gridDim.y * gridDim.z;
    unsigned sum, cnt, mine, sp = 0u;
    for (;;) {
        sum = 0u; cnt = 0u; mine = 0u;
#pragma unroll
        for (unsigned j = 0; j < 16; ++j) { const unsigned c = xb_ld(&bar[XB_XCNT(j)]); sum += c; cnt += (c > 0u) ? 1u : 0u; mine = (j == x) ? c : mine; }
        if (sum == G) break;
        __builtin_amdgcn_s_sleep(1);
        if ((++sp & 255u) == 0u) { if (xb_ld(&bar[XB_TMO])) break; if (sp > XB_SPIN_CAP) { atomicAdd(&bar[XB_TMO], 1u); break; } }
    }
    nloc = mine > 0u ? mine : 1u; nx = cnt > 0u ? cnt : 1u;
}

__device__ __forceinline__ void xcd_barrier(const XcdBarrier& b) {
    asm volatile("s_waitcnt vmcnt(0)" ::: "memory");
    __syncthreads();
    if (threadIdx.x == 0) {
        unsigned* bar = b.bar;
        __builtin_amdgcn_s_waitcnt(0);
        unsigned nloc = b.st[0], nx = b.st[1];
        if (nloc == 0u) { xcd_barrier_complete(bar, b.x, nloc, nx); b.st[0] = nloc; b.st[1] = nx; }
        const unsigned old = xb_add(&bar[XB_XSUB(b.x)], 1u);
        const unsigned gen = old / nloc;
        if (old + 1u == (gen + 1u) * nloc) {
            __builtin_amdgcn_fence(__ATOMIC_RELEASE, "agent");
            asm volatile("s_waitcnt vmcnt(0)" ::: "memory");
            const unsigned og = xb_add(&bar[XB_TOP], 1u);
            const unsigned tg = og / nx;
            if (og + 1u == (tg + 1u) * nx) xb_add(&bar[XB_TOPGEN], 1u);
            else XB_SPIN(xb_ld(&bar[XB_TOPGEN]) == tg, bar);
            __builtin_amdgcn_fence(__ATOMIC_ACQUIRE, "agent");
            xb_add(&bar[XB_XGEN(b.x)], 1u);
            asm volatile("s_waitcnt vmcnt(0)" ::: "memory");
        } else {
            XB_SPIN(xb_ld(&bar[XB_XGEN(b.x)]) == gen, bar);
            __builtin_amdgcn_fence(__ATOMIC_ACQUIRE, "agent");
            asm volatile("s_waitcnt vmcnt(0)" ::: "memory");
        }
    }
    __syncthreads();
}
#ifndef ITEM_KFAST
#define ITEM_KFAST 0
#endif
struct Frame {
    LAS unsigned char* lds;
    volatile LAS unsigned* MISC;
    gu32* ctl;
    int wave;
    int vcu, G;
};
__device__ __forceinline__ float wave_sum(float v) {
#pragma unroll
    for (int o = 1; o < 64; o <<= 1) v += __shfl_xor(v, o);
    return v;
}
struct ItemP { const float* W; int N; const float* kscale; bf16* WT; int item; int nperm; unsigned char* W8; int n8; int ksplit; int f16; };
__device__ __forceinline__ void ti_load(f32x4 (&v)[16], f32x4 (&ks)[2], const ItemP& P, int lane) {
    const float* W = P.W; const int N = P.N, item = P.item;
    const int kb = ITEM_KFAST ? (item & 63) : item / (N >> 6), nb = ITEM_KFAST ? (item >> 6) : item - kb * (N >> 6), k0 = kb << 6, n0 = nb << 6;
    const int lr = lane >> 4, lc = (lane & 15) << 2;
    { const float* kp = P.kscale ? P.kscale + k0 : W;
      ks[0] = *(const f32x4*)(kp + 8 * (lane & 7)); ks[1] = *(const f32x4*)(kp + 8 * (lane & 7) + 4); }
#pragma unroll
    for (int i = 0; i < 16; ++i) v[i] = *(const f32x4*)(W + (size_t)(k0 + 4 * i + lr) * N + n0 + lc);
}
__device__ __forceinline__ void ti_finish(f32x4 (&v)[16], const f32x4 (&ks)[2], const ItemP& P, LAS float* scr, int lane) {
    const int N = P.N, item = P.item, nperm = P.nperm, n8 = P.n8, ksplit = P.ksplit; bf16* WT = P.WT; unsigned char* W8 = P.W8; const bool f16 = P.f16 != 0;
    const int kb = ITEM_KFAST ? (item & 63) : item / (N >> 6), nb = ITEM_KFAST ? (item >> 6) : item - kb * (N >> 6), k0 = kb << 6, n0 = nb << 6;
    const int lr = lane >> 4, lc = (lane & 15) << 2; (void)lc;
#pragma unroll
    for (int i = 0; i < 16; ++i) { const int k = 4 * i + lr;
        *(LAS f32x4*)(scr + k * 64 + (lc ^ (((k >> 3) & 3) << 3))) = v[i]; }
    LDS_WAIT(); asm volatile("" ::: "memory");
    const int c = lane & 7, nn = lane >> 3, f = (c & 3) << 3;
    const bool hasg = P.kscale != nullptr; const f32x4 one4 = {1.f, 1.f, 1.f, 1.f}; const f32x4 g0 = hasg ? ks[0] : one4, g1 = hasg ? ks[1] : one4;
#pragma unroll
    for (int j = 0; j < 8; ++j) { const int n = nn + 8 * j; const LAS float* sp = scr + (8 * c) * 64 + (n ^ f);
                const float t0 = sp[0 * 64] * g0[0], t1 = sp[1 * 64] * g0[1], t2 = sp[2 * 64] * g0[2], t3 = sp[3 * 64] * g0[3], t4 = sp[4 * 64] * g1[0], t5 = sp[5 * 64] * g1[1], t6 = sp[6 * 64] * g1[2], t7 = sp[7 * 64] * g1[3];
        v4u o; if (f16) { o.x = pk2h(t0, t1); o.y = pk2h(t2, t3); o.z = pk2h(t4, t5); o.w = pk2h(t6, t7); }
        else { o.x = pk2(t0, t1); o.y = pk2(t2, t3); o.z = pk2(t4, t5); o.w = pk2(t6, t7); }
        const int cn = n0 + n, dn = cn < nperm ? (cn & ~63) + 8 * ((cn & 31) >> 2) + 4 * ((cn >> 5) & 1) + (cn & 3) : cn;
        const bool to8 = n8 > 0 && (n0 < 3072 || (n0 >= 9216 && n0 < (GATEB_F8 ? 13312 : 11264)));
        if (to8) { const int dn8 = n0 < 3072 ? dn : 3072 + (cn - 9216); int e0 = __builtin_amdgcn_cvt_pk_fp8_f32(t0 * W8_SCALE, t1 * W8_SCALE, 0, false); e0 = __builtin_amdgcn_cvt_pk_fp8_f32(t2 * W8_SCALE, t3 * W8_SCALE, e0, true);
            int e1 = __builtin_amdgcn_cvt_pk_fp8_f32(t4 * W8_SCALE, t5 * W8_SCALE, 0, false); e1 = __builtin_amdgcn_cvt_pk_fp8_f32(t6 * W8_SCALE, t7 * W8_SCALE, e1, true);
            typedef int i32x2t __attribute__((ext_vector_type(2))); *(GAS i32x2t*)(W8 + (size_t)dn8 * DM + k0 + 8 * c) = (i32x2t){e0, e1}; }
        else if (k0 < ksplit) { int e0 = __builtin_amdgcn_cvt_pk_fp8_f32(t0 * W8_SCALE, t1 * W8_SCALE, 0, false); e0 = __builtin_amdgcn_cvt_pk_fp8_f32(t2 * W8_SCALE, t3 * W8_SCALE, e0, true);
            int e1 = __builtin_amdgcn_cvt_pk_fp8_f32(t4 * W8_SCALE, t5 * W8_SCALE, 0, false); e1 = __builtin_amdgcn_cvt_pk_fp8_f32(t6 * W8_SCALE, t7 * W8_SCALE, e1, true);
            typedef int i32x2u __attribute__((ext_vector_type(2))); *(GAS i32x2u*)((GAS unsigned char*)(WT + (size_t)dn * DM) + k0 + 8 * c) = (i32x2u){e0, e1}; }
        else *(GAS v4u*)(WT + (size_t)dn * DM + k0 + 8 * c) = o; }
    LDS_WAIT(); asm volatile("" ::: "memory");
}
__device__ __forceinline__ void transpose_item(const float* W, int N, const float* kscale, bf16* WT, LAS float* scr, int item, int lane, int nperm = 0, unsigned char* W8 = nullptr, int n8 = 0, int ksplit = 0, bool f16 = false) {
    const ItemP P{W, N, kscale, WT, item, nperm, W8, n8, ksplit, f16 ? 1 : 0};
    f32x4 v[16], ks[2]; ti_load(v, ks, P, lane); ti_finish(v, ks, P, scr, lane);
}

__device__ __forceinline__ unsigned group_sync(gu32* cnt, unsigned need, unsigned* tmo, volatile LAS unsigned* bc) {
    asm volatile("s_waitcnt vmcnt(0)" ::: "memory");
    __syncthreads();
    if (threadIdx.x == 0) {
        __builtin_amdgcn_fence(__ATOMIC_RELEASE, "agent");
        asm volatile("s_waitcnt vmcnt(0)" ::: "memory");
        const unsigned ticket = __hip_atomic_fetch_add(cnt, 1u, __ATOMIC_RELAXED, __HIP_MEMORY_SCOPE_AGENT);
        unsigned sp = 0u;
        while (__hip_atomic_load(cnt, __ATOMIC_RELAXED, __HIP_MEMORY_SCOPE_AGENT) < need) { __builtin_amdgcn_s_sleep(1);
            if ((++sp & 255u) == 0u) { if (xb_ld(tmo)) break; if (sp > XB_SPIN_CAP) { atomicAdd(tmo, 1u); break; } } }
        __builtin_amdgcn_fence(__ATOMIC_ACQUIRE, "agent");
        asm volatile("s_waitcnt vmcnt(0)" ::: "memory");
        bc[0] = ticket;
    }
    __syncthreads();
    return bc[0];
}
constexpr int CW_GRP = 16384;

struct PanelOrder {
    int pm, k, f8;
    __device__ __forceinline__ bool next(int i, pg8::Unit& u) const {
        u.pm = pm;
#if GATEB_F8
        if (f8) { if (i < 3) { u.pn = k + 8 * i; return true; } if (i == 3 && k < 4) { u.pn = 24 + k; return true; } return false; }
        if (i < 3) { u.pn = 12 + k + 8 * i; return true; } return false;
#else
        if (f8) { if (i < 2) { u.pn = k + 8 * i; return true; } if (i == 2 && k < 4) { u.pn = 16 + k; return true; } return false; }
        if (i < 4) { const int j = k + 8 * i; u.pn = j < 24 ? 12 + j : 20 + j; return true; } return false;
#endif
    }
    __device__ __forceinline__ void a_ready(const pg8::Unit&) const {}
    __device__ __forceinline__ void done(const pg8::Unit&) const {}
};

struct Args { const float* in[11]; float* out; unsigned char* ws; int ph_lo, ph_hi; };
constexpr int PH_FINAL = 1 + 4 * DEPTH, PH_END = PH_FINAL + 1;
#ifndef DENSE_PP
#define DENSE_PP 1
#endif
#ifndef CONV_SH_LO
#define CONV_SH_LO 1
#endif
#ifndef CONV_SH_HI
#define CONV_SH_HI 2
#endif
#ifndef PV_F8
#define PV_F8 1
#endif
#ifndef OUT_F8
#define OUT_F8 1
#endif
#ifndef INP_F8
#define INP_F8 1
#endif
#ifndef DENSE_F8
#define DENSE_F8 1
#endif
#ifndef DENSE_FS
#define DENSE_FS 1
#endif
#ifndef F8_QS
#define F8_QS 1.0f
#endif
#if DENSE_F8
#define DENSE_QSCALE (att::SCALE * att::LOG2E * F8_QS)
#define DENSE_CALL(QO, KO, VP, GP, YP) do { const unsigned char* q8_ = ws + WS_Q8 + (size_t)(qb * 256) * 2048 + h * HD; const unsigned char* k8_ = ws + WS_K8 + kvh * HD; \
    bf16* yp_ = OUT_F8 ? (bf16*)((char*)Y + (size_t)(qb * 256) * (DM * 2) + h * HD) : (YP); \
    if (PV_F8) { if (dense_nm >= -19.5f) att::dense_unit_f8pv<NIN_E, OUT_F8 != 0, false>(q8_, k8_, ws + WS_VT8 + (size_t)kvh * HD * S, S, GP, yp_, S, al); \
                 else att::dense_unit_f8pv<NIN_E, OUT_F8 != 0, true>(q8_, k8_, ws + WS_VT8 + (size_t)kvh * HD * S, S, GP, yp_, S, al); }     \
    else if (dense_nm >= -40.0f) att::dense_unit_f8<NIN_E, false, OUT_F8 != 0>(q8_, k8_, VP, GP, yp_, S, dense_nm, al); else att::dense_unit_f8<NIN_E, true, OUT_F8 != 0>(q8_, k8_, VP, GP, yp_, S, dense_nm, al); } while (0)
#elif DENSE_FS
#define DENSE_QSCALE (att::SCALE * att::LOG2E)
#define DENSE_CALL(...) do { if (dense_nm >= -40.0f) att::dense_unit_fs<NIN_E, false>(__VA_ARGS__, S, dense_nm, al); else att::dense_unit_fs<NIN_E, true>(__VA_ARGS__, S, dense_nm, al); } while (0)
#elif DENSE_PP
#define DENSE_QSCALE 1.0f
#define DENSE_CALL(...) att::dense_unit_pp<NIN_E>(__VA_ARGS__, S / 64, al)
#else
#define DENSE_QSCALE 1.0f
#define DENSE_CALL(...) att::dense_unit<NIN_E>(__VA_ARGS__, S, al)
#endif
#ifndef ZP_O
#define ZP_O NIN_O
#endif
#ifndef WIN_GQA
#define WIN_GQA 1
#endif
#ifndef GROUP_SYNC
#define GROUP_SYNC 0
#endif
#ifndef TAIL_OUT_O
#define TAIL_OUT_O 0
#endif
#ifndef TAIL_INO_ITEMS
#define TAIL_INO_ITEMS 10240
#endif
#ifndef GEMM_ALIGN_OUT
#define GEMM_ALIGN_OUT true
#endif
#ifndef GEMM_SP2
#define GEMM_SP2 true
#endif
#ifndef GEMM_ALIGN
#define GEMM_ALIGN true
#endif
#ifndef REP_PRO
#define REP_PRO 1
#endif
#ifndef REP_IN
#define REP_IN 1
#endif
#ifndef REP_OUT0
#define REP_OUT0 1
#endif
#ifndef REP_DENSE
#define REP_DENSE 1
#endif
#ifndef CONV_SLOTS
#define CONV_SLOTS 1
#endif
#ifndef HM_ALL
#define HM_ALL 1
#endif
#ifndef RES_F16
#define RES_F16 15
#endif
constexpr bool res_combo(bool ob, bool nf, int parity) { for (int L = parity; L < DEPTH; L += 2) { const bool o = L > 0 && ((RES_F16 >> (L - 1)) & 1), n = !((RES_F16 >> L) & 1); if (o == ob && n == nf) return true; } return false; }
#ifndef NA_HALF_REPS
#define NA_HALF_REPS 0
#endif
#ifndef NA_HALF_DIV
#define NA_HALF_DIV 2
#endif
#ifndef NA_ROT
#define NA_ROT 1
#endif
#ifndef WIN_ROT
#define WIN_ROT 1
#endif
#ifndef REP_NA
#define REP_NA 1
#endif
#ifndef REP_LOCAL
#define REP_LOCAL 1
#endif

__global__ void __launch_bounds__(NWAVES * 64, 2) mk_fwd(Args args) {
    extern __shared__ __attribute__((aligned(16))) unsigned char lds[];
    Frame F;
    F.lds = (LAS unsigned char*)lds;
    F.MISC = (volatile LAS unsigned*)(F.lds + MISC_OFF);
    F.wave = __builtin_amdgcn_readfirstlane((int)threadIdx.x >> 6);
    F.G = gridDim.x; { const int bx = blockIdx.x; F.vcu = (F.G % 8 == 0) ? (bx % 8) * (F.G / 8) + bx / 8 : bx; }
    unsigned char* ws = args.ws;
    F.ctl = (gu32*)(ws + WS_CTL);
    for (int u = ((int)threadIdx.x); u < (LDS_BYTES - LDSCTL_OFF) / 4; u += NWAVES * 64) ((LAS unsigned*)(F.lds + LDSCTL_OFF))[u] = 0u;
    __syncthreads();
    const int lo = args.ph_lo, hi = args.ph_hi;
    const bool use_bar = (hi - lo) > 1;
    XcdBarrier bar; bar.bar = (unsigned*)(F.ctl + CW_BAR); bar.x = 0; bar.st = nullptr;
    if (use_bar) bar = xcd_barrier_post((unsigned*)(F.ctl + CW_BAR), F.MISC + 8);
#define IN(k) (lo <= (k) && (k) < hi)
#if defined(DIAG_IDLE)
    unsigned long long idle_acc = 0;
#define SEAM(k) do { if (IN(k) && IN((k) + 1)) { const unsigned long long t0_ = __builtin_amdgcn_s_memrealtime(); xcd_barrier(bar); \
        if ((DIAG_IDLE >> (k)) & 1) idle_acc += __builtin_amdgcn_s_memrealtime() - t0_; } } while (0)
#else
#define SEAM(k) do { if (IN(k) && IN((k) + 1)) xcd_barrier(bar); } while (0)
#endif

#if defined(DIAG_PHT)
    unsigned long long pht = 0;
    if (DIAG_PHT & 1) pht -= __builtin_amdgcn_s_memrealtime();
#undef SEAM
#define SEAM(k) do { if (IN(k) && IN((k) + 1)) xcd_barrier(bar); if ((DIAG_PHT >> (k)) & 1) pht += __builtin_amdgcn_s_memrealtime(); } while (0)
#define CLK_BEGIN(k) do { if ((k) > 0 && ((DIAG_PHT >> (k)) & 1)) pht -= __builtin_amdgcn_s_memrealtime(); } while (0)
#define CLK_END(k) do {} while (0)
#elif defined(DIAG_CLK)
    unsigned long long clk_m = 0, clk_r = 0;
#define CLK_BEGIN(k) do { if ((k) == DIAG_CLK) { clk_m -= __builtin_amdgcn_s_memtime(); clk_r -= __builtin_amdgcn_s_memrealtime(); } } while (0)
#define CLK_END(k) do { if ((k) == DIAG_CLK) { clk_m += __builtin_amdgcn_s_memtime(); clk_r += __builtin_amdgcn_s_memrealtime(); } } while (0)
#else
#define CLK_BEGIN(k) do {} while (0)
#define CLK_END(k) do {} while (0)
#endif
    const float* x_in = args.in[0];
    float* X = args.out;
    float* PART = (float*)(ws + WS_PART);
    bf16* XB = (bf16*)(ws + WS_XB); bf16* Y = (bf16*)(ws + WS_Y); bf16* Z = (bf16*)(ws + WS_Z); bf16* KVB = (bf16*)(ws + WS_KVB);
    unsigned short* XH = IN_F16 ? (unsigned short*)XB : (unsigned short*)(ws + WS_XH);
    static_assert(!IN_F16 || RES_F16 == 15, "IN_F16 needs the fp16 residual stream in every layer");
    float* ROPE = (float*)(ws + WS_ROPE);
    const int gw = F.vcu * NWAVES + F.wave, NGW = F.G * NWAVES;

    if (IN(0)) {
      _Pragma("nounroll") for (int rep = 0; rep < REP_PRO; ++rep) {
        LAS float* scr = (LAS float*)(F.lds + RING_OFF + F.wave * 16384);
        constexpr int I_INE = 64 * (NIN_E / 64), I_OUT = 64 * (DM / 64);
        constexpr int NITEMS = (CONV_SLOTS ? I_INE : 2 * I_INE + 4 * I_OUT) + 2 * (64 * (NIN_O / 64) - TAIL_INO_ITEMS);
        static_assert(!TAIL_OUT_O, "the prologue converts both out-projection weight sets");
        auto pro_item = [&](int it) __attribute__((always_inline)) -> ItemP {
            int r = it;
            if (r < I_INE) return ItemP{args.in[2], NIN_E, args.in[1], (bf16*)(ws + WS_WIN_E), r, E_VA, ws + WS_W8, INP_F8 ? (int)W8_ROWS : 0, 0, IN_F16 != 0};
            r -= I_INE;
            if (!CONV_SLOTS) {
            if (r < I_OUT) return ItemP{args.in[3], DM, nullptr, (bf16*)(ws + WS_WOUT_E), r, 0, nullptr, 0, OUT_F8 ? 2048 : 0, 0};
            r -= I_OUT;
            if (r < I_OUT) return ItemP{args.in[8], DM, nullptr, (bf16*)(ws + WS_WOUT_O), r, 0, nullptr, 0, 0, 0};
            r -= I_OUT;
            if (r < I_INE) return ItemP{args.in[2] + (size_t)DM * NIN_E, NIN_E, args.in[1] + 2 * DM, (bf16*)(ws + WS_WIN_E + WIN_E_BYTES), r, E_VA, ws + WS_W8 + W8_BYTES, INP_F8 ? (int)W8_ROWS : 0, 0, IN_F16 != 0};
            r -= I_INE;
            if (r < I_OUT) return ItemP{args.in[3] + (size_t)DM * DM, DM, nullptr, (bf16*)(ws + WS_WOUT_E + WOUT_BYTES), r, 0, nullptr, 0, OUT_F8 ? 2048 : 0, 0};
            r -= I_OUT;
            if (r < I_OUT) return ItemP{args.in[8] + (size_t)DM * DM, DM, nullptr, (bf16*)(ws + WS_WOUT_O + WOUT_BYTES), r, 0, nullptr, 0, 0, 0};
            r -= I_OUT;
            }
            constexpr int REST = 64 * (NIN_O / 64) - TAIL_INO_ITEMS; const int eo = r / (REST > 0 ? REST : 1); r -= eo * REST;
            return ItemP{args.in[7] + (size_t)eo * DM * NIN_O, NIN_O, args.in[1] + (2 * eo + 1) * DM, (bf16*)(ws + WS_WIN_O + eo * WIN_O_BYTES), TAIL_INO_ITEMS + r, 0, nullptr, 0, 0, IN_F16 != 0};
        };
        { int ln = ((int)threadIdx.x & 63); asm volatile("" : "+v"(ln));
          constexpr int LASTI = NITEMS - 1;
          int it = gw;
          if (it < NITEMS) {
            f32x4 va[16], vb[16], ka[2], kb[2];
            ItemP pa = pro_item(it), pb = pa;
            ti_load(va, ka, pa, ln);
            for (;;) {
                { const int itn = it + NGW; pb = pro_item(itn < NITEMS ? itn : LASTI); ti_load(vb, kb, pb, ln); asm volatile("" ::: "memory");
                  ti_finish(va, ka, pa, scr, ln); it = itn; if (it >= NITEMS) break; }
                { const int itn = it + NGW; pa = pro_item(itn < NITEMS ? itn : LASTI); ti_load(va, ka, pa, ln); asm volatile("" ::: "memory");
                  ti_finish(vb, kb, pb, scr, ln); it = itn; if (it >= NITEMS) break; }
            }
          }
        }
        for (int m = gw; m < S; m += NGW) {
            const GAS f32x4* xr = (const GAS f32x4*)(x_in + (size_t)m * DM) + ((int)threadIdx.x & 63);
            GAS unsigned long long* o8 = (GAS unsigned long long*)(XB + (size_t)m * DM) + ((int)threadIdx.x & 63);
            float ss = 0.f;
#pragma unroll
            for (int j = 0; j < 16; ++j) { const f32x4 v = xr[64 * j]; ss += (v.x * v.x + v.y * v.y) + (v.z * v.z + v.w * v.w);
                o8[64 * j] = IN_F16 ? ((unsigned long long)pk2h(v.x, v.y) | ((unsigned long long)pk2h(v.z, v.w) << 32)) : ((unsigned long long)pk2(v.x, v.y) | ((unsigned long long)pk2(v.z, v.w) << 32));
                if (INP_F8) { int e0 = __builtin_amdgcn_cvt_pk_fp8_f32(v.x, v.y, 0, false); e0 = __builtin_amdgcn_cvt_pk_fp8_f32(v.z, v.w, e0, true); ((GAS int*)(ws + WS_XB8 + (size_t)m * DM))[64 * j + ((int)threadIdx.x & 63)] = e0; } }
            ss = wave_sum(ss);
            PART[(size_t)m * 64 + ((int)threadIdx.x & 63)] = ((int)threadIdx.x & 63) == 0 ? ss : 0.f;
        }
        for (int i = blockIdx.x * 512 + ((int)threadIdx.x); i < 128 * 32; i += F.G * 512) {
            const int p = i >> 5, k = i & 31;
            double inv = 1.0; for (int q = 0; q < k; ++q) inv *= 0.7498942093324558;
            const double ang = (double)p * inv, n = __builtin_rint(ang * 0.6366197723675814);
            double r = __builtin_fma(-n, 1.5707963267948966, ang); r = __builtin_fma(-n, 6.123233995736766e-17, r);
            const double r2 = r * r;
            double sp = 2.8114572543455206e-15; sp = sp * r2 - 7.647163731819816e-13; sp = sp * r2 + 1.6059043836821613e-10; sp = sp * r2 - 2.505210838544172e-08; sp = sp * r2 + 2.7557319223985893e-06;
            sp = sp * r2 - 0.0001984126984126984; sp = sp * r2 + 0.008333333333333333; sp = sp * r2 - 0.16666666666666666; sp = sp * r2 + 1.0; sp *= r;
            double cp = 1.5619206968586225e-16; cp = cp * r2 - 4.779477332387385e-14; cp = cp * r2 + 1.1470745597729725e-11; cp = cp * r2 - 2.08767569878681e-09; cp = cp * r2 + 2.755731922398589e-07;
            cp = cp * r2 - 2.48015873015873e-05; cp = cp * r2 + 0.001388888888888889; cp = cp * r2 - 0.041666666666666664; cp = cp * r2 + 0.5; cp = 1.0 - cp * r2;
            const int q4 = (int)n & 3;
            const double cv = q4 == 0 ? cp : (q4 == 1 ? -sp : (q4 == 2 ? -cp : sp)), sv = q4 == 0 ? sp : (q4 == 1 ? cp : (q4 == 2 ? -sp : -cp));
            ROPE[2 * i] = (float)cv; ROPE[2 * i + 1] = (float)sv;
        }
      }
    }
    SEAM(0);

    int grp_ticket = 0, my_pm = 0;
    for (int L = 0; L < DEPTH; ++L) {
        const int e = L >> 1; const bool even = (L & 1) == 0;
        const int NIN = even ? NIN_E : NIN_O;
        const int pb = 1 + 4 * L;
        CLK_BEGIN(pb);
        if (IN(pb)) {
            const bf16* Wt = (const bf16*)(ws + (even ? WS_WIN_E + e * WIN_E_BYTES : WS_WIN_O + e * WIN_O_BYTES));
            pg8::Gemm g{XB, Wt, S, NIN, DM}; pg8::StaticOrder So; So.init(S, NIN, F.G, (int)blockIdx.x);
            LAS float* rstd = (LAS float*)(F.lds + RSTD_OFF);
            { pg8::Unit u0; So.next(0, u0);
                int t_ = ((int)threadIdx.x); asm volatile("" : "+v"(t_));
                const f32x4* pp = (const f32x4*)(PART + (size_t)(u0.pm * 256 + (t_ >> 1)) * 64 + (t_ & 1) * 32);
                f32x4 a = pp[0] + pp[1], b = pp[2] + pp[3], c = pp[4] + pp[5], d = pp[6] + pp[7]; a = (a + b) + (c + d);
                float s = (a[0] + a[1]) + (a[2] + a[3]); s += __shfl_xor(s, 1);
                if (!(t_ & 1)) rstd[t_ >> 1] = 1.0f / sqrtf(s * (1.0f / DM) + NORM_EPS);
                __syncthreads(); }
            pg8::EpiIn E{Z, even ? NIN_E : ZP_O, rstd, att::SCALE * att::LOG2E, even ? 0 : O_K / 256, KVB, HM_ALL ? (even ? E_QB / 256 : 0) : (even ? E_KB / 256 : O_K / 256), HM_ALL ? (even ? NIN_E / 256 : NIN_O / 256) : (even ? E_G / 256 : O_G / 256)};
#ifndef NO_GEMM_IN
            if (even) {
                PanelOrder Po; { pg8::Unit u0; So.next(0, u0); Po.pm = u0.pm; Po.k = ((int)blockIdx.x & 1) * 4 + ((int)blockIdx.x >> 6); }
                { pg8::EpiInA E8{Z, NIN_E, rstd, 1.0f / W8_SCALE, args.in[4] + e * HD, args.in[5] + e * HD, ROPE, (LAS float*)(F.lds + NRP_OFF), att::SCALE * att::LOG2E, ws + WS_Q8, ws + WS_K8, PV_F8 ? ws + WS_VT8 : nullptr, S, KVB};
                  pg8::Gemm g8{(const bf16*)(ws + WS_XB8), (const bf16*)(ws + WS_W8 + e * W8_BYTES), S, (int)W8_ROWS, DM / 2};
                  Po.f8 = 1; pg8::gemm_phase<pg8::EpiInA, PanelOrder, GEMM_ALIGN, GEMM_SP2, true>(F.lds + RING_OFF, g8, Po, E8); }
                Po.f8 = 0; pg8::gemm_phase<pg8::EpiIn, PanelOrder, GEMM_ALIGN, GEMM_SP2, false, 0, IN_F16 != 0>(F.lds + RING_OFF, g, Po, E);
                LAS float* scr = (LAS float*)(F.lds + RING_OFF + F.wave * 16384);
                constexpr int I_INO = 64 * (NIN_O / 64), SH_LO = CONV_SH_LO, SH_HI = CONV_SH_HI, PER_PANEL = I_INO / (S / 256);
                int ln = ((int)threadIdx.x & 63); asm volatile("" : "+v"(ln));
                constexpr int PER_LO = PER_PANEL * SH_LO / (4 * (SH_LO + SH_HI)), PER_HI = (PER_PANEL - 4 * PER_LO) / 4;
                const int i0 = Po.pm * PER_PANEL + (Po.k < 4 ? Po.k * PER_LO : 4 * PER_LO + (Po.k - 4) * PER_HI), i1 = i0 + (Po.k < 4 ? PER_LO : PER_HI);
                for (int it = i0 + F.wave; it < i1; it += NWAVES)
                    transpose_item(args.in[7] + (size_t)e * DM * NIN_O, NIN_O, args.in[1] + (2 * e + 1) * DM, (bf16*)(ws + WS_WIN_O + e * WIN_O_BYTES), scr, it, ln, 0, nullptr, 0, 0, IN_F16 != 0);
            } else {
            _Pragma("nounroll") for (int rep = 0; rep < REP_IN; ++rep)
            pg8::gemm_phase<pg8::EpiIn, pg8::StaticOrder, GEMM_ALIGN, GEMM_SP2, false, 0, IN_F16 != 0>(F.lds + RING_OFF, g, So, E);
            }
#endif
        }
        CLK_END(pb);
        SEAM(pb);
        CLK_BEGIN(pb + 2);
        if (IN(pb + 2)) {
            const int xcd = (int)blockIdx.x & 7, slot = (int)blockIdx.x >> 3;
            char* al = (char*)lds + RING_OFF;
            if (even) {
                float dense_nm;
                { const float* qw = args.in[4] + e * HD; const float* kw = args.in[5] + e * HD; int ln_ = (int)threadIdx.x & 63; asm volatile("" : "+v"(ln_));
                  float mq = fmaxf(fabsf(qw[ln_]), fabsf(qw[64 + ln_])), mk = fmaxf(fabsf(kw[ln_]), fabsf(kw[64 + ln_]));
#pragma unroll
                  for (int o_ = 1; o_ < 64; o_ <<= 1) { mq = fmaxf(mq, __shfl_xor(mq, o_)); mk = fmaxf(mk, __shfl_xor(mk, o_)); }
                  dense_nm = __builtin_amdgcn_readfirstlane(-(att::LOG2E * 11.313708498984761f * 1.01f) * mq * mk); }
#if CONV_SLOTS
                const int nd = (512 + F.G - 1) / F.G, cgrp = ((int)blockIdx.x >> 3) & 3;
                _Pragma("nounroll") for (int st = 0; st < 2 * nd; ++st) {
                    if (L == 0 && st == (cgrp < 2 * nd ? cgrp : 2 * nd - 1)) {
                        constexpr int I_INE = 64 * (NIN_E / 64), I_OUT = 64 * (DM / 64), NDEF = I_INE + 4 * I_OUT;
                        auto def_item = [&](int d) __attribute__((always_inline)) -> ItemP {
                            int r = d;
                            if (r < I_INE) return ItemP{args.in[2] + (size_t)DM * NIN_E, NIN_E, args.in[1] + 2 * DM, (bf16*)(ws + WS_WIN_E + WIN_E_BYTES), r, E_VA, ws + WS_W8 + W8_BYTES, INP_F8 ? (int)W8_ROWS : 0, 0, IN_F16 != 0};
                            r -= I_INE;
                            if (r < I_OUT) return ItemP{args.in[3] + (size_t)DM * DM, DM, nullptr, (bf16*)(ws + WS_WOUT_E + WOUT_BYTES), r, 0, nullptr, 0, OUT_F8 ? 2048 : 0, 0};
                            r -= I_OUT;
                            if (r < I_OUT) return ItemP{args.in[8] + (size_t)DM * DM, DM, nullptr, (bf16*)(ws + WS_WOUT_O + WOUT_BYTES), r, 0, nullptr, 0, 0, 0};
                            r -= I_OUT;
                            if (r < I_OUT) return ItemP{args.in[3], DM, nullptr, (bf16*)(ws + WS_WOUT_E), r, 0, nullptr, 0, OUT_F8 ? 2048 : 0, 0};
                            r -= I_OUT;
                            return ItemP{args.in[8], DM, nullptr, (bf16*)(ws + WS_WOUT_O), r, 0, nullptr, 0, 0, 0};
                        };
                        const int per = (NDEF + F.G - 1) / F.G, d0 = (int)blockIdx.x * per, d1 = d0 + per < NDEF ? d0 + per : NDEF;
                        LAS float* scr = (LAS float*)(F.lds + RING_OFF + F.wave * 16384);
                        int ln = ((int)threadIdx.x & 63); asm volatile("" : "+v"(ln));
                        __syncthreads();
                        int it = d0 + F.wave;
                        if (it < d1) {
                            f32x4 va[16], vb[16], ka[2], kb[2];
                            ItemP pa = def_item(it), pb = pa;
                            ti_load(va, ka, pa, ln);
                            for (;;) {
                                { const int itn = it + NWAVES; pb = def_item(itn < d1 ? itn : d1 - 1); ti_load(vb, kb, pb, ln); asm volatile("" ::: "memory");
                                  ti_finish(va, ka, pa, scr, ln); it = itn; if (it >= d1) break; }
                                { const int itn = it + NWAVES; pa = def_item(itn < d1 ? itn : d1 - 1); ti_load(va, ka, pa, ln); asm volatile("" ::: "memory");
                                  ti_finish(vb, kb, pb, scr, ln); it = itn; if (it >= d1) break; }
                            }
                        }
                        __syncthreads();
                    }
                    const int u = (int)blockIdx.x + (st < nd ? st : st - nd) * F.G;
                    if (u >= 512) continue;
                    if (st < nd) {
                        const int h = (u / 256) * 8 + (u & 7), qb = (u & 255) >> 3, kvh = h >> 2;
                        const bf16* Zq = Z + (size_t)(qb * 256) * NIN_E;
                        DENSE_CALL(Zq + E_QA + h * HD, Z + E_KA + kvh * HD, Z + E_VA + kvh * HD, Zq + E_G + h * HD, Y + (size_t)(qb * 256) * DM + h * HD);
                    } else {
                        const int h = (u / 256) * 8 + (u & 7), blk = (u & 255) >> 3;
                        const int r0 = 4 * blk, rw = r0 + (F.wave >> 1);
                        int jlo = r0 - 4; jlo = jlo < 0 ? 0 : (jlo > 120 ? 120 : jlo);
                        int jh = r0 + 3 - 4; jh = jh < 0 ? 0 : (jh > 120 ? 120 : jh); jh += 8;
                        int wlo = rw - 4; wlo = wlo < 0 ? 0 : (wlo > 120 ? 120 : wlo);
                        const bf16* Zq = Z + (size_t)(blk * 256) * NIN_E; (void)Zq;
                    att::local_unit<1, HM_ALL ? HD : NIN_E, false, 128>(HM_ALL ? KVB + ((size_t)h * S + blk * 256) * HD : Zq + E_QB + h * HD, KVB + (size_t)((HM_ALL ? 16 : 0) + h) * S * HD, KVB + (size_t)((HM_ALL ? 32 : 16) + h) * S * HD, HM_ALL ? KVB + ((size_t)(64 + h) * S + blk * 256) * HD : Zq + E_G + 2048 + h * HD, Y + (size_t)(blk * 256) * DM + 2048 + h * HD, al,
                                              jlo, jh, wlo, wlo + 8, rw, 0.f, 0.f, args.in[6] + ((size_t)e * 16 + h) * 465, (NA_ROT && jh - jlo == 12) ? (12 - jlo % 12) % 12 : 0);
                    }
                }
#else
                _Pragma("nounroll") for (int rep = 0; rep < REP_DENSE; ++rep)
                for (int u = (int)blockIdx.x; u < 512; u += F.G) {
                    const int h = (u / 256) * 8 + (u & 7), qb = (u & 255) >> 3, kvh = h >> 2;
                    const bf16* Zq = Z + (size_t)(qb * 256) * NIN_E;
#ifndef NO_DENSE
                    DENSE_CALL(Zq + E_QA + h * HD, Z + E_KA + kvh * HD, Z + E_VA + kvh * HD, Zq + E_G + h * HD, Y + (size_t)(qb * 256) * DM + h * HD);
#endif
                }
#if defined(PROBE_DENSE_VAR)
                if (L == 0) for (int u = (int)blockIdx.x; u < 512; u += F.G) {
                    const int h = (u / 256) * 8 + (u & 7), qb = (u & 255) >> 3, kvh = h >> 2;
                    const bf16* Zq = Z + (size_t)(qb * 256) * NIN_E;
                    att::dense_unit_pp<NIN_E, PROBE_DENSE_VAR>(Zq + E_QA + h * HD, Z + E_KA + kvh * HD, Z + E_VA + kvh * HD, Zq + E_G + h * HD, (bf16*)(ws + 900 * MiB) + (size_t)(qb * 256) * DM + h * HD, S / 64, al);
                }
#endif
                _Pragma("nounroll") for (int rep = 0; rep < REP_LOCAL * REP_NA; ++rep)
                for (int u = (int)blockIdx.x; u < 512; u += F.G) {
                    const int h = (u / 256) * 8 + (u & 7), blk = (u & 255) >> 3;
                    const int r0 = 4 * blk, rw = r0 + (F.wave >> 1);
                    int jlo = r0 - 4; jlo = jlo < 0 ? 0 : (jlo > 120 ? 120 : jlo);
                    int jh = r0 + 3 - 4; jh = jh < 0 ? 0 : (jh > 120 ? 120 : jh); jh += 8;
                    int wlo = rw - 4; wlo = wlo < 0 ? 0 : (wlo > 120 ? 120 : wlo);
                    const bf16* Zq = Z + (size_t)(blk * 256) * NIN_E;
#ifndef NO_NA
                    att::local_unit<1, HM_ALL ? HD : NIN_E, false, 128>(HM_ALL ? KVB + ((size_t)h * S + blk * 256) * HD : Zq + E_QB + h * HD, KVB + (size_t)((HM_ALL ? 16 : 0) + h) * S * HD, KVB + (size_t)((HM_ALL ? 32 : 16) + h) * S * HD, HM_ALL ? KVB + ((size_t)(64 + h) * S + blk * 256) * HD : Zq + E_G + 2048 + h * HD, Y + (size_t)(blk * 256) * DM + 2048 + h * HD, al,
                                              jlo, (rep < NA_HALF_REPS) ? jlo + (jh - jlo) / NA_HALF_DIV : jh, wlo, wlo + 8, rw, 0.f, 0.f, args.in[6] + ((size_t)e * 16 + h) * 465, (NA_ROT && jh - jlo == 12 && rep >= NA_HALF_REPS) ? (12 - jlo % 12) % 12 : 0);
#endif
                }
#endif
                (void)xcd; (void)slot;
            } else {
                _Pragma("nounroll") for (int rep = 0; rep < REP_LOCAL; ++rep)
#if WIN_GQA
#if defined(PROBE_WIN_VAR)
                for (int u = (int)blockIdx.x; u < 1024; u += F.G) {
                    const int kvh = u & 7, qblk = (u & 255) >> 3 | (u >> 8) << 5, q0 = qblk * 64, h = kvh * 4 + (F.wave >> 1), q0w = q0 + 32 * (F.wave & 1);
                    int klo = q0 - 128; klo = klo < 0 ? 0 : klo; int khi = q0 + 64 + 128; khi = khi > S ? S : khi;
                    int wl = q0w - 128; wl = wl < 0 ? 0 : wl; int wh = q0w + 31 + 128; wh = wh > S - 1 ? S - 1 : wh;
                    const float slope = exp2f(-8.0f * (float)(h + 1) / 32.0f);
                    const bf16* Zq = Z + (size_t)q0w * ZP_O;
                    att::local_unit<2, HD, true, 128, PROBE_WIN_VAR>(KVB + ((size_t)h * S + q0w) * HD, KVB + (size_t)(32 + kvh) * S * HD, KVB + (size_t)(40 + kvh) * S * HD, KVB + ((size_t)(48 + h) * S + q0w) * HD, (bf16*)(ws + 1100 * MiB) + (size_t)q0w * DM + h * HD, al,
                                              klo >> 6, khi >> 6, wl >> 6, (wh >> 6) + 1, q0w, slope * att::LOG2E, args.in[9][e * 32 + h] * att::LOG2E, nullptr, (WIN_ROT && (khi - klo) >> 6 == 5) ? (5 - (klo >> 6) % 5) % 5 : 0);
                }
#endif
                for (int u = (int)blockIdx.x; u < 1024; u += F.G) {
                    const int kvh = u & 7, qblk = (u & 255) >> 3 | (u >> 8) << 5, q0 = qblk * 64, h = kvh * 4 + (F.wave >> 1), q0w = q0 + 32 * (F.wave & 1);
                    int klo = q0 - 128; klo = klo < 0 ? 0 : klo; int khi = q0 + 64 + 128; khi = khi > S ? S : khi;
                    int wl = q0w - 128; wl = wl < 0 ? 0 : wl; int wh = q0w + 31 + 128; wh = wh > S - 1 ? S - 1 : wh;
                    const float slope = exp2f(-8.0f * (float)(h + 1) / 32.0f);
                    const bf16* Zq = Z + (size_t)q0w * ZP_O;
#ifndef NO_WIN
                    att::local_unit<2, HM_ALL ? HD : ZP_O, true, 128>(HM_ALL ? KVB + ((size_t)h * S + q0w) * HD : Zq + O_Q + h * HD, KVB + (size_t)((HM_ALL ? 32 : 0) + kvh) * S * HD, KVB + (size_t)((HM_ALL ? 40 : 8) + kvh) * S * HD, HM_ALL ? KVB + ((size_t)(48 + h) * S + q0w) * HD : Zq + O_G + h * HD, Y + (size_t)q0w * DM + h * HD, al,
                                              klo >> 6, khi >> 6, wl >> 6, (wh >> 6) + 1, q0w, slope * att::LOG2E, args.in[9][e * 32 + h] * att::LOG2E, nullptr, (WIN_ROT && (khi - klo) >> 6 == 5) ? (5 - (klo >> 6) % 5) % 5 : 0);
#endif
                }
#else
                for (int u = (int)blockIdx.x; u < 1024; u += F.G) {
                    const int h = (u / 256) * 8 + (u & 7), qb = (u & 255) >> 3, kvh = h >> 2, i0 = qb * 256, q0 = i0 + F.wave * 32;
                    int klo = i0 - 128; klo = klo < 0 ? 0 : klo; int khi = i0 + 256 + 128; khi = khi > S ? S : khi;
                    int wl = q0 - 128; wl = wl < 0 ? 0 : wl; int wh = q0 + 31 + 128; wh = wh > S - 1 ? S - 1 : wh;
                    const float slope = exp2f(-8.0f * (float)(h + 1) / 32.0f);
                    const bf16* Zq = Z + (size_t)i0 * ZP_O;
#ifndef NO_WIN
                    att::local_unit<2, ZP_O>(Zq + O_Q + h * HD, Z + O_K + kvh * HD, Z + O_V + kvh * HD, Zq + O_G + h * HD, Y + (size_t)i0 * DM + h * HD, al,
                                              klo >> 6, khi >> 6, wl >> 6, (wh >> 6) + 1, i0, slope * att::LOG2E, args.in[9][e * 32 + h] * att::LOG2E, nullptr);
#endif
                }
#endif
            }
        }
        CLK_END(pb + 2);
        SEAM(pb + 2);
        CLK_BEGIN(pb + 3);
        if (IN(pb + 3)) {
            const bf16* Wt = (const bf16*)(ws + (even ? WS_WOUT_E : WS_WOUT_O) + e * WOUT_BYTES);
            pg8::Gemm g{Y, Wt, S, DM, DM}; pg8::StaticOrder So; So.init(S, DM, F.G, (int)blockIdx.x);
            const bool oldb = L > 0 && ((RES_F16 >> (L - 1)) & 1), newf = !((RES_F16 >> L) & 1);
            bf16* xbo = (L == DEPTH - 1 || IN_F16) ? nullptr : XB; float* parto = L == DEPTH - 1 ? nullptr : PART;
            unsigned char* xb8o = (INP_F8 && L == 1) ? ws + WS_XB8 : nullptr;
#ifndef NO_GEMM_OUT
#define OUT_CASE(OB, NF) if (oldb == OB && newf == NF) { \
              if constexpr (res_combo(OB, NF, 0)) { if (even) { pg8::EpiOutT<OB, NF> E{L == 0 ? x_in : X, X, xbo, parto, xb8o, XH}; \
                if (OUT_F8) pg8::gemm_phase<pg8::EpiOutT<OB, NF>, pg8::StaticOrder, GEMM_ALIGN_OUT, GEMM_SP2, false, 16>(F.lds + RING_OFF, g, So, E, 1.0f / (att::Y8_SCALE * W8_SCALE)); \
                else pg8::gemm_phase<pg8::EpiOutT<OB, NF>, pg8::StaticOrder, GEMM_ALIGN_OUT, GEMM_SP2>(F.lds + RING_OFF, g, So, E); } } \
              if constexpr (res_combo(OB, NF, 1)) { if (!even) { pg8::EpiOutT<OB, NF> E{L == 0 ? x_in : X, X, xbo, parto, xb8o, XH}; \
                pg8::gemm_phase<pg8::EpiOutT<OB, NF>, pg8::StaticOrder, GEMM_ALIGN_OUT, GEMM_SP2>(F.lds + RING_OFF, g, So, E); } } }
            OUT_CASE(false, true) OUT_CASE(false, false) OUT_CASE(true, true) OUT_CASE(true, false)
#undef OUT_CASE
#endif
        }
#if defined(PROBE_OUT_LIGHT)
        if (IN(pb + 3) && L == 0) { const bf16* Wt = (const bf16*)(ws + WS_WOUT_E);
            pg8::Gemm g{Y, Wt, S, DM, DM}; pg8::StaticOrder So; So.init(S, DM, F.G, (int)blockIdx.x);
            pg8::EpiLight E{(bf16*)(ws + 900 * MiB)};
            pg8::gemm_phase<pg8::EpiLight, pg8::StaticOrder, GEMM_ALIGN, GEMM_SP2>(F.lds + RING_OFF, g, So, E); }
#endif
        CLK_END(pb + 3);
#if !GROUP_SYNC
        SEAM(pb + 3);
#else
        if (IN(pb + 3) && IN(pb + 4)) {
            pg8::StaticOrder So; So.init(S, DM, F.G, (int)blockIdx.x); pg8::Unit u0; So.next(0, u0); my_pm = u0.pm;
            grp_ticket = (int)group_sync(F.ctl + CW_GRP + (L * 32 + u0.pm) * 64, (unsigned)(F.G / (S / 256)), (unsigned*)(F.ctl + CW_BAR) + XB_TMO, F.MISC + 12);
        }
#endif
    }
    if (IN(PH_FINAL)) {
        const float* fw = args.in[10]; const int per = 256 / (F.G / (S / 256)), ln = (int)threadIdx.x & 63;
#if GROUP_SYNC
        for (int i = F.wave; i < per; i += NWAVES) { const int m = my_pm * 256 + grp_ticket * per + i;
#else
        (void)per; (void)my_pm; (void)grp_ticket;
        for (int m = gw; m < S; m += NGW) {
#endif
            GAS f32x4* xr = (GAS f32x4*)(X + (size_t)m * DM) + ln;
            f32x4 v[16]; float ss = 0.f;
            if ((RES_F16 >> (DEPTH - 1)) & 1) {
                const GAS v4u* xb = (const GAS v4u*)(XH + (size_t)m * DM) + ln;
#pragma unroll
                for (int j = 0; j < 8; ++j) { const v4u t = xb[64 * j];
                    v[2 * j] = f32x4{pg8::h_lo(t.x), pg8::h_hi(t.x), pg8::h_lo(t.y), pg8::h_hi(t.y)};
                    v[2 * j + 1] = f32x4{pg8::h_lo(t.z), pg8::h_hi(t.z), pg8::h_lo(t.w), pg8::h_hi(t.w)}; }
#pragma unroll
                for (int j = 0; j < 16; ++j) ss += (v[j].x * v[j].x + v[j].y * v[j].y) + (v[j].z * v[j].z + v[j].w * v[j].w);
                const float rs = 1.0f / sqrtf(wave_sum(ss) * (1.0f / DM) + NORM_EPS);
                GAS f32x4* xo = (GAS f32x4*)(X + (size_t)m * DM) + 2 * ln;
#pragma unroll
                for (int j = 0; j < 16; ++j) { const f32x4 w = ((const f32x4*)fw)[128 * (j >> 1) + 2 * ln + (j & 1)]; xo[128 * (j >> 1) + (j & 1)] = v[j] * rs * w; }
                continue;
            }
#pragma unroll
            for (int j = 0; j < 16; ++j) { v[j] = xr[64 * j]; ss += (v[j].x * v[j].x + v[j].y * v[j].y) + (v[j].z * v[j].z + v[j].w * v[j].w); }
            const float rs = 1.0f / sqrtf(wave_sum(ss) * (1.0f / DM) + NORM_EPS);
#pragma unroll
            for (int j = 0; j < 16; ++j) { const f32x4 w = ((const f32x4*)fw)[64 * j + ln]; xr[64 * j] = v[j] * rs * w; }
        }
    }
#if defined(DIAG_PHT)
    if (blockIdx.x == 0 && ((int)threadIdx.x) == 0) { const unsigned long long dt = pht * DIAG_PHT_K, t0_ = __builtin_amdgcn_s_memrealtime();
        while (__builtin_amdgcn_s_memrealtime() - t0_ < dt) __builtin_amdgcn_s_sleep(32); }
#elif defined(DIAG_CLK)
    if (blockIdx.x == 0 && ((int)threadIdx.x) == 0) { const unsigned long long mhz = (clk_m * 100ull) / (clk_r ? clk_r : 1ull);
        const unsigned long long dt = mhz * 50ull, t0_ = __builtin_amdgcn_s_memrealtime();
        while (__builtin_amdgcn_s_memrealtime() - t0_ < dt) __builtin_amdgcn_s_sleep(32); }
#endif
#if defined(DIAG_IDLE)
    if (((int)threadIdx.x) == 0) { atomicAdd((unsigned long long*)(F.ctl + 2048), idle_acc); atomicAdd((unsigned long long*)(F.ctl + 2048 + 64 + 64 * (bar.x & 7u)), idle_acc); }
    xcd_barrier(bar);
    if (blockIdx.x == 0 && ((int)threadIdx.x) == 0) { const unsigned long long tot = __hip_atomic_load((unsigned long long*)(F.ctl + 2048), __ATOMIC_RELAXED, __HIP_MEMORY_SCOPE_AGENT);
#if defined(DIAG_XCD_SPREAD)
        unsigned long long mx = 0, mnv = ~0ull; for (int j = 0; j < 8; ++j) { const unsigned long long v = __hip_atomic_load((unsigned long long*)(F.ctl + 2048 + 64 + 64 * j), __ATOMIC_RELAXED, __HIP_MEMORY_SCOPE_AGENT); mx = v > mx ? v : mx; mnv = v < mnv ? v : mnv; }
#if defined(DIAG_XCD_ARGMIN)
        int amin = 0; for (int j = 0; j < 8; ++j) { const unsigned long long v = __hip_atomic_load((unsigned long long*)(F.ctl + 2048 + 64 + 64 * j), __ATOMIC_RELAXED, __HIP_MEMORY_SCOPE_AGENT); if (v == mnv) amin = j; }
        const unsigned long long dt = (unsigned long long)(amin + 1) * 10000ull, t0_ = __builtin_amdgcn_s_memrealtime();
#else
        const unsigned long long dt = ((mx - mnv) / (unsigned long long)(F.G / 8)) * DIAG_K, t0_ = __builtin_amdgcn_s_memrealtime();
#endif
#else
        const unsigned long long dt = (tot / (unsigned long long)F.G) * DIAG_K, t0_ = __builtin_amdgcn_s_memrealtime();
#endif
        while (__builtin_amdgcn_s_memrealtime() - t0_ < dt) __builtin_amdgcn_s_sleep(32); }
#endif
#undef IN
#undef SEAM
}

#ifndef MK_SPLIT
#define MK_SPLIT 0
#endif
extern "C" void kernel_launch(void* const* d_in, const int* in_sizes, int n_in, void* d_out, int out_size, void* d_ws, size_t ws_size, hipStream_t stream) {
    static int grid = 0;
    if (grid == 0) {
        if (n_in != 11 || in_sizes[0] != S * DM || out_size != S * DM || ws_size < WS_END) {
            fprintf(stderr, "kernel_launch: shape mismatch: n_in %d in0 %d out %d ws %zu (need %zu)\n", n_in, n_in > 0 ? in_sizes[0] : -1, out_size, ws_size, (size_t)WS_END); grid = -1; return; }
        int dev = 0, cus = 0, per_cu = 0;
        if (hipGetDevice(&dev) != hipSuccess || hipDeviceGetAttribute(&cus, hipDeviceAttributeMultiprocessorCount, dev) != hipSuccess) { grid = -1; return; }
        if (hipFuncSetAttribute((const void*)mk_fwd, hipFuncAttributeMaxDynamicSharedMemorySize, LDS_BYTES) != hipSuccess) { fprintf(stderr, "kernel_launch: hipFuncSetAttribute failed\n"); grid = -1; return; }
        if (hipOccupancyMaxActiveBlocksPerMultiprocessor(&per_cu, (const void*)mk_fwd, NWAVES * 64, LDS_BYTES) != hipSuccess || per_cu < 1)
            fprintf(stderr, "kernel_launch: note: occupancy query reports %d workgroups per CU\n", per_cu);
        (void)hipGetLastError();
        grid = cus;
        if (grid % (S / 256) != 0 || 256 % (grid / (S / 256)) != 0) { fprintf(stderr, "kernel_launch: grid %d does not split into equal panel groups; nothing launched\n", grid); grid = -1; return; }
        { int cntp[S / 256] = {0};
            for (int c = 0; c < grid; ++c) { pg8::StaticOrder A_, B_, C_; A_.init(S, NIN_E, grid, c); B_.init(S, NIN_O, grid, c); C_.init(S, DM, grid, c); pg8::Unit a, b, d; A_.next(0, a); B_.next(0, b); C_.next(0, d);
                if (a.pm != d.pm || b.pm != d.pm) { fprintf(stderr, "kernel_launch: workgroup %d owns different row panels in different GEMMs; nothing launched\n", c); grid = -1; return; } ++cntp[d.pm]; }
            for (int p = 0; p < S / 256; ++p) if (cntp[p] != grid / (S / 256)) { fprintf(stderr, "kernel_launch: panel %d has %d owners; nothing launched\n", p, cntp[p]); grid = -1; return; } }
        { const int Ns[3] = {NIN_E, NIN_O, DM};
            for (int k = 0; k < 3; ++k) for (int c = 0; c < grid; ++c) { pg8::StaticOrder So; So.init(S, Ns[k], grid, c); pg8::Unit u0, u; if (!So.next(0, u0)) continue;
                for (int i = 1; So.next(i, u); ++i) if (u.pm != u0.pm) { fprintf(stderr, "kernel_launch: unit order gives workgroup %d two row panels (N %d); nothing launched\n", c, Ns[k]); grid = -1; return; } } }
    }
    if (grid < 0) return;
    if (hipMemsetAsync((char*)d_ws + WS_CTL, 0, CTL_ZERO_BYTES, stream) != hipSuccess) { fprintf(stderr, "kernel_launch: memset failed\n"); return; }
    Args a{};
    for (int i = 0; i < 11; ++i) a.in[i] = (const float*)d_in[i];
    a.out = (float*)d_out; a.ws = (unsigned char*)d_ws;
#if MK_SPLIT
    for (int p = 0; p < PH_END; ++p) { a.ph_lo = p; a.ph_hi = p + 1; hipLaunchKernelGGL(mk_fwd, dim3(grid), dim3(NWAVES * 64), LDS_BYTES, stream, a); }
#else
    a.ph_lo = 0; a.ph_hi = PH_END;
    hipLaunchKernelGGL(mk_fwd, dim3(grid), dim3(NWAVES * 64), LDS_BYTES, stream, a);
#endif
    const hipError_t le = hipPeekAtLastError();
    if (le != hipSuccess) fprintf(stderr, "kernel_launch: launch failed: %s\n", hipGetErrorName(le));
}
```
